# Optimizing an MI355X kernel written in HIP

```python
import jax, jax.numpy as jnp
from jax import lax
import numpy as np

D_MODEL = 2048
BATCH = 8
SEQ = 2048
DEPTH = 2

MEM_LEN = 256
EPS = 1e-6
FFN_RESIDUAL = 0.5
D_FF = ((8 * D_MODEL // 3 + 127) // 128) * 128
NEG_INF = -1e30
A_HEAD_DIM = 128
A_HEADS = (D_MODEL // 2) // A_HEAD_DIM
A_WIDTH = A_HEADS * A_HEAD_DIM
DILATED_CONFIGS = ((128, 1), (512, 4), (2048, 16))
GLA_HEADS = 4
GLA_VAL_WIDTH = D_MODEL // 2
GLA_KEY_WIDTH = GLA_VAL_WIDTH // 2
GLA_GATE_RANK = 16
GLA_GATE_TEMP = 16.0
GLA_CHUNK = 64
C_HEAD_DIM = 64
C_HEADS = D_MODEL // C_HEAD_DIM
C_KV_HEADS = C_HEADS // 8
C_HALF_WINDOW = 128
X_HEADS = 4
X_HEAD_DIM = D_MODEL // X_HEADS

AB_IN_WIDTH = 3 * A_WIDTH + 2 * GLA_KEY_WIDTH + 2 * GLA_VAL_WIDTH + 2 * GLA_GATE_RANK
C_IN_WIDTH = C_HEADS * C_HEAD_DIM + 2 * C_KV_HEADS * C_HEAD_DIM

kernel_name = 'hybrid_dilated_gla_swa_encoder'


def rms_norm(x, gain):
    xf = x.astype(jnp.float32)
    y = xf * lax.rsqrt(jnp.mean(xf * xf, axis=-1, keepdims=True) + EPS)
    return (y * gain.astype(jnp.float32)).astype(x.dtype)


def split_cols(t, sizes):
    return jnp.split(t, [int(c) for c in np.cumsum(sizes)[:-1]], axis=-1)


def alibi_slopes(n_heads):
    return jnp.exp2(-8.0 * jnp.arange(1, n_heads + 1, dtype=jnp.float32) / n_heads)


def swiglu_ffn(h, w_in, w_out):
    gate, up = jnp.split(h @ w_in, 2, axis=-1)
    return (jax.nn.silu(gate) * up) @ w_out


def banded_attention(q, k, v, half_window, slopes, dist_scale, sink=None):
    Bsz, G, R, L, hd = q.shape
    W = half_window
    nb = -(-L // W)
    pad = nb * W - L
    qb = jnp.pad(q, ((0, 0), (0, 0), (0, 0), (0, pad), (0, 0))).reshape(Bsz, G, R, nb, W, hd)

    def key_blocks(t):
        tp = jnp.pad(t, ((0, 0), (0, 0), (W, W + pad), (0, 0))).reshape(Bsz, G, nb + 2, W, hd)
        return jnp.concatenate([tp[:, :, :-2], tp[:, :, 1:-1], tp[:, :, 2:]], axis=3)

    kb, vb = key_blocks(k), key_blocks(v)
    qpos = jnp.arange(nb * W).reshape(nb, W)
    kpos = jnp.arange(nb)[:, None] * W - W + jnp.arange(3 * W)[None, :]
    rel = jnp.abs(qpos[:, :, None] - kpos[:, None, :])
    valid = (rel <= W) & (kpos[:, None, :] >= 0) & (kpos[:, None, :] < L)
    bias = -slopes.astype(jnp.float32)[:, :, None, None, None] * (rel * dist_scale).astype(jnp.float32)
    scores = jnp.einsum('bgrnqd,bgnkd->bgrnqk', qb, kb, preferred_element_type=jnp.float32) * (hd ** -0.5) + bias
    scores = jnp.where(valid, scores, NEG_INF)
    m = jnp.max(scores, axis=-1)
    if sink is not None:
        sink_b = sink.astype(jnp.float32)[:, :, None, None]
        m = jnp.maximum(m, sink_b)
    p = jnp.exp(scores - m[..., None])
    denom = jnp.sum(p, axis=-1)
    if sink is not None:
        denom = denom + jnp.exp(sink_b - m)
    out = jnp.einsum('bgrnqk,bgnkd->bgrnqd', p, vb.astype(jnp.float32)) / denom[..., None]
    lse = m + jnp.log(denom)
    out = out.reshape(Bsz, G, R, nb * W, hd)[:, :, :, :L]
    lse = lse.reshape(Bsz, G, R, nb * W)[..., :L]
    return out.astype(q.dtype), lse


def dilated_attention(q, k, v):
    Bsz, S, _ = q.shape
    H, hd = A_HEADS, A_HEAD_DIM
    slopes = alibi_slopes(H)[:, None]
    outs, lses = [], []
    for window, dil in DILATED_CONFIGS:
        L = S // dil
        half = window // (2 * dil)

        def fold(t):
            return t.reshape(Bsz, L, dil, H, hd).transpose(0, 2, 3, 1, 4).reshape(Bsz * dil, H, L, hd)

        o, lse = banded_attention(fold(q)[:, :, None], fold(k), fold(v), half, slopes, dil)
        outs.append(o[:, :, 0].reshape(Bsz, dil, H, L, hd).transpose(0, 3, 1, 2, 4).reshape(Bsz, S, H, hd))
        lses.append(lse[:, :, 0].reshape(Bsz, dil, H, L).transpose(0, 3, 1, 2).reshape(Bsz, S, H))
    w = jax.nn.softmax(jnp.stack(lses), axis=0)
    o = jnp.sum(w[..., None] * jnp.stack(outs).astype(jnp.float32), axis=0)
    return o.reshape(Bsz, S, H * hd).astype(q.dtype)


def gla_chunked(q, k, v, g, include_diag):
    Bsz, H, S, dk = q.shape
    dv = v.shape[-1]
    C = GLA_CHUNK
    n = S // C

    def to_chunks(t):
        return t.reshape(Bsz, H, n, C, t.shape[-1]).transpose(2, 0, 1, 3, 4)

    idx = jnp.arange(C)
    mask = (idx[:, None] >= idx[None, :]) if include_diag else (idx[:, None] > idx[None, :])

    def step(state, inp):
        qi, ki, vi, gi = inp
        b = jnp.cumsum(gi, axis=2)
        inter = jnp.einsum('bhik,bhkv->bhiv', qi * jnp.exp(b), state)
        diff = b[:, :, :, None, :] - b[:, :, None, :, :]
        decay = jnp.exp(jnp.where(mask[:, :, None], diff, NEG_INF))
        attn = jnp.einsum('bhik,bhjk,bhijk->bhij', qi, ki, decay)
        intra = jnp.einsum('bhij,bhjv->bhiv', attn, vi)
        b_last = b[:, :, -1, :]
        new_state = jnp.exp(b_last)[..., None] * state + jnp.einsum('bhjk,bhjv->bhkv', ki * jnp.exp(b_last[:, :, None, :] - b), vi)
        return new_state, inter + intra

    state0 = jnp.zeros((Bsz, H, dk, dv), jnp.float32)
    _, out = lax.scan(step, state0, (to_chunks(q), to_chunks(k), to_chunks(v), to_chunks(g)))
    return out.transpose(1, 2, 0, 3, 4).reshape(Bsz, H, S, dv)


def gla_bidirectional(q, k, v, r, z_f, z_b, gate_w_f, gate_b_f, gate_w_b, gate_b_b, head_norm):
    Bsz, S, _ = q.shape
    H = GLA_HEADS
    dk = GLA_KEY_WIDTH // H
    dv = GLA_VAL_WIDTH // H

    def to_heads(t):
        return t.reshape(Bsz, S, H, -1).transpose(0, 2, 1, 3).astype(jnp.float32)

    def log_gate(z, w, b):
        return to_heads(jax.nn.log_sigmoid((z @ w + b).astype(jnp.float32)) / GLA_GATE_TEMP)

    qh, kh, vh = to_heads(q) * (dk ** -0.5), to_heads(k), to_heads(v)

    def flip(t):
        return jnp.flip(t, axis=2)

    o_fwd = gla_chunked(qh, kh, vh, log_gate(z_f, gate_w_f, gate_b_f), True)
    o_bwd = flip(gla_chunked(flip(qh), flip(kh), flip(vh), flip(log_gate(z_b, gate_w_b, gate_b_b)), False))
    o = o_fwd + o_bwd
    o = o * lax.rsqrt(jnp.mean(o * o, axis=-1, keepdims=True) + EPS) * head_norm.astype(jnp.float32).reshape(H, 1, dv)
    o = o.transpose(0, 2, 1, 3).reshape(Bsz, S, H * dv).astype(q.dtype)
    return o * jax.nn.silu(r)


def mixer_ab(h, w_in, gate_w_fwd, gate_b_fwd, gate_w_bwd, gate_b_bwd, head_norm, w_out):
    qa, ka, va, qb, kb, vb, rb, zf, zb = split_cols(h @ w_in, (A_WIDTH, A_WIDTH, A_WIDTH, GLA_KEY_WIDTH, GLA_KEY_WIDTH, GLA_VAL_WIDTH, GLA_VAL_WIDTH, GLA_GATE_RANK, GLA_GATE_RANK))
    oa = dilated_attention(qa, ka, va)
    ob = gla_bidirectional(qb, kb, vb, rb, zf, zb, gate_w_fwd, gate_b_fwd, gate_w_bwd, gate_b_bwd, head_norm)
    return jnp.concatenate([oa, ob], axis=-1) @ w_out


def mixer_c(h, w_in, sink, w_out):
    Bsz, S, _ = h.shape
    G, R, hd = C_KV_HEADS, C_HEADS // C_KV_HEADS, C_HEAD_DIM
    q, k, v = split_cols(h @ w_in, (C_HEADS * hd, G * hd, G * hd))
    q = q.reshape(Bsz, S, G, R, hd).transpose(0, 2, 3, 1, 4)
    k = k.reshape(Bsz, S, G, hd).transpose(0, 2, 1, 3)
    v = v.reshape(Bsz, S, G, hd).transpose(0, 2, 1, 3)
    o, _ = banded_attention(q, k, v, C_HALF_WINDOW, alibi_slopes(C_HEADS).reshape(G, R), 1, sink.reshape(G, R))
    o = o.transpose(0, 3, 1, 2, 4).reshape(Bsz, S, C_HEADS * hd)
    return o @ w_out


def cross_attention(h, mem_h, w_q, w_kv, w_o):
    Bsz, S, _ = h.shape
    M = mem_h.shape[1]
    q = (h @ w_q).reshape(Bsz, S, X_HEADS, X_HEAD_DIM)
    k, v = jnp.split(mem_h @ w_kv, 2, axis=-1)
    k = k.reshape(Bsz, M, X_HEADS, X_HEAD_DIM)
    v = v.reshape(Bsz, M, X_HEADS, X_HEAD_DIM)
    scores = jnp.einsum('bshd,bmhd->bhsm', q, k, preferred_element_type=jnp.float32) * (X_HEAD_DIM ** -0.5)
    p = jax.nn.softmax(scores, axis=-1)
    o = jnp.einsum('bhsm,bmhd->bshd', p, v.astype(jnp.float32)).reshape(Bsz, S, X_HEADS * X_HEAD_DIM)
    return o.astype(h.dtype) @ w_o


def setup_inputs(seed: int = 0) -> dict:
    key = jax.random.key(seed)
    keys = iter(jax.random.split(key, 64))

    def dense(fan_in, fan_out):
        return jax.random.normal(next(keys), (fan_in, fan_out), jnp.float32) * (fan_in ** -0.5)

    def gain(n):
        return 1.0 + 0.02 * jax.random.normal(next(keys), (n,), jnp.float32)

    def small(shape, scale):
        return scale * jax.random.normal(next(keys), shape, jnp.float32)

    inputs = {}
    inputs['x'] = jax.random.normal(next(keys), (BATCH, SEQ, D_MODEL), jnp.float32)
    inputs['mem'] = jax.random.normal(next(keys), (BATCH, MEM_LEN, D_MODEL), jnp.float32)
    for i in range(DEPTH):
        p = 'l%d_' % i
        inputs[p + 'ffn1_norm'] = gain(D_MODEL)
        inputs[p + 'ffn1_w_in'] = dense(D_MODEL, 2 * D_FF)
        inputs[p + 'ffn1_w_out'] = dense(D_FF, D_MODEL)
        inputs[p + 'mix_norm'] = gain(D_MODEL)
        if i % 2 == 0:
            inputs[p + 'mix_w_in'] = dense(D_MODEL, AB_IN_WIDTH)
            inputs[p + 'gla_gate_w_fwd'] = dense(GLA_GATE_RANK, GLA_KEY_WIDTH)
            inputs[p + 'gla_gate_b_fwd'] = small((GLA_KEY_WIDTH,), 0.1)
            inputs[p + 'gla_gate_w_bwd'] = dense(GLA_GATE_RANK, GLA_KEY_WIDTH)
            inputs[p + 'gla_gate_b_bwd'] = small((GLA_KEY_WIDTH,), 0.1)
            inputs[p + 'gla_head_norm'] = gain(GLA_VAL_WIDTH)
            inputs[p + 'mix_w_out'] = dense(A_WIDTH + GLA_VAL_WIDTH, D_MODEL)
        else:
            inputs[p + 'mix_w_in'] = dense(D_MODEL, C_IN_WIDTH)
            inputs[p + 'sink'] = small((C_HEADS,), 0.5)
            inputs[p + 'mix_w_out'] = dense(C_HEADS * C_HEAD_DIM, D_MODEL)
        inputs[p + 'xattn_norm'] = gain(D_MODEL)
        inputs[p + 'xattn_mem_norm'] = gain(D_MODEL)
        inputs[p + 'xattn_w_q'] = dense(D_MODEL, X_HEADS * X_HEAD_DIM)
        inputs[p + 'xattn_w_kv'] = dense(D_MODEL, 2 * X_HEADS * X_HEAD_DIM)
        inputs[p + 'xattn_w_o'] = dense(X_HEADS * X_HEAD_DIM, D_MODEL)
        inputs[p + 'ffn2_norm'] = gain(D_MODEL)
        inputs[p + 'ffn2_w_in'] = dense(D_MODEL, 2 * D_FF)
        inputs[p + 'ffn2_w_out'] = dense(D_FF, D_MODEL)
    inputs['final_norm'] = gain(D_MODEL)
    return inputs


def reference(x, mem,
              l0_ffn1_norm, l0_ffn1_w_in, l0_ffn1_w_out,
              l0_mix_norm, l0_mix_w_in, l0_gla_gate_w_fwd, l0_gla_gate_b_fwd, l0_gla_gate_w_bwd, l0_gla_gate_b_bwd, l0_gla_head_norm, l0_mix_w_out,
              l0_xattn_norm, l0_xattn_mem_norm, l0_xattn_w_q, l0_xattn_w_kv, l0_xattn_w_o,
              l0_ffn2_norm, l0_ffn2_w_in, l0_ffn2_w_out,
              l1_ffn1_norm, l1_ffn1_w_in, l1_ffn1_w_out,
              l1_mix_norm, l1_mix_w_in, l1_sink, l1_mix_w_out,
              l1_xattn_norm, l1_xattn_mem_norm, l1_xattn_w_q, l1_xattn_w_kv, l1_xattn_w_o,
              l1_ffn2_norm, l1_ffn2_w_in, l1_ffn2_w_out,
              final_norm):
    layers = (
        dict(ffn1=(l0_ffn1_norm, l0_ffn1_w_in, l0_ffn1_w_out),
             mix_norm=l0_mix_norm,
             mix=(l0_mix_w_in, l0_gla_gate_w_fwd, l0_gla_gate_b_fwd, l0_gla_gate_w_bwd, l0_gla_gate_b_bwd, l0_gla_head_norm, l0_mix_w_out),
             xattn=(l0_xattn_norm, l0_xattn_mem_norm, l0_xattn_w_q, l0_xattn_w_kv, l0_xattn_w_o),
             ffn2=(l0_ffn2_norm, l0_ffn2_w_in, l0_ffn2_w_out)),
        dict(ffn1=(l1_ffn1_norm, l1_ffn1_w_in, l1_ffn1_w_out),
             mix_norm=l1_mix_norm,
             mix=(l1_mix_w_in, l1_sink, l1_mix_w_out),
             xattn=(l1_xattn_norm, l1_xattn_mem_norm, l1_xattn_w_q, l1_xattn_w_kv, l1_xattn_w_o),
             ffn2=(l1_ffn2_norm, l1_ffn2_w_in, l1_ffn2_w_out)),
    )
    for i in range(DEPTH):
        p = layers[i]
        n1, wi1, wo1 = p['ffn1']
        x = x + FFN_RESIDUAL * swiglu_ffn(rms_norm(x, n1), wi1, wo1)
        mixer = mixer_ab if i % 2 == 0 else mixer_c
        x = x + mixer(rms_norm(x, p['mix_norm']), *p['mix'])
        xn, mn, wq, wkv, wo = p['xattn']
        x = x + cross_attention(rms_norm(x, xn), rms_norm(mem, mn), wq, wkv, wo)
        n2, wi2, wo2 = p['ffn2']
        x = x + FFN_RESIDUAL * swiglu_ffn(rms_norm(x, n2), wi2, wo2)
    return rms_norm(x, final_norm)
```

```cpp
#include <hip/hip_runtime.h>
#include <hip/hip_cooperative_groups.h>
#include <cstdio>
#include <cstdint>
namespace cg = cooperative_groups;
namespace pg8 {
#define PG8_LAS __attribute__((address_space(3)))
typedef unsigned short bf16_t;
typedef short bf16x8 __attribute__((ext_vector_type(8)));
typedef float f32x4 __attribute__((ext_vector_type(4)));
typedef unsigned u32x4 __attribute__((ext_vector_type(4)));
constexpr int BM = 256, BK = 64, HALF = 128, HTB = HALF * BK * 2  , STAGE_BYTES = 8 * HTB, NXCD = 8, WGM = 8;

__host__ __device__ __forceinline__ int lds_byte(int r, int c) { const int st = (r >> 4) * 2 + (c >> 5), rr = r & 15, cc = c & 31, ob = rr * 64 + cc * 2; return st * 1024 + (ob ^ (((ob >> 9) & 1) << 5)); }
__host__ __device__ __forceinline__ void stage_rc(int b, int& R, int& C) { const int st = b / 1024, sb = b % 1024, swz = sb ^ (((sb >> 9) & 1) << 5); R = (st >> 1) * 16 + swz / 64; C = (st & 1) * 32 + (swz % 64) / 2; }
__host__ __device__ __forceinline__ int perm32(int rho) { const int n = rho >> 4, i = rho & 15; return 8 * (i >> 2) + 4 * n + (i & 3); }

struct Unit { int pm, pn; };
struct Gemm { const bf16_t* A; const bf16_t* Bt; int M, N, K; };

struct StaticOrder {
    int nM, nN, nwg, G, c;
    __host__ __device__ void init(int M, int N, int G_, int c_) { nM = M / BM; nN = N / BM; nwg = nM * nN; G = G_; c = c_; }
    __host__ __device__ bool next(int i, Unit& u) const {
        const long L = (long)i * G + c; if (L >= nwg) return false;
        int wgid = (int)L; { const int q = nwg / NXCD, r = nwg % NXCD, xcd = wgid % NXCD, off = wgid / NXCD; wgid = (xcd < r ? xcd * (q + 1) : r * (q + 1) + (xcd - r) * q) + off; }
        const int nig = WGM * nN, gid = wgid / nig, fm = gid * WGM, gsz = (nM - fm) < WGM ? (nM - fm) : WGM;
        u.pm = fm + ((wgid % nig) % gsz); u.pn = (wgid % nig) / gsz; return true;
    }
    __device__ __forceinline__ void a_ready(const Unit&) const {}
    __device__ __forceinline__ void done(const Unit&) const {}
};

typedef float f32x2_cv __attribute__((ext_vector_type(2))); typedef __bf16 bf16x2_cv __attribute__((ext_vector_type(2)));
__device__ __forceinline__ unsigned cvt_pk_bf16(float lo, float hi) { const f32x2_cv v = {lo, hi}; const bf16x2_cv b = __builtin_convertvector(v, bf16x2_cv); return __builtin_bit_cast(unsigned, b); }
template <class Epi, class Sched, bool ALIGN_EPI = false, bool SP2 = false>
__device__ __forceinline__ void gemm_phase(PG8_LAS unsigned char* lds, const Gemm g, const Sched& S, const Epi& E) {
    int tid_l = threadIdx.x; asm volatile("" : "+v"(tid_l));
    const int tid = tid_l, wid = __builtin_amdgcn_readfirstlane(tid >> 6), lane = tid & 63, wr = wid >> 2, wc = wid & 3, fr = lane & 15, fq = lane >> 4;
    const int K = g.K, nt = K / BK;
    unsigned voffA[2], voffB[2];
#pragma unroll
    for (int i = 0; i < 2; ++i) { int R, C; stage_rc(tid * 16 + i * 8192, R, C); const int Rb = Epi::PERM ? ((R & ~31) + perm32(R & 31)) : R;
        voffA[i] = (unsigned)(R * K + C) * 2u; voffB[i] = (unsigned)(Rb * K + C) * 2u; }
    const size_t kstep = (size_t)(BK * 2);
    const size_t hstep = (size_t)HALF * K * 2;
    const size_t tstep = 2 * hstep;
    const unsigned ldsw = (unsigned)wid * 1024u;
    const int aoff = lds_byte(wr * 64 + fr, fq * 8), boff = lds_byte(wc * 32 + fr, fq * 8);
#define PG8_SA(b, h) (((b) * 2 + (h)) * HTB)
#define PG8_SB(b, h) ((4 + (b) * 2 + (h)) * HTB)
#define PG8_STAGE(bufoff, gbase, voff) do { _Pragma("unroll") for (int _i = 0; _i < 2; ++_i) \
        __builtin_amdgcn_global_load_lds((const unsigned*)((const char*)(gbase) + (voff)[_i]), (PG8_LAS unsigned*)(lds + (bufoff) + ldsw + _i * 8192), 16, 0, 0); } while (0)
#define PG8_LDA(dst, b, h) do { _Pragma("unroll") for (int m = 0; m < 4; ++m) _Pragma("unroll") for (int k = 0; k < 2; ++k) dst[m][k] = *(const PG8_LAS bf16x8*)(lds + PG8_SA(b, h) + aoff + m * 2048 + k * 1024); } while (0)
#define PG8_LDB(dst, b, h) do { _Pragma("unroll") for (int n = 0; n < 2; ++n) _Pragma("unroll") for (int k = 0; k < 2; ++k) dst[n][k] = *(const PG8_LAS bf16x8*)(lds + PG8_SB(b, h) + boff + n * 2048 + k * 1024); } while (0)
#define PG8_MMA(ai, bj, At, Bt) do { __builtin_amdgcn_s_setprio(1); _Pragma("unroll") for (int m = 0; m < 4; ++m) _Pragma("unroll") for (int n = 0; n < 2; ++n) _Pragma("unroll") for (int k = 0; k < 2; ++k) \
        acc[ai][bj][m][n] = __builtin_amdgcn_mfma_f32_16x16x32_bf16(Bt[n][k], At[m][k], acc[ai][bj][m][n], 0, 0, 0); __builtin_amdgcn_s_setprio(0); } while (0)
#define PG8_WAIT_V(n) asm volatile("s_waitcnt vmcnt(" #n ")" ::: "memory")
#define PG8_WAIT_L(n) asm volatile("s_waitcnt lgkmcnt(" #n ")" ::: "memory")
#define PG8_BAR __builtin_amdgcn_s_barrier()
#define PG8_SCHED __builtin_amdgcn_sched_barrier(0)
    Unit cur, nxt; int ui = 0;
    if (!S.next(0, cur)) return;
    f32x4 acc[2][2][4][2];
#pragma unroll
    for (int a = 0; a < 2; ++a)
#pragma unroll
        for (int b = 0; b < 2; ++b)
#pragma unroll
            for (int m = 0; m < 4; ++m)
#pragma unroll
                for (int n = 0; n < 2; ++n) acc[a][b][m][n] = (f32x4){0.f, 0.f, 0.f, 0.f};
    bf16x8 At[4][2], B0[2][2], B1[2][2];
    const char* cA = (const char*)g.A + (size_t)cur.pm * tstep; const char* cB = (const char*)g.Bt + (size_t)cur.pn * tstep;
    S.a_ready(cur);
    if constexpr (SP2) {
        PG8_STAGE(PG8_SB(0, 0), cB, voffB); PG8_STAGE(PG8_SB(0, 1), cB + hstep, voffB); PG8_STAGE(PG8_SA(0, 0), cA, voffA); PG8_STAGE(PG8_SA(0, 1), cA + hstep, voffA);
        if (wr == 1) PG8_BAR;
        PG8_WAIT_V(2); PG8_BAR;
        PG8_STAGE(PG8_SB(1, 0), cB + kstep, voffB); PG8_STAGE(PG8_SA(1, 0), cA + kstep, voffA); PG8_STAGE(PG8_SB(1, 1), cB + hstep + kstep, voffB);
        PG8_WAIT_V(6); PG8_BAR;
    } else {
        PG8_STAGE(PG8_SB(0, 0), cB, voffB); PG8_STAGE(PG8_SA(0, 0), cA, voffA); PG8_STAGE(PG8_SB(0, 1), cB + hstep, voffB); PG8_STAGE(PG8_SA(0, 1), cA + hstep, voffA);
        if (wr == 1) PG8_BAR;
        PG8_WAIT_V(4); PG8_BAR;
        PG8_STAGE(PG8_SB(1, 0), cB + kstep, voffB); PG8_STAGE(PG8_SA(1, 0), cA + kstep, voffA); PG8_STAGE(PG8_SB(1, 1), cB + hstep + kstep, voffB);
        PG8_WAIT_V(6); PG8_BAR;
    }
    for (;;) {
        const bool has_next = S.next(ui + 1, nxt);
        const char* nA = has_next ? (const char*)g.A + (size_t)nxt.pm * tstep : cA; const char* nB = has_next ? (const char*)g.Bt + (size_t)nxt.pn * tstep : cB;
        for (int t = 0; t < nt; t += 2) {
            const bool last = (t == nt - 2);
            const char* a1 = cA + (size_t)(t + 1) * kstep;
            const char* a2 = last ? nA : cA + (size_t)(t + 2) * kstep; const char* b2 = last ? nB : cB + (size_t)(t + 2) * kstep;
            const char* a3 = a2 + kstep; const char* b3 = b2 + kstep;
            if (last && has_next) S.a_ready(nxt);
            if constexpr (SP2) {
            PG8_LDB(B0, 0, 0); PG8_LDB(B1, 0, 1); PG8_SCHED; PG8_LDA(At, 0, 0); PG8_STAGE(PG8_SA(1, 1), a1 + hstep, voffA);
            PG8_WAIT_V(8); PG8_WAIT_L(0); PG8_BAR; PG8_MMA(0, 0, At, B0); PG8_MMA(0, 1, At, B1); PG8_BAR; PG8_SCHED;
            PG8_LDA(At, 0, 1); PG8_STAGE(PG8_SB(0, 0), b2, voffB); PG8_STAGE(PG8_SB(0, 1), b2 + hstep, voffB); PG8_STAGE(PG8_SA(0, 0), a2, voffA);
            PG8_WAIT_V(8); PG8_WAIT_L(0); PG8_BAR; PG8_MMA(1, 0, At, B0); PG8_MMA(1, 1, At, B1); PG8_BAR; PG8_SCHED;
            PG8_LDB(B0, 1, 0); PG8_LDB(B1, 1, 1); PG8_SCHED; PG8_LDA(At, 1, 0); PG8_STAGE(PG8_SA(0, 1), a2 + hstep, voffA);
            PG8_WAIT_V(8); PG8_WAIT_L(0); PG8_BAR; PG8_MMA(0, 0, At, B0); PG8_MMA(0, 1, At, B1); PG8_BAR; PG8_SCHED;
            PG8_LDA(At, 1, 1); PG8_STAGE(PG8_SB(1, 0), b3, voffB); PG8_STAGE(PG8_SB(1, 1), b3 + hstep, voffB); PG8_STAGE(PG8_SA(1, 0), a3, voffA);
            PG8_WAIT_V(8); PG8_WAIT_L(0); PG8_BAR; PG8_MMA(1, 0, At, B0); PG8_MMA(1, 1, At, B1); PG8_BAR; PG8_SCHED;
            } else {
            PG8_LDB(B0, 0, 0); PG8_SCHED; PG8_LDA(At, 0, 0); PG8_STAGE(PG8_SA(1, 1), a1 + hstep, voffA);
            PG8_WAIT_L(8); PG8_BAR; PG8_WAIT_L(0); PG8_MMA(0, 0, At, B0); PG8_BAR; PG8_SCHED;
            PG8_LDB(B1, 0, 1); PG8_STAGE(PG8_SB(0, 0), b2, voffB);
            PG8_BAR; PG8_WAIT_L(0); PG8_MMA(0, 1, At, B1); PG8_BAR;
            PG8_LDA(At, 0, 1); PG8_STAGE(PG8_SA(0, 0), a2, voffA);
            PG8_BAR; PG8_WAIT_L(0); PG8_MMA(1, 0, At, B0); PG8_BAR; PG8_SCHED;
            PG8_STAGE(PG8_SB(0, 1), b2 + hstep, voffB);
            PG8_WAIT_V(6); PG8_BAR; PG8_MMA(1, 1, At, B1); PG8_BAR;
            PG8_LDB(B0, 1, 0); PG8_SCHED; PG8_LDA(At, 1, 0); PG8_STAGE(PG8_SA(0, 1), a2 + hstep, voffA);
            PG8_WAIT_L(8); PG8_BAR; PG8_WAIT_L(0); PG8_MMA(0, 0, At, B0); PG8_BAR; PG8_SCHED;
            PG8_LDB(B1, 1, 1); PG8_STAGE(PG8_SB(1, 0), b3, voffB);
            PG8_BAR; PG8_WAIT_L(0); PG8_MMA(0, 1, At, B1); PG8_BAR;
            PG8_LDA(At, 1, 1); PG8_STAGE(PG8_SA(1, 0), a3, voffA);
            PG8_BAR; PG8_WAIT_L(0); PG8_MMA(1, 0, At, B0); PG8_BAR; PG8_SCHED;
            PG8_STAGE(PG8_SB(1, 1), b3 + hstep, voffB);
            PG8_WAIT_V(6); PG8_BAR; PG8_MMA(1, 1, At, B1); PG8_BAR;
            }
        }
        if constexpr (ALIGN_EPI) { if (wr == 0) PG8_BAR; }
        if constexpr (!Epi::AFTER_DRAIN) { E(acc, cur, wr, wc, fr, fq); S.done(cur); }
        if (!has_next) break;
#pragma unroll
        for (int a = 0; a < 2; ++a)
#pragma unroll
            for (int b = 0; b < 2; ++b)
#pragma unroll
                for (int m = 0; m < 4; ++m)
#pragma unroll
                    for (int n = 0; n < 2; ++n) acc[a][b][m][n] = (f32x4){0.f, 0.f, 0.f, 0.f};
        cur = nxt; cA = nA; cB = nB; ++ui;
        if constexpr (ALIGN_EPI) { if (wr == 1) PG8_BAR; }
    }
    PG8_WAIT_V(0);
    if constexpr (!ALIGN_EPI) { if (wr == 0) PG8_BAR; }
    PG8_BAR;
    if constexpr (Epi::AFTER_DRAIN) { E.fused(acc, cur, wr, wc, fr, fq, lds, wid, lane); S.done(cur); }
#undef PG8_SA
#undef PG8_SB
#undef PG8_STAGE
#undef PG8_LDA
#undef PG8_LDB
#undef PG8_MMA
#undef PG8_WAIT_V
#undef PG8_WAIT_L
#undef PG8_BAR
#undef PG8_SCHED
}
}

namespace pg8 {
struct EpiPlain {
    static constexpr bool PERM = true, AFTER_DRAIN = false;
    bf16_t* O; int ldc;
    __device__ __forceinline__ void operator()(const f32x4 (&acc)[2][2][4][2], const Unit& u, int wr, int wc, int fr, int fq) const {
        const int row0 = u.pm * BM + wr * 64 + fr, col0 = u.pn * BM + wc * 32 + 8 * fq;
#pragma unroll
        for (int ai = 0; ai < 2; ++ai)
#pragma unroll
            for (int m = 0; m < 4; ++m) { bf16_t* rowp = O + (size_t)(row0 + ai * HALF + m * 16) * ldc + col0;
#pragma unroll
                for (int bj = 0; bj < 2; ++bj) { const f32x4 v0 = acc[ai][bj][m][0], v1 = acc[ai][bj][m][1];
                    u32x4 w; w.x = cvt_pk_bf16(v0[0], v0[1]); w.y = cvt_pk_bf16(v0[2], v0[3]); w.z = cvt_pk_bf16(v1[0], v1[1]); w.w = cvt_pk_bf16(v1[2], v1[3]);
                    *(u32x4*)(rowp + bj * HALF) = w; } }
    }
};
__device__ __forceinline__ float silu_f(float x) { return x * __builtin_amdgcn_rcpf(1.f + __builtin_amdgcn_exp2f(x * -1.4426950408889634f)); }
struct EpiSwiglu {
    static constexpr bool PERM = true, AFTER_DRAIN = false;
    bf16_t* O; int ldc;
    __device__ __forceinline__ void operator()(const f32x4 (&acc)[2][2][4][2], const Unit& u, int wr, int wc, int fr, int fq) const {
        const int row0 = u.pm * BM + wr * 64 + fr, col0 = u.pn * HALF + wc * 32 + 8 * fq;
#pragma unroll
        for (int ai = 0; ai < 2; ++ai)
#pragma unroll
            for (int m = 0; m < 4; ++m) { bf16_t* rowp = O + (size_t)(row0 + ai * HALF + m * 16) * ldc + col0;
                const f32x4 g0 = acc[ai][0][m][0], g1 = acc[ai][0][m][1], u0 = acc[ai][1][m][0], u1 = acc[ai][1][m][1];
                u32x4 w;
                w.x = cvt_pk_bf16(silu_f(g0[0]) * u0[0], silu_f(g0[1]) * u0[1]); w.y = cvt_pk_bf16(silu_f(g0[2]) * u0[2], silu_f(g0[3]) * u0[3]);
                w.z = cvt_pk_bf16(silu_f(g1[0]) * u1[0], silu_f(g1[1]) * u1[1]); w.w = cvt_pk_bf16(silu_f(g1[2]) * u1[2], silu_f(g1[3]) * u1[3]);
                *(u32x4*)rowp = w; }
    }
};
struct EpiResid {
    static constexpr bool PERM = false, AFTER_DRAIN = false;
    const float* base; float* out; float alpha;
    __device__ __forceinline__ void operator()(const f32x4 (&acc)[2][2][4][2], const Unit& u, int wr, int wc, int fr, int fq) const {
        const int col0 = u.pn * BM + wc * 32 + 4 * fq;
#pragma unroll
        for (int ai = 0; ai < 2; ++ai)
#pragma unroll
            for (int m = 0; m < 4; ++m) { const size_t off = (size_t)(u.pm * BM + ai * HALF + wr * 64 + m * 16 + fr) * 2048 + col0;
#pragma unroll
                for (int bj = 0; bj < 2; ++bj)
#pragma unroll
                    for (int n = 0; n < 2; ++n) { const size_t o = off + bj * HALF + n * 16; const f32x4 bs = *(const f32x4*)(base + o); *(f32x4*)(out + o) = bs + acc[ai][bj][m][n] * alpha; } }
    }
};
}

#define LAS __attribute__((address_space(3)))
typedef unsigned short bf16;
typedef float f32x4 __attribute__((ext_vector_type(4)));
typedef short bf16x8 __attribute__((ext_vector_type(8)));
typedef short s16x4 __attribute__((ext_vector_type(4)));
typedef unsigned u32x4 __attribute__((ext_vector_type(4)));
typedef unsigned u32x2 __attribute__((ext_vector_type(2)));

constexpr int MTOK = 16384, DM = 2048, SEQ = 2048, NBATCH = 8, DFF = 5504, MEMLEN = 256;
constexpr int LD_AB = 6400, LD_C = 2560;
constexpr float EPS = 1e-6f;
constexpr size_t MiB = 1u << 20;
constexpr size_t WS_FF1IN = 0, WS_FF1OUT = 44 * MiB, WS_FF2IN = 66 * MiB, WS_FF2OUT = 110 * MiB, WS_MIXIN = 132 * MiB, WS_MIXOUT = 157 * MiB,
                 WS_WQ = 165 * MiB, WS_WO = 173 * MiB, WS_WKV0 = 181 * MiB, WS_WKV1 = 197 * MiB, WS_H = 213 * MiB, WS_PROJ = 277 * MiB, WS_OBUF = 477 * MiB,
                 WS_OC = 541 * MiB, WS_LSE = 637 * MiB, WS_ST = 639 * MiB, WS_DD = 767 * MiB, WS_KV = 768 * MiB, WS_MEMH = 800 * MiB, WS_CTL = 816 * MiB, WS_END = 817 * MiB;
constexpr int LDS_BYTES = 147456;

struct Params { const float* in[37]; float* out; unsigned char* ws; };

__device__ __forceinline__ unsigned pk2(float lo, float hi) { return pg8::cvt_pk_bf16(lo, hi); }
__device__ __forceinline__ float bflo(unsigned w) { return __uint_as_float(w << 16); }
__device__ __forceinline__ float bfhi(unsigned w) { return __uint_as_float(w & 0xffff0000u); }
__device__ __forceinline__ float wave_sum(float v) {
#pragma unroll
    for (int o = 1; o < 64; o <<= 1) v += __shfl_xor(v, o);
    return v;
}
__device__ __forceinline__ f32x4 mfma16(bf16x8 a, bf16x8 b, f32x4 c) { return __builtin_amdgcn_mfma_f32_16x16x32_bf16(a, b, c, 0, 0, 0); }
__device__ __forceinline__ bf16x8 lds16(const LAS unsigned char* p) { return *(const LAS bf16x8*)p; }
__device__ __forceinline__ bf16x8 vtr8(const LAS unsigned char* p0, const LAS unsigned char* p1) {
    const s16x4 lo = __builtin_bit_cast(s16x4, __builtin_amdgcn_ds_read_tr16_b64_v4i16((LAS s16x4*)p0));
    const s16x4 hi = __builtin_bit_cast(s16x4, __builtin_amdgcn_ds_read_tr16_b64_v4i16((LAS s16x4*)p1));
    return (bf16x8){lo[0], lo[1], lo[2], lo[3], hi[0], hi[1], hi[2], hi[3]};
}

__device__ __forceinline__ void transpose_item(const float* __restrict__ W, int K, int N, bf16* __restrict__ WT, int mode, LAS float* scr, int item, int lane) {
    const int nblk = N / 32, kb = item / nblk, nb = item % nblk, k0 = 64 * kb, n0 = 32 * nb;
    int drow0 = n0;
    if (mode == 1) { const int up = n0 >= DFF ? 1 : 0, j = n0 - up * DFF; drow0 = (j >> 7) * 256 + (j & 127) + up * 128; }
#pragma unroll 8
    for (int i = 0; i < 32; ++i) { const int kk = 2 * i + (lane >> 5); scr[kk * 33 + (lane & 31)] = W[(size_t)(k0 + kk) * N + n0 + (lane & 31)]; }
    asm volatile("s_waitcnt lgkmcnt(0)" ::: "memory");
    const int c = lane & 7;
#pragma unroll
    for (int j = 0; j < 4; ++j) { const int n = (lane >> 3) + 8 * j; const LAS float* s = scr + (8 * c) * 33 + n;
        u32x4 o; o.x = pk2(s[0 * 33], s[1 * 33]); o.y = pk2(s[2 * 33], s[3 * 33]); o.z = pk2(s[4 * 33], s[5 * 33]); o.w = pk2(s[6 * 33], s[7 * 33]);
        *(u32x4*)(WT + (size_t)(drow0 + n) * K + k0 + 8 * c) = o; }
    asm volatile("s_waitcnt lgkmcnt(0)" ::: "memory");
}
struct TD { const float* W; int K, N, mode; size_t dst; };
__device__ __forceinline__ TD get_td(const Params& p, int layer, int i) {
    TD t; t.mode = 0; t.K = DM; t.N = DM; t.W = nullptr; t.dst = 0;
    if (layer == 0) {
        switch (i) {
            case 0: t.W = p.in[3]; t.N = 2 * DFF; t.mode = 1; t.dst = WS_FF1IN; break;
            case 1: t.W = p.in[4]; t.K = DFF; t.dst = WS_FF1OUT; break;
            case 2: t.W = p.in[6]; t.N = 6176; t.dst = WS_MIXIN; break;
            case 3: t.W = p.in[12]; t.dst = WS_MIXOUT; break;
            case 4: t.W = p.in[15]; t.dst = WS_WQ; break;
            case 5: t.W = p.in[16]; t.N = 4096; t.dst = WS_WKV0; break;
            case 6: t.W = p.in[17]; t.dst = WS_WO; break;
            case 7: t.W = p.in[19]; t.N = 2 * DFF; t.mode = 1; t.dst = WS_FF2IN; break;
            case 8: t.W = p.in[20]; t.K = DFF; t.dst = WS_FF2OUT; break;
            default: t.W = p.in[31]; t.N = 4096; t.dst = WS_WKV1; break;
        }
    } else {
        switch (i) {
            case 0: t.W = p.in[22]; t.N = 2 * DFF; t.mode = 1; t.dst = WS_FF1IN; break;
            case 1: t.W = p.in[23]; t.K = DFF; t.dst = WS_FF1OUT; break;
            case 2: t.W = p.in[25]; t.N = 2560; t.dst = WS_MIXIN; break;
            case 3: t.W = p.in[27]; t.dst = WS_MIXOUT; break;
            case 4: t.W = p.in[30]; t.dst = WS_WQ; break;
            case 5: t.W = p.in[32]; t.dst = WS_WO; break;
            case 6: t.W = p.in[34]; t.N = 2 * DFF; t.mode = 1; t.dst = WS_FF2IN; break;
            default: t.W = p.in[35]; t.K = DFF; t.dst = WS_FF2OUT; break;
        }
    }
    return t;
}
template <int layer>
__device__ __forceinline__ void convert_weights(const Params& p, LAS unsigned char* lds, int gw, int ngw, int wave, int lane) {
    LAS float* scr = (LAS float*)(lds + wave * 16384);
    constexpr int nmat = layer == 0 ? 10 : 8;
#pragma unroll
    for (int i = 0; i < nmat; ++i) {
        const TD t = get_td(p, layer, i);
        const float* W = t.W; bf16* WT = (bf16*)(p.ws + t.dst);
        const int items = (t.K / 64) * (t.N / 32);
        for (int it = gw; it < items; it += ngw) transpose_item(W, t.K, t.N, WT, t.mode, scr, it, lane);
    }
}
__device__ __forceinline__ void norm_row(const float* xrow, const float* gain, bf16* orow, float* of, int lane) {
    const f32x4* xr = (const f32x4*)xrow + lane;
    f32x4 v[8]; float s = 0.f;
#pragma unroll
    for (int j = 0; j < 8; ++j) { v[j] = xr[64 * j]; s += (v[j].x * v[j].x + v[j].y * v[j].y) + (v[j].z * v[j].z + v[j].w * v[j].w); }
    const float rstd = rsqrtf(wave_sum(s) * (1.f / DM) + EPS);
    const f32x4* gr = (const f32x4*)gain + lane;
#pragma unroll
    for (int j = 0; j < 8; ++j) { const f32x4 g = gr[64 * j]; const f32x4 y = v[j] * rstd * g;
        if (of) ((f32x4*)of)[64 * j + lane] = y;
        else { u32x2 w; w.x = pk2(y.x, y.y); w.y = pk2(y.z, y.w); ((u32x2*)orow)[64 * j + lane] = w; } }
}
__device__ __forceinline__ void norm_row2(const float* xa, const float* xb_, const float* gain, bf16* oa, bf16* ob_, float* fa, float* fb, int lane) {
    const f32x4* ra = (const f32x4*)xa + lane; const f32x4* rb = (const f32x4*)xb_ + lane;
    f32x4 va[8], vb[8]; float sa = 0.f, sb = 0.f;
#pragma unroll
    for (int j = 0; j < 8; ++j) { va[j] = ra[64 * j]; vb[j] = rb[64 * j]; }
#pragma unroll
    for (int j = 0; j < 8; ++j) { sa += (va[j].x * va[j].x + va[j].y * va[j].y) + (va[j].z * va[j].z + va[j].w * va[j].w); sb += (vb[j].x * vb[j].x + vb[j].y * vb[j].y) + (vb[j].z * vb[j].z + vb[j].w * vb[j].w); }
    const float rsa = rsqrtf(wave_sum(sa) * (1.f / DM) + EPS), rsb = rsqrtf(wave_sum(sb) * (1.f / DM) + EPS);
    const f32x4* gr = (const f32x4*)gain + lane;
#pragma unroll
    for (int j = 0; j < 8; ++j) { const f32x4 g = gr[64 * j]; const f32x4 ya = va[j] * rsa * g, yb = vb[j] * rsb * g;
        if (fa) { ((f32x4*)fa)[64 * j + lane] = ya; ((f32x4*)fb)[64 * j + lane] = yb; }
        else { u32x2 wa, wb; wa.x = pk2(ya.x, ya.y); wa.y = pk2(ya.z, ya.w); wb.x = pk2(yb.x, yb.y); wb.y = pk2(yb.z, yb.w); ((u32x2*)oa)[64 * j + lane] = wa; ((u32x2*)ob_)[64 * j + lane] = wb; } }
}
__device__ __forceinline__ void norm_rows(const float* x, const float* gain, bf16* out, int nrows, int gw, int ngw, int lane) {
    int m = gw;
    for (; m + ngw < nrows; m += 2 * ngw) norm_row2(x + (size_t)m * DM, x + (size_t)(m + ngw) * DM, gain, out + (size_t)m * DM, out + (size_t)(m + ngw) * DM, nullptr, nullptr, lane);
    for (; m < nrows; m += ngw) norm_row(x + (size_t)m * DM, gain, out + (size_t)m * DM, nullptr, lane);
}

template <int HD, int NB, int NQ, int NROWS>
__device__ __forceinline__ void banded_unit(LAS unsigned char* lds, int tid, const bf16* __restrict__ qb, const bf16* __restrict__ kbp, const bf16* __restrict__ vbp, int ld,
                                            int dil, int r, int L, int qpos0, int ks, int nrows, int wave_row_off, int W, float slope, float scale, float m_init, float l_init,
                                            bf16* __restrict__ ob, int old, float* __restrict__ lseb) {
    constexpr int CH = HD / 8, ROWB = HD * 2, SWZ = (CH - 1) & 15, NK = HD / 32, ND = HD / 16;
    LAS unsigned char* Kt = lds; LAS unsigned char* Vt = lds + nrows * ROWB;
    constexpr int NIT = (NROWS * CH + 511) / 512;
    u32x4 k4[NIT], v4[NIT];
#pragma unroll
    for (int it = 0; it < NIT; ++it) { const int idx = tid + it * 512, row = idx / CH, ch = idx % CH, kp = ks + row;
        k4[it] = (u32x4){0u, 0u, 0u, 0u}; v4[it] = (u32x4){0u, 0u, 0u, 0u};
        if (idx < NROWS * CH && kp >= 0 && kp < L) { const size_t off = (size_t)(kp * dil + r) * ld + ch * 8; k4[it] = *(const u32x4*)(kbp + off); v4[it] = *(const u32x4*)(vbp + off); } }
#pragma unroll
    for (int it = 0; it < NIT; ++it) { const int idx = tid + it * 512, row = idx / CH, ch = idx % CH;
        if (idx < NROWS * CH) { const int lo = row * ROWB + ((ch ^ (row & SWZ)) << 4); *(LAS u32x4*)(Kt + lo) = k4[it]; *(LAS u32x4*)(Vt + lo) = v4[it]; } }
    __syncthreads();
    const int lane = tid & 63, g = lane >> 4, c = lane & 15;
    bf16x8 qf[NQ][NK]; f32x4 O[NQ][ND]; float m[NQ], l[NQ];
#pragma unroll
    for (int qi = 0; qi < NQ; ++qi) { const size_t qtok = (size_t)((qpos0 + 16 * qi + c) * dil + r);
#pragma unroll
        for (int k = 0; k < NK; ++k) qf[qi][k] = *(const bf16x8*)(qb + qtok * ld + k * 32 + g * 8);
#pragma unroll
        for (int d = 0; d < ND; ++d) O[qi][d] = (f32x4){0.f, 0.f, 0.f, 0.f};
        m[qi] = m_init; l[qi] = (g == 0) ? l_init : 0.f; }
    const int krow_a = (c >> 2) * 8 + (c & 3), vrow_a = g * 8 + (c >> 2), vch = (c & 3) >> 1, vhalf = (c & 1) * 8;
    for (int kb = 0; kb < NB; ++kb) {
        const int R0 = wave_row_off + kb * 32;
        const int ra = R0 + krow_a, rb = ra + 4;
        bf16x8 ka[NK], kbf[NK];
#pragma unroll
        for (int k = 0; k < NK; ++k) { const int chunk = k * 4 + g;
            ka[k] = lds16(Kt + ra * ROWB + ((chunk ^ (ra & SWZ)) << 4)); kbf[k] = lds16(Kt + rb * ROWB + ((chunk ^ (rb & SWZ)) << 4)); }
        const int r0 = R0 + vrow_a, r1 = r0 + 4;
        bf16x8 vf[ND];
#pragma unroll
        for (int d = 0; d < ND; ++d) { const int chunk = d * 2 + vch;
            vf[d] = vtr8(Vt + r0 * ROWB + ((chunk ^ (r0 & SWZ)) << 4) + vhalf, Vt + r1 * ROWB + ((chunk ^ (r1 & SWZ)) << 4) + vhalf); }
        const int kp0 = ks + R0 + g * 8;
#pragma unroll
        for (int qi = 0; qi < NQ; ++qi) {
            const int qb0 = qpos0 + 16 * qi;
            if (NQ > 1 && !((ks + R0 + 31 >= qb0 - W) && (ks + R0 <= qb0 + 15 + W))) continue;
            const int qpos = qb0 + c;
            f32x4 s0 = (f32x4){0.f, 0.f, 0.f, 0.f}, s1 = s0;
#pragma unroll
            for (int k = 0; k < NK; ++k) { s0 = mfma16(ka[k], qf[qi][k], s0); s1 = mfma16(kbf[k], qf[qi][k], s1); }
            float sv[8]; float bm = -1e30f;
#pragma unroll
            for (int jj = 0; jj < 8; ++jj) { const int kp = kp0 + jj; const int dd = kp - qpos; const int ad = dd < 0 ? -dd : dd; const bool valid = (ad <= W) && (kp >= 0) && (kp < L);
                const float raw = jj < 4 ? s0[jj & 3] : s1[jj & 3];
                sv[jj] = valid ? raw * scale - slope * (float)ad : -1e30f; bm = fmaxf(bm, sv[jj]); }
            bm = fmaxf(bm, __shfl_xor(bm, 16)); bm = fmaxf(bm, __shfl_xor(bm, 32));
            const float m_new = fmaxf(m[qi], bm), alpha = __expf(m[qi] - m_new);
            float ps = 0.f;
#pragma unroll
            for (int jj = 0; jj < 8; ++jj) { sv[jj] = __expf(sv[jj] - m_new); ps += sv[jj]; }
            l[qi] = l[qi] * alpha + ps; m[qi] = m_new;
            u32x4 pw; pw.x = pk2(sv[0], sv[1]); pw.y = pk2(sv[2], sv[3]); pw.z = pk2(sv[4], sv[5]); pw.w = pk2(sv[6], sv[7]);
            const bf16x8 pf = __builtin_bit_cast(bf16x8, pw);
#pragma unroll
            for (int d = 0; d < ND; ++d) O[qi][d] = mfma16(vf[d], pf, O[qi][d] * alpha);
        }
    }
#pragma unroll
    for (int qi = 0; qi < NQ; ++qi) { const size_t qtok = (size_t)((qpos0 + 16 * qi + c) * dil + r);
        float lt = l[qi]; lt += __shfl_xor(lt, 16); lt += __shfl_xor(lt, 32);
        const float inv = 1.f / lt;
#pragma unroll
        for (int d = 0; d < ND; ++d) { u32x2 w; w.x = pk2(O[qi][d][0] * inv, O[qi][d][1] * inv); w.y = pk2(O[qi][d][2] * inv, O[qi][d][3] * inv); *(u32x2*)(ob + qtok * old + d * 16 + g * 4) = w; }
        if (lseb != nullptr && g == 0) lseb[qtok * 8] = m[qi] + __logf(lt); }
    __syncthreads();
}

__device__ __forceinline__ void xattn_unit(LAS unsigned char* lds, int tid, const bf16* __restrict__ qx, const bf16* __restrict__ kv, bf16* __restrict__ obuf, int u) {
    const int b = u >> 6, h = (u >> 4) & 3, qt = u & 15;
    const int lane = tid & 63, w = tid >> 6, g = lane >> 4, c = lane & 15;
    const size_t token = (size_t)b * SEQ + qt * 128 + 16 * w + c;
    const bf16* qrow = qx + token * DM + h * 512;
    const bf16* kbase = kv + (size_t)(b * MEMLEN) * 4096 + h * 512; const bf16* vbase = kbase + 2048;
    const int krow_a = (c >> 2) * 8 + (c & 3), vrow_a = g * 8 + (c >> 2), vch = (c & 3) >> 1, vhalf = (c & 1) * 8;
    int offK[2][4], offV[2][8];
#pragma unroll
    for (int t = 0; t < 2; ++t) { const int rk = krow_a + 4 * t, rv = vrow_a + 4 * t;
#pragma unroll
        for (int k = 0; k < 4; ++k) offK[t][k] = rk * 256 + (((k * 4 + g) ^ (rk & 15)) << 4);
#pragma unroll
        for (int d = 0; d < 8; ++d) offV[t][d] = rv * 256 + (((d * 2 + vch) ^ (rv & 15)) << 4) + vhalf; }
    f32x4 S[16];
#pragma unroll
    for (int i = 0; i < 16; ++i) S[i] = (f32x4){0.f, 0.f, 0.f, 0.f};
    for (int dc = 0; dc < 4; ++dc) {
        bf16x8 qf[4];
#pragma unroll
        for (int k = 0; k < 4; ++k) qf[k] = *(const bf16x8*)(qrow + dc * 128 + k * 32 + g * 8);
        for (int idx = tid; idx < 4096; idx += 512) { const int row = idx >> 4, ch = idx & 15;
            *(LAS u32x4*)(lds + row * 256 + ((ch ^ (row & 15)) << 4)) = *(const u32x4*)(kbase + (size_t)row * 4096 + dc * 128 + ch * 8); }
        __syncthreads();
#pragma unroll
        for (int kb = 0; kb < 8; ++kb) {
#pragma unroll
            for (int k = 0; k < 4; ++k) {
                S[kb * 2] = mfma16(lds16(lds + offK[0][k] + kb * 8192), qf[k], S[kb * 2]);
                S[kb * 2 + 1] = mfma16(lds16(lds + offK[1][k] + kb * 8192), qf[k], S[kb * 2 + 1]); }
            asm volatile("" : "+v"(S[kb * 2]), "+v"(S[kb * 2 + 1]) :: "memory"); }
        __syncthreads();
    }
    const float scale = 0.044194173824159216f;
    float mx = -1e30f;
#pragma unroll
    for (int i = 0; i < 16; ++i) { mx = fmaxf(mx, fmaxf(fmaxf(S[i][0], S[i][1]), fmaxf(S[i][2], S[i][3]))); }
    mx = fmaxf(mx, __shfl_xor(mx, 16)); mx = fmaxf(mx, __shfl_xor(mx, 32));
    float l = 0.f;
#pragma unroll
    for (int i = 0; i < 16; ++i)
#pragma unroll
        for (int j = 0; j < 4; ++j) { const float pv = __expf((S[i][j] - mx) * scale); S[i][j] = pv; l += pv; }
    l += __shfl_xor(l, 16); l += __shfl_xor(l, 32);
    const float inv = 1.f / l;
    bf16x8 pf[8];
#pragma unroll
    for (int kb = 0; kb < 8; ++kb) { u32x4 pw; pw.x = pk2(S[kb * 2][0], S[kb * 2][1]); pw.y = pk2(S[kb * 2][2], S[kb * 2][3]); pw.z = pk2(S[kb * 2 + 1][0], S[kb * 2 + 1][1]); pw.w = pk2(S[kb * 2 + 1][2], S[kb * 2 + 1][3]);
        pf[kb] = __builtin_bit_cast(bf16x8, pw); }
    for (int dc = 0; dc < 4; ++dc) {
        for (int idx = tid; idx < 4096; idx += 512) { const int row = idx >> 4, ch = idx & 15;
            *(LAS u32x4*)(lds + row * 256 + ((ch ^ (row & 15)) << 4)) = *(const u32x4*)(vbase + (size_t)row * 4096 + dc * 128 + ch * 8); }
        __syncthreads();
#pragma unroll
        for (int d = 0; d < 8; ++d) {
            f32x4 O = (f32x4){0.f, 0.f, 0.f, 0.f};
#pragma unroll
            for (int kb = 0; kb < 8; ++kb) O = mfma16(vtr8(lds + offV[0][d] + kb * 8192, lds + offV[1][d] + kb * 8192), pf[kb], O);
            u32x2 wv; wv.x = pk2(O[0] * inv, O[1] * inv); wv.y = pk2(O[2] * inv, O[3] * inv);
            *(u32x2*)(obuf + token * DM + h * 512 + dc * 128 + d * 16 + g * 4) = wv;
            asm volatile("" ::: "memory");
        }
        __syncthreads();
    }
}

constexpr int G_BCUM = 0, G_X1 = 65536, G_X2 = 98304, G_ZS = 131072, G_RED = 139264;
__device__ __forceinline__ void gla_gates(LAS unsigned char* lds, int tid, const bf16* __restrict__ proj, size_t tok0, int h, const float* __restrict__ Wf, const float* __restrict__ bf_,
                                          const float* __restrict__ Wb, const float* __restrict__ bb_) {
    if (tid < 256) { const int t = tid >> 2, part = tid & 3; const u32x4 v = *(const u32x4*)(proj + (tok0 + t) * LD_AB + 6144 + part * 8);
        LAS f32x4* zp = (LAS f32x4*)(lds + G_ZS + (t * 32 + part * 8) * 4);
        zp[0] = (f32x4){bflo(v.x), bfhi(v.x), bflo(v.y), bfhi(v.y)}; zp[1] = (f32x4){bflo(v.z), bfhi(v.z), bflo(v.w), bfhi(v.w)}; }
    __syncthreads();
    if (tid < 256) {
        const int dir = tid >> 7, kk = tid & 127; const float* Wg = dir ? Wb : Wf; const float* bg = dir ? bb_ : bf_;
        float w[16];
#pragma unroll
        for (int r = 0; r < 16; ++r) w[r] = Wg[r * 512 + h * 128 + kk];
        const float bias = bg[h * 128 + kk];
        float cum = 0.f; LAS float* bc = (LAS float*)(lds + G_BCUM) + dir * 8192 + kk; const LAS unsigned char* zs = lds + G_ZS + dir * 64;
        for (int s = 0; s < 64; ++s) { const int t = dir ? 63 - s : s;
            const LAS f32x4* z4 = (const LAS f32x4*)(zs + t * 128);
            const f32x4 z0 = z4[0], z1 = z4[1], z2 = z4[2], z3 = z4[3];
            float u = bias;
            u += z0[0] * w[0] + z0[1] * w[1] + z0[2] * w[2] + z0[3] * w[3];
            u += z1[0] * w[4] + z1[1] * w[5] + z1[2] * w[6] + z1[3] * w[7];
            u += z2[0] * w[8] + z2[1] * w[9] + z2[2] * w[10] + z2[3] * w[11];
            u += z3[0] * w[12] + z3[1] * w[13] + z3[2] * w[14] + z3[3] * w[15];
            const float ls = fminf(u, 0.f) - __logf(1.f + __expf(-fabsf(u)));
            cum += ls * 0.0625f; bc[t * 128] = cum; }
    }
    __syncthreads();
}
__device__ __forceinline__ void gla_stage_v(LAS unsigned char* vdst, int tid, const bf16* __restrict__ proj, size_t tok0, int h) {
    for (int idx = tid; idx < 2048; idx += 512) { const int row = idx >> 5, ch = idx & 31;
        *(LAS u32x4*)(vdst + row * 512 + ((ch ^ (row & 15)) << 4)) = *(const u32x4*)(proj + (tok0 + row) * LD_AB + 4096 + h * 256 + ch * 8); }
}
__device__ __forceinline__ void gla_stage1_unit(LAS unsigned char* lds, int tid, const bf16* __restrict__ proj, int item, const float* Wf, const float* bf_, const float* Wb, const float* bb_,
                                                bf16* __restrict__ St, float* __restrict__ Dd) {
    const int b = item >> 7, h = (item >> 5) & 3, cidx = item & 31; const size_t tok0 = (size_t)b * SEQ + cidx * 64;
    gla_gates(lds, tid, proj, tok0, h, Wf, bf_, Wb, bb_);
    {
        const int kk = tid & 127, jq = tid >> 7;
        const LAS float* bcf = (const LAS float*)(lds + G_BCUM) + kk; const LAS float* bcb = bcf + 8192;
        const float blf = bcf[63 * 128], blb = bcb[0];
#pragma unroll
        for (int cc = 0; cc < 2; ++cc) { const int jc = jq * 2 + cc; float of[8], obk[8];
#pragma unroll
            for (int e = 0; e < 8; ++e) { const int j = jc * 8 + e; const float kv = __uint_as_float((unsigned)proj[(tok0 + j) * LD_AB + 3584 + h * 128 + kk] << 16);
                of[e] = kv * __expf(blf - bcf[j * 128]); obk[e] = kv * __expf(blb - bcb[j * 128]); }
            const int lo = kk * 128 + ((jc ^ (kk & 7)) << 4);
            *(LAS u32x4*)(lds + G_X1 + lo) = (u32x4){pk2(of[0], of[1]), pk2(of[2], of[3]), pk2(of[4], of[5]), pk2(of[6], of[7])};
            *(LAS u32x4*)(lds + G_X1 + 16384 + lo) = (u32x4){pk2(obk[0], obk[1]), pk2(obk[2], obk[3]), pk2(obk[4], obk[5]), pk2(obk[6], obk[7])}; }
        if (tid < 128) { Dd[(size_t)item * 128 + kk] = __expf(blf); Dd[(size_t)(1024 + item) * 128 + kk] = __expf(blb); }
    }
    gla_stage_v(lds + G_X2, tid, proj, tok0, h);
    __syncthreads();
    const int lane = tid & 63, w = tid >> 6, g = lane >> 4, c = lane & 15;
    const int vrow_a = g * 8 + (c >> 2), vch = (c & 3) >> 1, vhalf = (c & 1) * 8;
#pragma unroll
    for (int dbi = 0; dbi < 2; ++dbi) { const int db = 2 * w + dbi; bf16x8 vf[2];
#pragma unroll
        for (int ksj = 0; ksj < 2; ++ksj) { const int r0 = ksj * 32 + vrow_a, r1 = r0 + 4, chunk = db * 2 + vch;
            vf[ksj] = vtr8(lds + G_X2 + r0 * 512 + ((chunk ^ (r0 & 15)) << 4) + vhalf, lds + G_X2 + r1 * 512 + ((chunk ^ (r1 & 15)) << 4) + vhalf); }
#pragma unroll
        for (int dir = 0; dir < 2; ++dir)
#pragma unroll
            for (int nb = 0; nb < 8; ++nb) { f32x4 acc = (f32x4){0.f, 0.f, 0.f, 0.f}; const int kk = nb * 16 + c;
#pragma unroll
                for (int ksj = 0; ksj < 2; ++ksj) acc = mfma16(vf[ksj], lds16(lds + G_X1 + dir * 16384 + kk * 128 + (((ksj * 4 + g) ^ (kk & 7)) << 4)), acc);
                bf16* sp = St + ((size_t)(dir * 1024 + item) * 256 + db * 16 + g * 4) * 128 + kk;
#ifdef DBG_ZERO_ST
                for (int j = 0; j < 4; ++j) sp[j * 128] = (bf16)0; }
#else
                for (int j = 0; j < 4; ++j) sp[j * 128] = (bf16)(pk2(acc[j], 0.f) & 0xffffu); }
#endif
    }
    __syncthreads();
}
__device__ __forceinline__ void gla_scan(bf16* __restrict__ St, const float* __restrict__ Dd, int gtid, int nthreads) {
    for (int wi = gtid; wi < 262144; wi += nthreads) {
        const int dir = wi >> 17, bh = (wi >> 12) & 31, e8 = wi & 4095, kk0 = (e8 * 8) & 127;
        float st[8];
#pragma unroll
        for (int e = 0; e < 8; ++e) st[e] = 0.f;
#pragma unroll 8
        for (int s = 0; s < 32; ++s) { const int cidx = dir ? 31 - s : s; const size_t it = (size_t)dir * 1024 + bh * 32 + cidx;
            u32x4* sp = (u32x4*)(St + it * 32768 + e8 * 8); const u32x4 uu = *sp;
            const f32x4 d0 = *(const f32x4*)(Dd + it * 128 + kk0), d1 = *(const f32x4*)(Dd + it * 128 + kk0 + 4);
            *sp = (u32x4){pk2(st[0], st[1]), pk2(st[2], st[3]), pk2(st[4], st[5]), pk2(st[6], st[7])};
            st[0] = d0[0] * st[0] + bflo(uu.x); st[1] = d0[1] * st[1] + bfhi(uu.x); st[2] = d0[2] * st[2] + bflo(uu.y); st[3] = d0[3] * st[3] + bfhi(uu.y);
            st[4] = d1[0] * st[4] + bflo(uu.z); st[5] = d1[1] * st[5] + bfhi(uu.z); st[6] = d1[2] * st[6] + bflo(uu.w); st[7] = d1[3] * st[7] + bfhi(uu.w); }
    }
}
__device__ __forceinline__ void gla_stage3_unit(LAS unsigned char* lds, int tid, const bf16* __restrict__ proj, int item, const float* Wf, const float* bf_, const float* Wb, const float* bb_,
                                                const bf16* __restrict__ St, const float* __restrict__ head_norm, bf16* __restrict__ obuf) {
    const int b = item >> 7, h = (item >> 5) & 3, cidx = item & 31; const size_t tok0 = (size_t)b * SEQ + cidx * 64;
    gla_gates(lds, tid, proj, tok0, h, Wf, bf_, Wb, bb_);
    const float qscale = 0.08838834764831845f;
    for (int task = tid; task < 1024; task += 512) { const int row = task >> 4, ch = task & 15;
        const u32x4 q8 = *(const u32x4*)(proj + (tok0 + row) * LD_AB + 3072 + h * 128 + ch * 8), k8 = *(const u32x4*)(proj + (tok0 + row) * LD_AB + 3584 + h * 128 + ch * 8);
        const LAS f32x4* bfp = (const LAS f32x4*)(lds + G_BCUM + (row * 128 + ch * 8) * 4); const LAS f32x4* bbp = (const LAS f32x4*)(lds + G_BCUM + 32768 + (row * 128 + ch * 8) * 4);
        const f32x4 f0 = bfp[0], f1 = bfp[1], b0 = bbp[0], b1 = bbp[1];
        const float qv[8] = {bflo(q8.x), bfhi(q8.x), bflo(q8.y), bfhi(q8.y), bflo(q8.z), bfhi(q8.z), bflo(q8.w), bfhi(q8.w)};
        const float kvv[8] = {bflo(k8.x), bfhi(k8.x), bflo(k8.y), bfhi(k8.y), bflo(k8.z), bfhi(k8.z), bflo(k8.w), bfhi(k8.w)};
        const float bfv[8] = {f0[0], f0[1], f0[2], f0[3], f1[0], f1[1], f1[2], f1[3]}, bbv[8] = {b0[0], b0[1], b0[2], b0[3], b1[0], b1[1], b1[2], b1[3]};
        float qgf[8], qgb[8], kdf[8], kdb[8];
#pragma unroll
        for (int e = 0; e < 8; ++e) { const float ef = __expf(bfv[e]), eb = __expf(bbv[e]); qgf[e] = qv[e] * qscale * ef; qgb[e] = qv[e] * qscale * eb; kdf[e] = kvv[e] / ef; kdb[e] = kvv[e] / eb; }
        const int lo = row * 256 + ((ch ^ (row & 15)) << 4);
        *(LAS u32x4*)(lds + G_X1 + lo) = (u32x4){pk2(qgf[0], qgf[1]), pk2(qgf[2], qgf[3]), pk2(qgf[4], qgf[5]), pk2(qgf[6], qgf[7])};
        *(LAS u32x4*)(lds + G_X1 + 16384 + lo) = (u32x4){pk2(qgb[0], qgb[1]), pk2(qgb[2], qgb[3]), pk2(qgb[4], qgb[5]), pk2(qgb[6], qgb[7])};
        *(LAS u32x4*)(lds + G_X2 + lo) = (u32x4){pk2(kdf[0], kdf[1]), pk2(kdf[2], kdf[3]), pk2(kdf[4], kdf[5]), pk2(kdf[6], kdf[7])};
        *(LAS u32x4*)(lds + G_X2 + 16384 + lo) = (u32x4){pk2(kdb[0], kdb[1]), pk2(kdb[2], kdb[3]), pk2(kdb[4], kdb[5]), pk2(kdb[6], kdb[7])}; }
    __syncthreads();
    gla_stage_v(lds + G_BCUM, tid, proj, tok0, h);
    __syncthreads();
    const int lane = tid & 63, w = tid >> 6, g = lane >> 4, c = lane & 15, ib = w & 3, dh = w >> 2;
    const int krow_a = (c >> 2) * 8 + (c & 3), vrow_a = g * 8 + (c >> 2), vch = (c & 3) >> 1, vhalf = (c & 1) * 8;
    bf16x8 qg[2][4];
#pragma unroll
    for (int dir = 0; dir < 2; ++dir)
#pragma unroll
        for (int k = 0; k < 4; ++k) qg[dir][k] = lds16(lds + G_X1 + dir * 16384 + (ib * 16 + c) * 256 + (((k * 4 + g) ^ c) << 4));
    bf16x8 pf[2];
#pragma unroll
    for (int jb = 0; jb < 2; ++jb) { const int ra = jb * 32 + krow_a, rb = ra + 4;
        f32x4 sf0 = (f32x4){0.f, 0.f, 0.f, 0.f}, sf1 = sf0, sb0 = sf0, sb1 = sf0;
#pragma unroll
        for (int k = 0; k < 4; ++k) { const int chunk = k * 4 + g; const int oa = ra * 256 + ((chunk ^ (ra & 15)) << 4), obb = rb * 256 + ((chunk ^ (rb & 15)) << 4);
            sf0 = mfma16(lds16(lds + G_X2 + oa), qg[0][k], sf0); sf1 = mfma16(lds16(lds + G_X2 + obb), qg[0][k], sf1);
            sb0 = mfma16(lds16(lds + G_X2 + 16384 + oa), qg[1][k], sb0); sb1 = mfma16(lds16(lds + G_X2 + 16384 + obb), qg[1][k], sb1); }
        float pv[8]; const int iidx = ib * 16 + c;
#pragma unroll
        for (int jj = 0; jj < 8; ++jj) { const int jidx = jb * 32 + g * 8 + jj; const float vf_ = jj < 4 ? sf0[jj & 3] : sf1[jj & 3], vb_ = jj < 4 ? sb0[jj & 3] : sb1[jj & 3]; pv[jj] = (jidx <= iidx) ? vf_ : vb_; }
        u32x4 pw; pw.x = pk2(pv[0], pv[1]); pw.y = pk2(pv[2], pv[3]); pw.z = pk2(pv[4], pv[5]); pw.w = pk2(pv[6], pv[7]);
        pf[jb] = __builtin_bit_cast(bf16x8, pw); }
    f32x4 O[8]; float ssq = 0.f;
#pragma unroll
    for (int d = 0; d < 8; ++d) { const int dvb = dh * 8 + d; f32x4 acc = (f32x4){0.f, 0.f, 0.f, 0.f};
#pragma unroll
        for (int jb = 0; jb < 2; ++jb) { const int r0 = jb * 32 + vrow_a, r1 = r0 + 4, chunk = dvb * 2 + vch;
            acc = mfma16(vtr8(lds + G_BCUM + r0 * 512 + ((chunk ^ (r0 & 15)) << 4) + vhalf, lds + G_BCUM + r1 * 512 + ((chunk ^ (r1 & 15)) << 4) + vhalf), pf[jb], acc); }
#ifndef DBG_NO_INTER
#pragma unroll
        for (int dir = 0; dir < 2; ++dir) { const bf16* sp = St + ((size_t)(dir * 1024 + item) * 256 + dvb * 16 + c) * 128 + g * 8;
#pragma unroll
            for (int k = 0; k < 4; ++k) acc = mfma16(*(const bf16x8*)(sp + k * 32), qg[dir][k], acc); }
#endif
        O[d] = acc; ssq += (acc[0] * acc[0] + acc[1] * acc[1]) + (acc[2] * acc[2] + acc[3] * acc[3]); }
    ssq += __shfl_xor(ssq, 16); ssq += __shfl_xor(ssq, 32);
    LAS float* red = (LAS float*)(lds + G_RED);
    if (g == 0) red[w * 16 + c] = ssq;
    __syncthreads();
    const float tot = red[w * 16 + c] + red[(w ^ 4) * 16 + c];
    const float rstd = rsqrtf(tot * (1.f / 256.f) + EPS);
    const size_t token = tok0 + ib * 16 + c;
#pragma unroll
    for (int d = 0; d < 8; ++d) { const int dv0 = (dh * 8 + d) * 16 + g * 4;
        const f32x4 hn = *(const f32x4*)(head_norm + h * 256 + dv0); const u32x2 r2 = *(const u32x2*)(proj + token * LD_AB + 5120 + h * 256 + dv0);
        const float rv[4] = {bflo(r2.x), bfhi(r2.x), bflo(r2.y), bfhi(r2.y)}; float ov[4];
#pragma unroll
        for (int j = 0; j < 4; ++j) ov[j] = O[d][j] * rstd * hn[j] * pg8::silu_f(rv[j]);
        u32x2 wv; wv.x = pk2(ov[0], ov[1]); wv.y = pk2(ov[2], ov[3]); *(u32x2*)(obuf + token * DM + 1024 + h * 256 + dv0) = wv; }
    __syncthreads();
}
__device__ __forceinline__ void combine_a(const bf16* __restrict__ oc, const float* __restrict__ lse, bf16* __restrict__ obuf, int gtid, int nthreads) {
#pragma unroll 4
    for (int task = gtid; task < MTOK * 128; task += nthreads) { const int token = task >> 7, h = (task >> 4) & 7, ch = task & 15;
        const float l0 = lse[(size_t)token * 8 + h], l1 = lse[(size_t)(MTOK + token) * 8 + h], l2 = lse[(size_t)(2 * MTOK + token) * 8 + h];
        const float mx = fmaxf(l0, fmaxf(l1, l2)); float w0 = __expf(l0 - mx), w1 = __expf(l1 - mx), w2 = __expf(l2 - mx); const float inv = 1.f / (w0 + w1 + w2); w0 *= inv; w1 *= inv; w2 *= inv;
        const size_t off = (size_t)token * 1024 + h * 128 + ch * 8;
        const u32x4 a = *(const u32x4*)(oc + off), bq = *(const u32x4*)(oc + (size_t)MTOK * 1024 + off), cq = *(const u32x4*)(oc + (size_t)2 * MTOK * 1024 + off);
        u32x4 o;
        o.x = pk2(w0 * bflo(a.x) + w1 * bflo(bq.x) + w2 * bflo(cq.x), w0 * bfhi(a.x) + w1 * bfhi(bq.x) + w2 * bfhi(cq.x));
        o.y = pk2(w0 * bflo(a.y) + w1 * bflo(bq.y) + w2 * bflo(cq.y), w0 * bfhi(a.y) + w1 * bfhi(bq.y) + w2 * bfhi(cq.y));
        o.z = pk2(w0 * bflo(a.z) + w1 * bflo(bq.z) + w2 * bflo(cq.z), w0 * bfhi(a.z) + w1 * bfhi(bq.z) + w2 * bfhi(cq.z));
        o.w = pk2(w0 * bflo(a.w) + w1 * bflo(bq.w) + w2 * bflo(cq.w), w0 * bfhi(a.w) + w1 * bfhi(bq.w) + w2 * bfhi(cq.w));
        *(u32x4*)(obuf + (size_t)token * DM + h * 128 + ch * 8) = o; }
}

#define XB_TMO      128
#define XB_XCNT(j)  (256  + 64 * (j))
#define XB_XSUB(j)  (1280 + 64 * (j))
#define XB_XGEN(j)  (2304 + 64 * (j))
#define XB_TOP      3328
#define XB_TOPGEN   3392
#define XCD_BAR_WORDS 3456
#define XB_SPIN_CAP (1u << 18)

__device__ __forceinline__ unsigned xb_ld(unsigned* p)              { return __hip_atomic_load(p, __ATOMIC_RELAXED, __HIP_MEMORY_SCOPE_AGENT); }
__device__ __forceinline__ unsigned xb_add(unsigned* p, unsigned v) { return __hip_atomic_fetch_add(p, v, __ATOMIC_RELAXED, __HIP_MEMORY_SCOPE_AGENT); }
__device__ __forceinline__ unsigned xb_xcc_id() { return (unsigned)__builtin_amdgcn_s_getreg((3 << 11) | 20) & 0xFu; }
#define XB_SPIN(cond, bar) do { unsigned _sp = 0; while (cond) { __builtin_amdgcn_s_sleep(1); \
    if ((++_sp & 255u) == 0u) { if (xb_ld(&(bar)[XB_TMO])) break; if (_sp > XB_SPIN_CAP) { atomicAdd(&(bar)[XB_TMO], 1u); break; } } } } while (0)

struct XcdBarrier {
    unsigned* bar; unsigned x;
    volatile LAS unsigned* st;
};

__device__ __forceinline__ XcdBarrier xcd_barrier_post(unsigned* bar, volatile LAS unsigned* st) {
    XcdBarrier b; b.bar = bar; b.x = xb_xcc_id(); b.st = st;
    if (threadIdx.x == 0) (void)xb_add(&bar[XB_XCNT(b.x)], 1u);
    return b;
}
__device__ __forceinline__ void xcd_barrier_complete(unsigned* bar, unsigned x, unsigned& nloc, unsigned& nx) {
    const unsigned G = gridDim.x * gridDim.y * gridDim.z;
    unsigned sum, cnt, mine, sp = 0u;
    for (;;) {
        sum = 0u; cnt = 0u; mine = 0u;
#pragma unroll
        for (unsigned j = 0; j < 16; ++j) { const unsigned c = xb_ld(&bar[XB_XCNT(j)]); sum += c; cnt += (c > 0u) ? 1u : 0u; mine = (j == x) ? c : mine; }
        if (sum == G) break;
        __builtin_amdgcn_s_sleep(1);
        if ((++sp & 255u) == 0u) { if (xb_ld(&bar[XB_TMO])) break; if (sp > XB_SPIN_CAP) { atomicAdd(&bar[XB_TMO], 1u); break; } }
    }
    nloc = mine > 0u ? mine : 1u; nx = cnt > 0u ? cnt : 1u;
}

__device__ __forceinline__ void xcd_barrier(const XcdBarrier& b) {
    asm volatile("s_waitcnt vmcnt(0)" ::: "memory");
    __syncthreads();
    if (threadIdx.x == 0) {
        unsigned* bar = b.bar;
        __builtin_amdgcn_s_waitcnt(0);
        unsigned nloc = b.st[0], nx = b.st[1];
        if (nloc == 0u) { xcd_barrier_complete(bar, b.x, nloc, nx); b.st[0] = nloc; b.st[1] = nx; }
        const unsigned old = xb_add(&bar[XB_XSUB(b.x)], 1u);
        const unsigned gen = old / nloc;
        if (old + 1u == (gen + 1u) * nloc) {
            __builtin_amdgcn_fence(__ATOMIC_RELEASE, "agent");
            asm volatile("s_waitcnt vmcnt(0)" ::: "memory");
            const unsigned og = xb_add(&bar[XB_TOP], 1u);
            const unsigned tg = og / nx;
            if (og + 1u == (tg + 1u) * nx) xb_add(&bar[XB_TOPGEN], 1u);
            else XB_SPIN(xb_ld(&bar[XB_TOPGEN]) == tg, bar);
            __builtin_amdgcn_fence(__ATOMIC_ACQUIRE, "agent");
            xb_add(&bar[XB_XGEN(b.x)], 1u);
            asm volatile("s_waitcnt vmcnt(0)" ::: "memory");
        } else {
            XB_SPIN(xb_ld(&bar[XB_XGEN(b.x)]) == gen, bar);
            __builtin_amdgcn_fence(__ATOMIC_ACQUIRE, "agent");
            asm volatile("s_waitcnt vmcnt(0)" ::: "memory");
        }
    }
    __syncthreads();
}

__device__ __forceinline__ void gsync_cg(cg::grid_group& grid) {
    asm volatile("s_waitcnt vmcnt(0) lgkmcnt(0)" ::: "memory");
    grid.sync();
    __builtin_amdgcn_fence(__ATOMIC_ACQUIRE, "agent");
    asm volatile("s_waitcnt vmcnt(0)" ::: "memory");
}
#define gsync(grid_) xcd_barrier(xbar)

__device__ __forceinline__ int fresh_tid() { int t = threadIdx.x; asm volatile("" : "+v"(t)); return t; }
#ifndef DBG_STOP
#define DBG_STOP 0
#endif
#define DBG_CHECK(k) do { if (DBG_STOP == (k)) { for (int m_ = gw; m_ < MTOK; m_ += ngw) norm_row(X + (size_t)m_ * DM, p.in[36], nullptr, X + (size_t)m_ * DM, fresh_tid() & 63); return true; } } while (0)
template <int layer>
__device__ __forceinline__ bool run_layer(const Params& p, LAS unsigned char* lds, cg::grid_group& grid, const XcdBarrier& xbar, int wave, int G, int bid, int gw, int ngw, int nthreads) {
    unsigned char* ws = p.ws;
    bf16* Hb = (bf16*)(ws + WS_H); bf16* PROJ = (bf16*)(ws + WS_PROJ); bf16* OBUF = (bf16*)(ws + WS_OBUF); bf16* OC = (bf16*)(ws + WS_OC); float* LSE = (float*)(ws + WS_LSE);
    bf16* ST = (bf16*)(ws + WS_ST); float* DD = (float*)(ws + WS_DD); bf16* KV = (bf16*)(ws + WS_KV);
    float* X = p.out;
        const float* g_mixnorm = layer == 0 ? p.in[5] : p.in[24]; const float* g_xn = layer == 0 ? p.in[13] : p.in[28]; const float* g_f2n = layer == 0 ? p.in[18] : p.in[33];
        { pg8::Gemm g{Hb, (const bf16*)(ws + WS_FF1IN), MTOK, 2 * DFF, DM}; pg8::StaticOrder S; S.init(MTOK, 2 * DFF, G, bid); pg8::EpiSwiglu E{PROJ, DFF};
          pg8::gemm_phase<pg8::EpiSwiglu, pg8::StaticOrder, true, true>(lds, g, S, E);
#ifdef EXP_DUP_FFNIN
          if (layer == 0) pg8::gemm_phase<pg8::EpiSwiglu, pg8::StaticOrder, true, true>(lds, g, S, E);
#endif
        }
        gsync(grid);
        { pg8::Gemm g{PROJ, (const bf16*)(ws + WS_FF1OUT), MTOK, DM, DFF}; pg8::StaticOrder S; S.init(MTOK, DM, G, bid); pg8::EpiResid E{layer == 0 ? p.in[0] : X, X, 0.5f};
          pg8::gemm_phase<pg8::EpiResid, pg8::StaticOrder, true, true>(lds, g, S, E); }
        gsync(grid);
        DBG_CHECK(layer * 4 + 1);
        norm_rows(X, g_mixnorm, Hb, MTOK, gw, ngw, fresh_tid() & 63);
#ifdef EXP_DUP_NORM
        norm_rows(X, g_mixnorm, Hb, MTOK, gw, ngw, fresh_tid() & 63);
        norm_rows(X, g_mixnorm, Hb, MTOK, gw, ngw, fresh_tid() & 63);
#endif
        gsync(grid);
        if (layer == 0) {
            { pg8::Gemm g{Hb, (const bf16*)(ws + WS_MIXIN), MTOK, LD_AB, DM}; pg8::StaticOrder S; S.init(MTOK, LD_AB, G, bid); pg8::EpiPlain E{PROJ, LD_AB};
              pg8::gemm_phase<pg8::EpiPlain, pg8::StaticOrder, true, true>(lds, g, S, E); }
            gsync(grid);
#ifdef EXP_DUP_MA
            for (int rep_ = 0; rep_ < 2; ++rep_) {
#else
            {
#endif
#ifndef DBG_NO_A
            { const int tid = fresh_tid();
            for (int u = bid; u < 3072; u += G) {
                const int cfg = u >> 10; int v = u & 1023; const int h = v & 7; v >>= 3; const int b = v >> 4, rest = v & 15;
                const int dil = cfg == 0 ? 1 : (cfg == 1 ? 4 : 16), tiles = 16 / dil, r = rest / tiles, tile = rest % tiles, L = SEQ / dil, q0 = tile * 128;
                const bf16* base = PROJ + (size_t)b * SEQ * LD_AB + h * 128;
                const float slope = exp2f(-(float)(h + 1)) * (float)dil;
                banded_unit<128, 5, 1, 272>(lds, tid, base, base + 1024, base + 2048, LD_AB, dil, r, L, q0 + 16 * wave, q0 - 64, 272, 16 * wave, 64, slope, 0.08838834764831845f, -1e30f, 0.f,
                                    OC + (size_t)cfg * MTOK * 1024 + (size_t)b * SEQ * 1024 + h * 128, 1024, LSE + (size_t)cfg * MTOK * 8 + (size_t)b * SEQ * 8 + h);
            } }
#endif
#ifndef DBG_NO_GLA
            { const int tid = fresh_tid(); for (int u = bid; u < 1024; u += G) gla_stage1_unit(lds, tid, PROJ, u, p.in[7], p.in[8], p.in[9], p.in[10], ST, DD); }
#endif
            }
            gsync(grid);
#if !defined(DBG_NO_GLA) && !defined(DBG_NO_SCAN)
            gla_scan(ST, DD, bid * 512 + fresh_tid(), nthreads);
#endif
            gsync(grid);
#ifdef EXP_DUP_MC
            for (int rep_ = 0; rep_ < 2; ++rep_) {
#else
            {
#endif
#ifndef DBG_NO_GLA
            { const int tid = fresh_tid(); for (int u = bid; u < 1024; u += G) gla_stage3_unit(lds, tid, PROJ, u, p.in[7], p.in[8], p.in[9], p.in[10], ST, p.in[11], OBUF); }
#else
            for (int t_ = bid * 512 + fresh_tid(); t_ < MTOK * 128; t_ += nthreads) *(u32x4*)(OBUF + (size_t)(t_ >> 7) * DM + 1024 + (t_ & 127) * 8) = (u32x4){0u, 0u, 0u, 0u};
#endif
#ifndef DBG_NO_A
            combine_a(OC, LSE, OBUF, bid * 512 + fresh_tid(), nthreads);
#else
            for (int t_ = bid * 512 + fresh_tid(); t_ < MTOK * 128; t_ += nthreads) *(u32x4*)(OBUF + (size_t)(t_ >> 7) * DM + (t_ & 127) * 8) = (u32x4){0u, 0u, 0u, 0u};
#endif
            }
            gsync(grid);
        } else {
            { pg8::Gemm g{Hb, (const bf16*)(ws + WS_MIXIN), MTOK, LD_C, DM}; pg8::StaticOrder S; S.init(MTOK, LD_C, G, bid); pg8::EpiPlain E{PROJ, LD_C};
              pg8::gemm_phase<pg8::EpiPlain, pg8::StaticOrder, true, true>(lds, g, S, E); }
            gsync(grid);
#ifdef EXP_DUP_C
            for (int rep_ = 0; rep_ < 2; ++rep_)
#endif
            { const int tid = fresh_tid();
            for (int u = bid; u < 1024; u += G) {
                const int qt = u & 31, gk = (u >> 5) & 3, b = u >> 7, head = gk * 8 + wave;
                const bf16* base = PROJ + (size_t)b * SEQ * LD_C;
                banded_unit<64, 10, 4, 320>(lds, tid, base + head * 64, base + 2048 + gk * 64, base + 2304 + gk * 64, LD_C, 1, 0, SEQ, qt * 64, qt * 64 - 128, 320, 0, 128,
                                   exp2f(-0.25f * (float)(head + 1)), 0.125f, p.in[26][head], 1.f, OBUF + (size_t)b * SEQ * DM + head * 64, DM, nullptr);
            } }
            gsync(grid);
        }
        { pg8::Gemm g{OBUF, (const bf16*)(ws + WS_MIXOUT), MTOK, DM, DM}; pg8::StaticOrder S; S.init(MTOK, DM, G, bid); pg8::EpiResid E{X, X, 1.0f};
          pg8::gemm_phase<pg8::EpiResid, pg8::StaticOrder, true, true>(lds, g, S, E); }
        gsync(grid);
        DBG_CHECK(layer * 4 + 2);
        norm_rows(X, g_xn, Hb, MTOK, gw, ngw, fresh_tid() & 63);
        gsync(grid);
        { pg8::Gemm g{Hb, (const bf16*)(ws + WS_WQ), MTOK, DM, DM}; pg8::StaticOrder S; S.init(MTOK, DM, G, bid); pg8::EpiPlain E{PROJ, DM};
          pg8::gemm_phase<pg8::EpiPlain, pg8::StaticOrder, true, true>(lds, g, S, E); }
        gsync(grid);
        { const int tid = fresh_tid(); for (int u = bid; u < 512; u += G) xattn_unit(lds, tid, PROJ, KV + (size_t)layer * NBATCH * MEMLEN * 4096, OBUF, u); }
#ifdef EXP_DUP_XATTN
        { const int tid = fresh_tid(); for (int u = bid; u < 512; u += G) xattn_unit(lds, tid, PROJ, KV + (size_t)layer * NBATCH * MEMLEN * 4096, OBUF, u); }
#endif
        gsync(grid);
        { pg8::Gemm g{OBUF, (const bf16*)(ws + WS_WO), MTOK, DM, DM}; pg8::StaticOrder S; S.init(MTOK, DM, G, bid); pg8::EpiResid E{X, X, 1.0f};
          pg8::gemm_phase<pg8::EpiResid, pg8::StaticOrder, true, true>(lds, g, S, E); }
        gsync(grid);
        DBG_CHECK(layer * 4 + 3);
        norm_rows(X, g_f2n, Hb, MTOK, gw, ngw, fresh_tid() & 63);
        gsync(grid);
        { pg8::Gemm g{Hb, (const bf16*)(ws + WS_FF2IN), MTOK, 2 * DFF, DM}; pg8::StaticOrder S; S.init(MTOK, 2 * DFF, G, bid); pg8::EpiSwiglu E{PROJ, DFF};
          pg8::gemm_phase<pg8::EpiSwiglu, pg8::StaticOrder, true, true>(lds, g, S, E); }
        gsync(grid);
        { pg8::Gemm g{PROJ, (const bf16*)(ws + WS_FF2OUT), MTOK, DM, DFF}; pg8::StaticOrder S; S.init(MTOK, DM, G, bid); pg8::EpiResid E{X, X, 0.5f};
          pg8::gemm_phase<pg8::EpiResid, pg8::StaticOrder, true, true>(lds, g, S, E); }
        gsync(grid);
        DBG_CHECK(layer * 4 + 4);
        if (layer == 0) {
            convert_weights<1>(p, lds, gw, ngw, wave, fresh_tid() & 63);
            norm_rows(X, p.in[21], Hb, MTOK, gw, ngw, fresh_tid() & 63);
            gsync(grid);
        } else {
            const int ftl = fresh_tid() & 63;
            int m = gw;
            for (; m + ngw < MTOK; m += 2 * ngw) norm_row2(X + (size_t)m * DM, X + (size_t)(m + ngw) * DM, p.in[36], nullptr, nullptr, X + (size_t)m * DM, X + (size_t)(m + ngw) * DM, ftl);
            for (; m < MTOK; m += ngw) norm_row(X + (size_t)m * DM, p.in[36], nullptr, X + (size_t)m * DM, ftl);
        }
    return false;
}

__global__ void __launch_bounds__(512, 2) mega_fwd(Params p) {
    extern __shared__ __attribute__((aligned(16))) unsigned char lds_raw[];
    LAS unsigned char* lds = (LAS unsigned char*)lds_raw;
    cg::grid_group grid = cg::this_grid();
    volatile LAS unsigned* xst = (volatile LAS unsigned*)(lds + LDS_BYTES - 64);
    if (threadIdx.x == 0) { xst[0] = 0u; xst[1] = 0u; }
    __syncthreads();
    const XcdBarrier xbar = xcd_barrier_post((unsigned*)(p.ws + WS_CTL), xst);
    const int wave = __builtin_amdgcn_readfirstlane((int)threadIdx.x >> 6);
    const int G = gridDim.x, bid = blockIdx.x, gw = bid * 8 + wave, ngw = G * 8, nthreads = G * 512;
    unsigned char* ws = p.ws;
    bf16* Hb = (bf16*)(ws + WS_H); bf16* PROJ = (bf16*)(ws + WS_PROJ); bf16* OBUF = (bf16*)(ws + WS_OBUF); bf16* OC = (bf16*)(ws + WS_OC); float* LSE = (float*)(ws + WS_LSE);
    bf16* ST = (bf16*)(ws + WS_ST); float* DD = (float*)(ws + WS_DD); bf16* KV = (bf16*)(ws + WS_KV); bf16* MEMH = (bf16*)(ws + WS_MEMH);
    float* X = p.out;

    convert_weights<0>(p, lds, gw, ngw, wave, fresh_tid() & 63);
#ifdef EXP_DUP_CONVERT
    convert_weights<0>(p, lds, gw, ngw, wave, fresh_tid() & 63);
#endif
#ifdef EXP_SYNCS
    for (int i_ = 0; i_ < 20; ++i_) gsync(grid);
#endif
    norm_rows(p.in[1], p.in[14], MEMH, NBATCH * MEMLEN, gw, ngw, fresh_tid() & 63);
    norm_rows(p.in[1], p.in[29], MEMH + (size_t)NBATCH * MEMLEN * DM, NBATCH * MEMLEN, gw, ngw, fresh_tid() & 63);
    norm_rows(p.in[0], p.in[2], Hb, MTOK, gw, ngw, fresh_tid() & 63);
    gsync_cg(grid);
    {
        pg8::Gemm g0{MEMH, (const bf16*)(ws + WS_WKV0), NBATCH * MEMLEN, 4096, DM}; pg8::StaticOrder S0; S0.init(NBATCH * MEMLEN, 4096, G, bid);
        pg8::EpiPlain E0{KV, 4096};
        pg8::gemm_phase<pg8::EpiPlain, pg8::StaticOrder, true, true>(lds, g0, S0, E0);
        pg8::Gemm g1{MEMH + (size_t)NBATCH * MEMLEN * DM, (const bf16*)(ws + WS_WKV1), NBATCH * MEMLEN, 4096, DM}; pg8::StaticOrder S1; S1.init(NBATCH * MEMLEN, 4096, G, (bid + G / 2) % G);
        pg8::EpiPlain E1{KV + (size_t)NBATCH * MEMLEN * 4096, 4096};
        pg8::gemm_phase<pg8::EpiPlain, pg8::StaticOrder, true, true>(lds, g1, S1, E1);
    }
    if (run_layer<0>(p, lds, grid, xbar, wave, G, bid, gw, ngw, nthreads)) return;
    if (run_layer<1>(p, lds, grid, xbar, wave, G, bid, gw, ngw, nthreads)) return;
}

extern "C" void kernel_launch(void* const* d_in, const int* in_sizes, int n_in, void* d_out, int out_size, void* d_ws, size_t ws_size, hipStream_t stream) {
    static int grid = 0;
    if (grid == 0) {
        if (n_in != 37 || out_size != MTOK * DM || ws_size < WS_END) { fprintf(stderr, "kernel_launch: unexpected shapes (n_in %d out %d ws %zu)\n", n_in, out_size, ws_size); grid = -1; return; }
        int dev = 0, cus = 0, per_cu = 0;
        hipGetDevice(&dev);
        hipDeviceGetAttribute(&cus, hipDeviceAttributeMultiprocessorCount, dev);
        hipFuncSetAttribute((const void*)mega_fwd, hipFuncAttributeMaxDynamicSharedMemorySize, LDS_BYTES);
        if (hipOccupancyMaxActiveBlocksPerMultiprocessor(&per_cu, (const void*)mega_fwd, 512, LDS_BYTES) != hipSuccess || per_cu < 1) per_cu = 1;
        (void)hipGetLastError();
        grid = cus * per_cu;
    }
    if (grid < 0) return;
    if (hipMemsetAsync((char*)d_ws + WS_CTL, 0, 16384, stream) != hipSuccess) { fprintf(stderr, "kernel_launch: memset of the barrier words failed\n"); return; }
    Params p{};
    for (int i = 0; i < 37; ++i) p.in[i] = (const float*)d_in[i];
    p.out = (float*)d_out; p.ws = (unsigned char*)d_ws;
    void* args[] = {&p};
    hipError_t e = hipLaunchCooperativeKernel((const void*)mega_fwd, dim3(grid), dim3(512), args, LDS_BYTES, stream);
    if (e != hipSuccess) fprintf(stderr, "cooperative launch failed: %s (grid %d)\n", hipGetErrorString(e), grid);
}
```

```cpp
#include <hip/hip_runtime.h>
#include <hip/hip_cooperative_groups.h>
#include <cstdio>
#include <cstdint>
namespace cg = cooperative_groups;
namespace pg8 {
#define PG8_LAS __attribute__((address_space(3)))
typedef unsigned short bf16_t;
typedef short bf16x8 __attribute__((ext_vector_type(8)));
typedef float f32x4 __attribute__((ext_vector_type(4)));
typedef unsigned u32x4 __attribute__((ext_vector_type(4)));
constexpr int BM = 256, BK = 64, HALF = 128, HTB = HALF * BK * 2  , STAGE_BYTES = 8 * HTB, NXCD = 8, WGM = 8;

__host__ __device__ __forceinline__ int lds_byte(int r, int c) { const int st = (r >> 4) * 2 + (c >> 5), rr = r & 15, cc = c & 31, ob = rr * 64 + cc * 2; return st * 1024 + (ob ^ (((ob >> 9) & 1) << 5)); }
__host__ __device__ __forceinline__ void stage_rc(int b, int& R, int& C) { const int st = b / 1024, sb = b % 1024, swz = sb ^ (((sb >> 9) & 1) << 5); R = (st >> 1) * 16 + swz / 64; C = (st & 1) * 32 + (swz % 64) / 2; }
__host__ __device__ __forceinline__ int perm32(int rho) { const int n = rho >> 4, i = rho & 15; return 8 * (i >> 2) + 4 * n + (i & 3); }

struct Unit { int pm, pn; };
struct Gemm { const bf16_t* A; const bf16_t* Bt; int M, N, K; };

struct StaticOrder {
    int nM, nN, nwg, G, c;
    __host__ __device__ void init(int M, int N, int G_, int c_) { nM = M / BM; nN = N / BM; nwg = nM * nN; G = G_; c = c_; }
    __host__ __device__ bool next(int i, Unit& u) const {
        const long L = (long)i * G + c; if (L >= nwg) return false;
        int wgid = (int)L; { const int q = nwg / NXCD, r = nwg % NXCD, xcd = wgid % NXCD, off = wgid / NXCD; wgid = (xcd < r ? xcd * (q + 1) : r * (q + 1) + (xcd - r) * q) + off; }
        const int nig = WGM * nN, gid = wgid / nig, fm = gid * WGM, gsz = (nM - fm) < WGM ? (nM - fm) : WGM;
        u.pm = fm + ((wgid % nig) % gsz); u.pn = (wgid % nig) / gsz; return true;
    }
    __device__ __forceinline__ void a_ready(const Unit&) const {}
    __device__ __forceinline__ void done(const Unit&) const {}
};

typedef float f32x2_cv __attribute__((ext_vector_type(2))); typedef __bf16 bf16x2_cv __attribute__((ext_vector_type(2)));
__device__ __forceinline__ unsigned cvt_pk_bf16(float lo, float hi) { const f32x2_cv v = {lo, hi}; const bf16x2_cv b = __builtin_convertvector(v, bf16x2_cv); return __builtin_bit_cast(unsigned, b); }
template <class Epi, class Sched, bool ALIGN_EPI = false, bool SP2 = false>
__device__ __forceinline__ void gemm_phase(PG8_LAS unsigned char* lds, const Gemm g, const Sched& S, const Epi& E) {
    int tid_l = threadIdx.x; asm volatile("" : "+v"(tid_l));
    const int tid = tid_l, wid = __builtin_amdgcn_readfirstlane(tid >> 6), lane = tid & 63, wr = wid >> 2, wc = wid & 3, fr = lane & 15, fq = lane >> 4;
    const int K = g.K, nt = K / BK;
    unsigned voffA[2], voffB[2];
#pragma unroll
    for (int i = 0; i < 2; ++i) { int R, C; stage_rc(tid * 16 + i * 8192, R, C); const int Rb = Epi::PERM ? ((R & ~31) + perm32(R & 31)) : R;
        voffA[i] = (unsigned)(R * K + C) * 2u; voffB[i] = (unsigned)(Rb * K + C) * 2u; }
    const size_t kstep = (size_t)(BK * 2);
    const size_t hstep = (size_t)HALF * K * 2;
    const size_t tstep = 2 * hstep;
    const unsigned ldsw = (unsigned)wid * 1024u;
    const int aoff = lds_byte(wr * 64 + fr, fq * 8), boff = lds_byte(wc * 32 + fr, fq * 8);
#define PG8_SA(b, h) (((b) * 2 + (h)) * HTB)
#define PG8_SB(b, h) ((4 + (b) * 2 + (h)) * HTB)
#define PG8_STAGE(bufoff, gbase, voff) do { _Pragma("unroll") for (int _i = 0; _i < 2; ++_i) \
        __builtin_amdgcn_global_load_lds((const unsigned*)((const char*)(gbase) + (voff)[_i]), (PG8_LAS unsigned*)(lds + (bufoff) + ldsw + _i * 8192), 16, 0, 0); } while (0)
#define PG8_LDA(dst, b, h) do { _Pragma("unroll") for (int m = 0; m < 4; ++m) _Pragma("unroll") for (int k = 0; k < 2; ++k) dst[m][k] = *(const PG8_LAS bf16x8*)(lds + PG8_SA(b, h) + aoff + m * 2048 + k * 1024); } while (0)
#define PG8_LDB(dst, b, h) do { _Pragma("unroll") for (int n = 0; n < 2; ++n) _Pragma("unroll") for (int k = 0; k < 2; ++k) dst[n][k] = *(const PG8_LAS bf16x8*)(lds + PG8_SB(b, h) + boff + n * 2048 + k * 1024); } while (0)
#define PG8_MMA(ai, bj, At, Bt) do { __builtin_amdgcn_s_setprio(1); _Pragma("unroll") for (int m = 0; m < 4; ++m) _Pragma("unroll") for (int n = 0; n < 2; ++n) _Pragma("unroll") for (int k = 0; k < 2; ++k) \
        acc[ai][bj][m][n] = __builtin_amdgcn_mfma_f32_16x16x32_bf16(Bt[n][k], At[m][k], acc[ai][bj][m][n], 0, 0, 0); __builtin_amdgcn_s_setprio(0); } while (0)
#define PG8_WAIT_V(n) asm volatile("s_waitcnt vmcnt(" #n ")" ::: "memory")
#define PG8_WAIT_L(n) asm volatile("s_waitcnt lgkmcnt(" #n ")" ::: "memory")
#define PG8_BAR __builtin_amdgcn_s_barrier()
#define PG8_SCHED __builtin_amdgcn_sched_barrier(0)
    Unit cur, nxt; int ui = 0;
    if (!S.next(0, cur)) return;
    f32x4 acc[2][2][4][2];
#pragma unroll
    for (int a = 0; a < 2; ++a)
#pragma unroll
        for (int b = 0; b < 2; ++b)
#pragma unroll
            for (int m = 0; m < 4; ++m)
#pragma unroll
                for (int n = 0; n < 2; ++n) acc[a][b][m][n] = (f32x4){0.f, 0.f, 0.f, 0.f};
    bf16x8 At[4][2], B0[2][2], B1[2][2];
    const char* cA = (const char*)g.A + (size_t)cur.pm * tstep; const char* cB = (const char*)g.Bt + (size_t)cur.pn * tstep;
    S.a_ready(cur);
    if constexpr (SP2) {
        PG8_STAGE(PG8_SB(0, 0), cB, voffB); PG8_STAGE(PG8_SB(0, 1), cB + hstep, voffB); PG8_STAGE(PG8_SA(0, 0), cA, voffA); PG8_STAGE(PG8_SA(0, 1), cA + hstep, voffA);
        if (wr == 1) PG8_BAR;
        PG8_WAIT_V(2); PG8_BAR;
        PG8_STAGE(PG8_SB(1, 0), cB + kstep, voffB); PG8_STAGE(PG8_SA(1, 0), cA + kstep, voffA); PG8_STAGE(PG8_SB(1, 1), cB + hstep + kstep, voffB);
        PG8_WAIT_V(6); PG8_BAR;
    } else {
        PG8_STAGE(PG8_SB(0, 0), cB, voffB); PG8_STAGE(PG8_SA(0, 0), cA, voffA); PG8_STAGE(PG8_SB(0, 1), cB + hstep, voffB); PG8_STAGE(PG8_SA(0, 1), cA + hstep, voffA);
        if (wr == 1) PG8_BAR;
        PG8_WAIT_V(4); PG8_BAR;
        PG8_STAGE(PG8_SB(1, 0), cB + kstep, voffB); PG8_STAGE(PG8_SA(1, 0), cA + kstep, voffA); PG8_STAGE(PG8_SB(1, 1), cB + hstep + kstep, voffB);
        PG8_WAIT_V(6); PG8_BAR;
    }
    for (;;) {
        const bool has_next = S.next(ui + 1, nxt);
        const char* nA = has_next ? (const char*)g.A + (size_t)nxt.pm * tstep : cA; const char* nB = has_next ? (const char*)g.Bt + (size_t)nxt.pn * tstep : cB;
        for (int t = 0; t < nt; t += 2) {
            const bool last = (t == nt - 2);
            const char* a1 = cA + (size_t)(t + 1) * kstep;
            const char* a2 = last ? nA : cA + (size_t)(t + 2) * kstep; const char* b2 = last ? nB : cB + (size_t)(t + 2) * kstep;
            const char* a3 = a2 + kstep; const char* b3 = b2 + kstep;
            if (last && has_next) S.a_ready(nxt);
            if constexpr (SP2) {
            PG8_LDB(B0, 0, 0); PG8_LDB(B1, 0, 1); PG8_SCHED; PG8_LDA(At, 0, 0); PG8_STAGE(PG8_SA(1, 1), a1 + hstep, voffA);
            PG8_WAIT_V(8); PG8_WAIT_L(0); PG8_BAR; PG8_MMA(0, 0, At, B0); PG8_MMA(0, 1, At, B1); PG8_BAR; PG8_SCHED;
            PG8_LDA(At, 0, 1); PG8_STAGE(PG8_SB(0, 0), b2, voffB); PG8_STAGE(PG8_SB(0, 1), b2 + hstep, voffB); PG8_STAGE(PG8_SA(0, 0), a2, voffA);
            PG8_WAIT_V(8); PG8_WAIT_L(0); PG8_BAR; PG8_MMA(1, 0, At, B0); PG8_MMA(1, 1, At, B1); PG8_BAR; PG8_SCHED;
            PG8_LDB(B0, 1, 0); PG8_LDB(B1, 1, 1); PG8_SCHED; PG8_LDA(At, 1, 0); PG8_STAGE(PG8_SA(0, 1), a2 + hstep, voffA);
            PG8_WAIT_V(8); PG8_WAIT_L(0); PG8_BAR; PG8_MMA(0, 0, At, B0); PG8_MMA(0, 1, At, B1); PG8_BAR; PG8_SCHED;
            PG8_LDA(At, 1, 1); PG8_STAGE(PG8_SB(1, 0), b3, voffB); PG8_STAGE(PG8_SB(1, 1), b3 + hstep, voffB); PG8_STAGE(PG8_SA(1, 0), a3, voffA);
            PG8_WAIT_V(8); PG8_WAIT_L(0); PG8_BAR; PG8_MMA(1, 0, At, B0); PG8_MMA(1, 1, At, B1); PG8_BAR; PG8_SCHED;
            } else {
            PG8_LDB(B0, 0, 0); PG8_SCHED; PG8_LDA(At, 0, 0); PG8_STAGE(PG8_SA(1, 1), a1 + hstep, voffA);
            PG8_WAIT_L(8); PG8_BAR; PG8_WAIT_L(0); PG8_MMA(0, 0, At, B0); PG8_BAR; PG8_SCHED;
            PG8_LDB(B1, 0, 1); PG8_STAGE(PG8_SB(0, 0), b2, voffB);
            PG8_BAR; PG8_WAIT_L(0); PG8_MMA(0, 1, At, B1); PG8_BAR;
            PG8_LDA(At, 0, 1); PG8_STAGE(PG8_SA(0, 0), a2, voffA);
            PG8_BAR; PG8_WAIT_L(0); PG8_MMA(1, 0, At, B0); PG8_BAR; PG8_SCHED;
            PG8_STAGE(PG8_SB(0, 1), b2 + hstep, voffB);
            PG8_WAIT_V(6); PG8_BAR; PG8_MMA(1, 1, At, B1); PG8_BAR;
            PG8_LDB(B0, 1, 0); PG8_SCHED; PG8_LDA(At, 1, 0); PG8_STAGE(PG8_SA(0, 1), a2 + hstep, voffA);
            PG8_WAIT_L(8); PG8_BAR; PG8_WAIT_L(0); PG8_MMA(0, 0, At, B0); PG8_BAR; PG8_SCHED;
            PG8_LDB(B1, 1, 1); PG8_STAGE(PG8_SB(1, 0), b3, voffB);
            PG8_BAR; PG8_WAIT_L(0); PG8_MMA(0, 1, At, B1); PG8_BAR;
            PG8_LDA(At, 1, 1); PG8_STAGE(PG8_SA(1, 0), a3, voffA);
            PG8_BAR; PG8_WAIT_L(0); PG8_MMA(1, 0, At, B0); PG8_BAR; PG8_SCHED;
            PG8_STAGE(PG8_SB(1, 1), b3 + hstep, voffB);
            PG8_WAIT_V(6); PG8_BAR; PG8_MMA(1, 1, At, B1); PG8_BAR;
            }
        }
        if constexpr (ALIGN_EPI) { if (wr == 0) PG8_BAR; }
        if constexpr (!Epi::AFTER_DRAIN) { E(acc, cur, wr, wc, fr, fq); S.done(cur); }
        if (!has_next) break;
#pragma unroll
        for (int a = 0; a < 2; ++a)
#pragma unroll
            for (int b = 0; b < 2; ++b)
#pragma unroll
                for (int m = 0; m < 4; ++m)
#pragma unroll
                    for (int n = 0; n < 2; ++n) acc[a][b][m][n] = (f32x4){0.f, 0.f, 0.f, 0.f};
        cur = nxt; cA = nA; cB = nB; ++ui;
        if constexpr (ALIGN_EPI) { if (wr == 1) PG8_BAR; }
    }
    PG8_WAIT_V(0);
    if constexpr (!ALIGN_EPI) { if (wr == 0) PG8_BAR; }
    PG8_BAR;
    if constexpr (Epi::AFTER_DRAIN) { E.fused(acc, cur, wr, wc, fr, fq, lds, wid, lane); S.done(cur); }
#undef PG8_SA
#undef PG8_SB
#undef PG8_STAGE
#undef PG8_LDA
#undef PG8_LDB
#undef PG8_MMA
#undef PG8_WAIT_V
#undef PG8_WAIT_L
#undef PG8_BAR
#undef PG8_SCHED
}
}

namespace pg8 {
struct EpiPlain {
    static constexpr bool PERM = true, AFTER_DRAIN = false;
    bf16_t* O; int ldc; const float* ssq;
    __device__ __forceinline__ void operator()(const f32x4 (&acc)[2][2][4][2], const Unit& u, int wr, int wc, int fr, int fq) const {
        const int row0 = u.pm * BM + wr * 64 + fr, col0 = u.pn * BM + wc * 32 + 8 * fq;
#pragma unroll
        for (int ai = 0; ai < 2; ++ai)
#pragma unroll
            for (int m = 0; m < 4; ++m) { const int row = row0 + ai * HALF + m * 16; bf16_t* rowp = O + (size_t)row * ldc + col0;
                float rs = 1.f; if (ssq) { const f32x4 p0 = *(const f32x4*)(ssq + (size_t)row * 8), p1 = *(const f32x4*)(ssq + (size_t)row * 8 + 4); rs = rsqrtf((((p0[0] + p0[1]) + (p0[2] + p0[3])) + ((p1[0] + p1[1]) + (p1[2] + p1[3]))) * (1.f / 2048.f) + 1e-6f); }
#pragma unroll
                for (int bj = 0; bj < 2; ++bj) { const f32x4 v0 = acc[ai][bj][m][0] * rs, v1 = acc[ai][bj][m][1] * rs;
                    u32x4 w; w.x = cvt_pk_bf16(v0[0], v0[1]); w.y = cvt_pk_bf16(v0[2], v0[3]); w.z = cvt_pk_bf16(v1[0], v1[1]); w.w = cvt_pk_bf16(v1[2], v1[3]);
                    *(u32x4*)(rowp + bj * HALF) = w; } }
    }
};
__device__ __forceinline__ float silu_f(float x) { return x * __builtin_amdgcn_rcpf(1.f + __builtin_amdgcn_exp2f(x * -1.4426950408889634f)); }
struct EpiSwiglu {
    static constexpr bool PERM = true, AFTER_DRAIN = false;
    bf16_t* O; int ldc; const float* ssq;
    __device__ __forceinline__ void operator()(const f32x4 (&acc)[2][2][4][2], const Unit& u, int wr, int wc, int fr, int fq) const {
        const int row0 = u.pm * BM + wr * 64 + fr, col0 = u.pn * HALF + wc * 32 + 8 * fq;
#pragma unroll
        for (int ai = 0; ai < 2; ++ai)
#pragma unroll
            for (int m = 0; m < 4; ++m) { const int row = row0 + ai * HALF + m * 16; bf16_t* rowp = O + (size_t)row * ldc + col0;
                const f32x4 p0 = *(const f32x4*)(ssq + (size_t)row * 8), p1 = *(const f32x4*)(ssq + (size_t)row * 8 + 4); const float rs = rsqrtf((((p0[0] + p0[1]) + (p0[2] + p0[3])) + ((p1[0] + p1[1]) + (p1[2] + p1[3]))) * (1.f / 2048.f) + 1e-6f);
                const f32x4 g0 = acc[ai][0][m][0] * rs, g1 = acc[ai][0][m][1] * rs, u0 = acc[ai][1][m][0] * rs, u1 = acc[ai][1][m][1] * rs;
                u32x4 w;
                w.x = cvt_pk_bf16(silu_f(g0[0]) * u0[0], silu_f(g0[1]) * u0[1]); w.y = cvt_pk_bf16(silu_f(g0[2]) * u0[2], silu_f(g0[3]) * u0[3]);
                w.z = cvt_pk_bf16(silu_f(g1[0]) * u1[0], silu_f(g1[1]) * u1[1]); w.w = cvt_pk_bf16(silu_f(g1[2]) * u1[2], silu_f(g1[3]) * u1[3]);
                *(u32x4*)rowp = w; }
    }
};
template <bool HALF_ALPHA, bool F32OUT> struct EpiResid {
    static constexpr bool PERM = true, AFTER_DRAIN = false;
    bf16_t* xb; float* fout; float* ssqp; PG8_LAS float* red;
    __device__ __forceinline__ void operator()(const f32x4 (&acc)[2][2][4][2], const Unit& u, int wr, int wc, int fr, int fq) const {
        const int col0 = u.pn * BM + wc * 32 + 8 * fq; const float alpha = HALF_ALPHA ? 0.5f : 1.0f;
#pragma unroll
        for (int ai = 0; ai < 2; ++ai)
#pragma unroll
            for (int m = 0; m < 4; ++m) { const int rl = ai * HALF + wr * 64 + m * 16 + fr; const size_t off = (size_t)(u.pm * BM + rl) * 2048 + col0; float sq = 0.f;
#pragma unroll
                for (int bj = 0; bj < 2; ++bj) { const size_t o = off + bj * HALF; const u32x4 bw = *(const u32x4*)(xb + o);
                    const f32x4 b0 = {__uint_as_float(bw.x << 16), __uint_as_float(bw.x & 0xffff0000u), __uint_as_float(bw.y << 16), __uint_as_float(bw.y & 0xffff0000u)};
                    const f32x4 b1 = {__uint_as_float(bw.z << 16), __uint_as_float(bw.z & 0xffff0000u), __uint_as_float(bw.w << 16), __uint_as_float(bw.w & 0xffff0000u)};
                    const f32x4 v0 = b0 + acc[ai][bj][m][0] * alpha, v1 = b1 + acc[ai][bj][m][1] * alpha;
                    if (F32OUT) { *(f32x4*)(fout + o) = v0; *(f32x4*)(fout + o + 4) = v1; }
                    else { u32x4 w; w.x = cvt_pk_bf16(v0[0], v0[1]); w.y = cvt_pk_bf16(v0[2], v0[3]); w.z = cvt_pk_bf16(v1[0], v1[1]); w.w = cvt_pk_bf16(v1[2], v1[3]); *(u32x4*)(xb + o) = w;
                        sq += ((v0[0] * v0[0] + v0[1] * v0[1]) + (v0[2] * v0[2] + v0[3] * v0[3])) + ((v1[0] * v1[0] + v1[1] * v1[1]) + (v1[2] * v1[2] + v1[3] * v1[3])); } }
                if (!F32OUT) { sq += __shfl_xor(sq, 16); sq += __shfl_xor(sq, 32); if (fq == 0) red[rl * 4 + wc] = sq; } }
        if (!F32OUT) {
            asm volatile("s_waitcnt lgkmcnt(0)" ::: "memory"); __builtin_amdgcn_s_barrier(); asm volatile("" ::: "memory");
            const int t = (wr * 4 + wc) * 64 + fq * 16 + fr;
            if (t < 256) { const f32x4 v = *(const PG8_LAS f32x4*)(red + t * 4); ssqp[(size_t)(u.pm * BM + t) * 8 + u.pn] = (v[0] + v[1]) + (v[2] + v[3]); } }
    }
};
}

#define LAS __attribute__((address_space(3)))
typedef unsigned short bf16;
typedef float f32x4 __attribute__((ext_vector_type(4)));
typedef short bf16x8 __attribute__((ext_vector_type(8)));
typedef short s16x4 __attribute__((ext_vector_type(4)));
typedef unsigned u32x4 __attribute__((ext_vector_type(4)));
typedef unsigned u32x2 __attribute__((ext_vector_type(2)));

constexpr int MTOK = 16384, DM = 2048, SEQ = 2048, NBATCH = 8, DFF = 5504, MEMLEN = 256;
constexpr int LD_AB = 6400, LD_C = 2560;
constexpr float EPS = 1e-6f;
constexpr size_t MiB = 1u << 20;
constexpr size_t WS_FF1IN = 0, WS_FF1OUT = 44 * MiB, WS_FF2IN = 66 * MiB, WS_FF2OUT = 110 * MiB, WS_MIXIN = 132 * MiB, WS_MIXOUT = 157 * MiB,
                 WS_WQ = 165 * MiB, WS_WO = 173 * MiB, WS_WKV0 = 181 * MiB, WS_WKV1 = 197 * MiB, WS_H = 213 * MiB, WS_PROJ = 277 * MiB, WS_OBUF = 477 * MiB,
                 WS_OC = 541 * MiB, WS_LSE = 637 * MiB, WS_ST = 639 * MiB, WS_DD = 767 * MiB, WS_KV = 768 * MiB, WS_MEMH = 800 * MiB, WS_CTL = 816 * MiB, WS_SSQ = 817 * MiB, WS_END = 822 * MiB;
constexpr int LDS_BYTES = 147456;

struct Params { const float* in[37]; float* out; unsigned char* ws; };

__device__ __forceinline__ unsigned pk2(float lo, float hi) { return pg8::cvt_pk_bf16(lo, hi); }
__device__ __forceinline__ float bflo(unsigned w) { return __uint_as_float(w << 16); }
__device__ __forceinline__ float bfhi(unsigned w) { return __uint_as_float(w & 0xffff0000u); }
__device__ __forceinline__ float wave_sum(float v) {
#pragma unroll
    for (int o = 1; o < 64; o <<= 1) v += __shfl_xor(v, o);
    return v;
}
__device__ __forceinline__ f32x4 mfma16(bf16x8 a, bf16x8 b, f32x4 c) { return __builtin_amdgcn_mfma_f32_16x16x32_bf16(a, b, c, 0, 0, 0); }
__device__ __forceinline__ bf16x8 lds16(const LAS unsigned char* p) { return *(const LAS bf16x8*)p; }
__device__ __forceinline__ bf16x8 vtr8(const LAS unsigned char* p0, const LAS unsigned char* p1) {
    const s16x4 lo = __builtin_bit_cast(s16x4, __builtin_amdgcn_ds_read_tr16_b64_v4i16((LAS s16x4*)p0));
    const s16x4 hi = __builtin_bit_cast(s16x4, __builtin_amdgcn_ds_read_tr16_b64_v4i16((LAS s16x4*)p1));
    return (bf16x8){lo[0], lo[1], lo[2], lo[3], hi[0], hi[1], hi[2], hi[3]};
}

__device__ __forceinline__ void transpose_item(const float* __restrict__ W, const float* __restrict__ gain, int K, int N, bf16* __restrict__ WT, int mode, LAS float* scr, int item, int lane) {
    const int nblk = N / 32, kb = item / nblk, nb = item % nblk, k0 = 64 * kb, n0 = 32 * nb;
    int drow0 = n0;
    if (mode == 1) { const int up = n0 >= DFF ? 1 : 0, j = n0 - up * DFF; drow0 = (j >> 7) * 256 + (j & 127) + up * 128; }
#pragma unroll 8
    for (int i = 0; i < 32; ++i) { const int kk = 2 * i + (lane >> 5); const float gk = gain ? gain[k0 + kk] : 1.f; scr[kk * 33 + (lane & 31)] = W[(size_t)(k0 + kk) * N + n0 + (lane & 31)] * gk; }
    asm volatile("s_waitcnt lgkmcnt(0)" ::: "memory");
    const int c = lane & 7;
#pragma unroll
    for (int j = 0; j < 4; ++j) { const int n = (lane >> 3) + 8 * j; const LAS float* s = scr + (8 * c) * 33 + n;
        u32x4 o; o.x = pk2(s[0 * 33], s[1 * 33]); o.y = pk2(s[2 * 33], s[3 * 33]); o.z = pk2(s[4 * 33], s[5 * 33]); o.w = pk2(s[6 * 33], s[7 * 33]);
        *(u32x4*)(WT + (size_t)(drow0 + n) * K + k0 + 8 * c) = o; }
    asm volatile("s_waitcnt lgkmcnt(0)" ::: "memory");
}
struct TD { const float* W; const float* gain; int K, N, mode; size_t dst; };
__device__ __forceinline__ TD get_td(const Params& p, int layer, int i) {
    TD t; t.mode = 0; t.K = DM; t.N = DM; t.W = nullptr; t.gain = nullptr; t.dst = 0;
    if (layer == 0) {
        switch (i) {
            case 0: t.W = p.in[3]; t.gain = p.in[2]; t.N = 2 * DFF; t.mode = 1; t.dst = WS_FF1IN; break;
            case 1: t.W = p.in[4]; t.K = DFF; t.dst = WS_FF1OUT; break;
            case 2: t.W = p.in[6]; t.gain = p.in[5]; t.N = 6176; t.dst = WS_MIXIN; break;
            case 3: t.W = p.in[12]; t.dst = WS_MIXOUT; break;
            case 4: t.W = p.in[15]; t.gain = p.in[13]; t.dst = WS_WQ; break;
            case 5: t.W = p.in[16]; t.N = 4096; t.dst = WS_WKV0; break;
            case 6: t.W = p.in[17]; t.dst = WS_WO; break;
            case 7: t.W = p.in[19]; t.gain = p.in[18]; t.N = 2 * DFF; t.mode = 1; t.dst = WS_FF2IN; break;
            case 8: t.W = p.in[20]; t.K = DFF; t.dst = WS_FF2OUT; break;
            default: t.W = p.in[31]; t.N = 4096; t.dst = WS_WKV1; break;
        }
    } else {
        switch (i) {
            case 0: t.W = p.in[22]; t.gain = p.in[21]; t.N = 2 * DFF; t.mode = 1; t.dst = WS_FF1IN; break;
            case 1: t.W = p.in[23]; t.K = DFF; t.dst = WS_FF1OUT; break;
            case 2: t.W = p.in[25]; t.gain = p.in[24]; t.N = 2560; t.dst = WS_MIXIN; break;
            case 3: t.W = p.in[27]; t.dst = WS_MIXOUT; break;
            case 4: t.W = p.in[30]; t.gain = p.in[28]; t.dst = WS_WQ; break;
            case 5: t.W = p.in[32]; t.dst = WS_WO; break;
            case 6: t.W = p.in[34]; t.gain = p.in[33]; t.N = 2 * DFF; t.mode = 1; t.dst = WS_FF2IN; break;
            default: t.W = p.in[35]; t.K = DFF; t.dst = WS_FF2OUT; break;
        }
    }
    return t;
}
template <int layer>
__device__ __forceinline__ void convert_weights(const Params& p, LAS unsigned char* lds, int gw, int ngw, int wave, int lane) {
    LAS float* scr = (LAS float*)(lds + wave * 16384);
    constexpr int nmat = layer == 0 ? 10 : 8;
#pragma unroll
    for (int i = 0; i < nmat; ++i) {
        const TD t = get_td(p, layer, i);
        const float* W = t.W; bf16* WT = (bf16*)(p.ws + t.dst);
        const int items = (t.K / 64) * (t.N / 32);
        for (int it = gw; it < items; it += ngw) transpose_item(W, t.gain, t.K, t.N, WT, t.mode, scr, it, lane);
    }
}
__device__ __forceinline__ void norm_row(const float* xrow, const float* gain, bf16* orow, float* of, int lane) {
    const f32x4* xr = (const f32x4*)xrow + lane;
    f32x4 v[8]; float s = 0.f;
#pragma unroll
    for (int j = 0; j < 8; ++j) { v[j] = xr[64 * j]; s += (v[j].x * v[j].x + v[j].y * v[j].y) + (v[j].z * v[j].z + v[j].w * v[j].w); }
    const float rstd = rsqrtf(wave_sum(s) * (1.f / DM) + EPS);
    const f32x4* gr = (const f32x4*)gain + lane;
#pragma unroll
    for (int j = 0; j < 8; ++j) { const f32x4 g = gr[64 * j]; const f32x4 y = v[j] * rstd * g;
        if (of) ((f32x4*)of)[64 * j + lane] = y;
        else { u32x2 w; w.x = pk2(y.x, y.y); w.y = pk2(y.z, y.w); ((u32x2*)orow)[64 * j + lane] = w; } }
}
__device__ __forceinline__ void cast_rows_ssq(const float* x, bf16* xb, float* ssq, int nrows, int gw, int ngw, int lane) {
    for (int m = gw; m < nrows; m += ngw) { const f32x4* xr = (const f32x4*)(x + (size_t)m * DM) + lane; float s_ = 0.f; f32x4 v[8];
#pragma unroll
        for (int j = 0; j < 8; ++j) v[j] = xr[64 * j];
#pragma unroll
        for (int j = 0; j < 8; ++j) { s_ += (v[j].x * v[j].x + v[j].y * v[j].y) + (v[j].z * v[j].z + v[j].w * v[j].w);
            u32x2 w; w.x = pk2(v[j].x, v[j].y); w.y = pk2(v[j].z, v[j].w); ((u32x2*)(xb + (size_t)m * DM))[64 * j + lane] = w; }
        s_ = wave_sum(s_); if (lane < 8) ssq[(size_t)m * 8 + lane] = lane == 0 ? s_ : 0.f; }
}
__device__ __forceinline__ void norm_row2(const float* xa, const float* xb_, const float* gain, bf16* oa, bf16* ob_, float* fa, float* fb, int lane) {
    const f32x4* ra = (const f32x4*)xa + lane; const f32x4* rb = (const f32x4*)xb_ + lane;
    f32x4 va[8], vb[8]; float sa = 0.f, sb = 0.f;
#pragma unroll
    for (int j = 0; j < 8; ++j) { va[j] = ra[64 * j]; vb[j] = rb[64 * j]; }
#pragma unroll
    for (int j = 0; j < 8; ++j) { sa += (va[j].x * va[j].x + va[j].y * va[j].y) + (va[j].z * va[j].z + va[j].w * va[j].w); sb += (vb[j].x * vb[j].x + vb[j].y * vb[j].y) + (vb[j].z * vb[j].z + vb[j].w * vb[j].w); }
    const float rsa = rsqrtf(wave_sum(sa) * (1.f / DM) + EPS), rsb = rsqrtf(wave_sum(sb) * (1.f / DM) + EPS);
    const f32x4* gr = (const f32x4*)gain + lane;
#pragma unroll
    for (int j = 0; j < 8; ++j) { const f32x4 g = gr[64 * j]; const f32x4 ya = va[j] * rsa * g, yb = vb[j] * rsb * g;
        if (fa) { ((f32x4*)fa)[64 * j + lane] = ya; ((f32x4*)fb)[64 * j + lane] = yb; }
        else { u32x2 wa, wb; wa.x = pk2(ya.x, ya.y); wa.y = pk2(ya.z, ya.w); wb.x = pk2(yb.x, yb.y); wb.y = pk2(yb.z, yb.w); ((u32x2*)oa)[64 * j + lane] = wa; ((u32x2*)ob_)[64 * j + lane] = wb; } }
}
__device__ __forceinline__ void norm_rows(const float* x, const float* gain, bf16* out, int nrows, int gw, int ngw, int lane) {
    int m = gw;
    for (; m + ngw < nrows; m += 2 * ngw) norm_row2(x + (size_t)m * DM, x + (size_t)(m + ngw) * DM, gain, out + (size_t)m * DM, out + (size_t)(m + ngw) * DM, nullptr, nullptr, lane);
    for (; m < nrows; m += ngw) norm_row(x + (size_t)m * DM, gain, out + (size_t)m * DM, nullptr, lane);
}

template <int HD, int NB, int NQ>
__device__ __forceinline__ void banded_unit(LAS unsigned char* lds, int tid, const bf16* __restrict__ qb, const bf16* __restrict__ kbp, const bf16* __restrict__ vbp, int ld,
                                            int dil, int r, int L, int qpos0, int ks, int nrows, int wave_row_off, int W, float slope, float scale, float m_init, float l_init,
                                            bf16* __restrict__ ob, int old, float* __restrict__ lseb) {
    constexpr int CH = HD / 8, ROWB = HD * 2, SWZ = (CH - 1) & 15, NK = HD / 32, ND = HD / 16;
    LAS unsigned char* Kt = lds; LAS unsigned char* Vt = lds + nrows * ROWB;
    for (int idx = tid; idx < nrows * CH; idx += 512) {
        const int row = idx / CH, ch = idx % CH, kp = ks + row;
        u32x4 k4 = (u32x4){0u, 0u, 0u, 0u}, v4 = (u32x4){0u, 0u, 0u, 0u};
        if (kp >= 0 && kp < L) { const size_t off = (size_t)(kp * dil + r) * ld + ch * 8; k4 = *(const u32x4*)(kbp + off); v4 = *(const u32x4*)(vbp + off); }
        const int lo = row * ROWB + ((ch ^ (row & SWZ)) << 4);
        *(LAS u32x4*)(Kt + lo) = k4; *(LAS u32x4*)(Vt + lo) = v4;
    }
    __syncthreads();
    const int lane = tid & 63, g = lane >> 4, c = lane & 15;
    bf16x8 qf[NQ][NK]; f32x4 O[NQ][ND]; float m[NQ], l[NQ];
#pragma unroll
    for (int qi = 0; qi < NQ; ++qi) { const size_t qtok = (size_t)((qpos0 + 16 * qi + c) * dil + r);
#pragma unroll
        for (int k = 0; k < NK; ++k) qf[qi][k] = *(const bf16x8*)(qb + qtok * ld + k * 32 + g * 8);
#pragma unroll
        for (int d = 0; d < ND; ++d) O[qi][d] = (f32x4){0.f, 0.f, 0.f, 0.f};
        m[qi] = m_init; l[qi] = (g == 0) ? l_init : 0.f; }
    const int krow_a = (c >> 2) * 8 + (c & 3), vrow_a = g * 8 + (c >> 2), vch = (c & 3) >> 1, vhalf = (c & 1) * 8;
    for (int kb = 0; kb < NB; ++kb) {
        const int R0 = wave_row_off + kb * 32;
        const int ra = R0 + krow_a, rb = ra + 4;
        bf16x8 ka[NK], kbf[NK];
#pragma unroll
        for (int k = 0; k < NK; ++k) { const int chunk = k * 4 + g;
            ka[k] = lds16(Kt + ra * ROWB + ((chunk ^ (ra & SWZ)) << 4)); kbf[k] = lds16(Kt + rb * ROWB + ((chunk ^ (rb & SWZ)) << 4)); }
        const int r0 = R0 + vrow_a, r1 = r0 + 4;
        bf16x8 vf[ND];
#pragma unroll
        for (int d = 0; d < ND; ++d) { const int chunk = d * 2 + vch;
            vf[d] = vtr8(Vt + r0 * ROWB + ((chunk ^ (r0 & SWZ)) << 4) + vhalf, Vt + r1 * ROWB + ((chunk ^ (r1 & SWZ)) << 4) + vhalf); }
        const int kp0 = ks + R0 + g * 8;
#pragma unroll
        for (int qi = 0; qi < NQ; ++qi) {
            const int qb0 = qpos0 + 16 * qi;
            if (NQ > 1 && !((ks + R0 + 31 >= qb0 - W) && (ks + R0 <= qb0 + 15 + W))) continue;
            const int qpos = qb0 + c;
            f32x4 s0 = (f32x4){0.f, 0.f, 0.f, 0.f}, s1 = s0;
#pragma unroll
            for (int k = 0; k < NK; ++k) { s0 = mfma16(ka[k], qf[qi][k], s0); s1 = mfma16(kbf[k], qf[qi][k], s1); }
            float sv[8]; float bm = -1e30f;
#pragma unroll
            for (int jj = 0; jj < 8; ++jj) { const int kp = kp0 + jj; const int dd = kp - qpos; const int ad = dd < 0 ? -dd : dd; const bool valid = (ad <= W) && (kp >= 0) && (kp < L);
                const float raw = jj < 4 ? s0[jj & 3] : s1[jj & 3];
                sv[jj] = valid ? raw * scale - slope * (float)ad : -1e30f; bm = fmaxf(bm, sv[jj]); }
            bm = fmaxf(bm, __shfl_xor(bm, 16)); bm = fmaxf(bm, __shfl_xor(bm, 32));
            const float m_new = fmaxf(m[qi], bm), alpha = __expf(m[qi] - m_new);
            float ps = 0.f;
#pragma unroll
            for (int jj = 0; jj < 8; ++jj) { sv[jj] = __expf(sv[jj] - m_new); ps += sv[jj]; }
            l[qi] = l[qi] * alpha + ps; m[qi] = m_new;
            u32x4 pw; pw.x = pk2(sv[0], sv[1]); pw.y = pk2(sv[2], sv[3]); pw.z = pk2(sv[4], sv[5]); pw.w = pk2(sv[6], sv[7]);
            const bf16x8 pf = __builtin_bit_cast(bf16x8, pw);
#pragma unroll
            for (int d = 0; d < ND; ++d) O[qi][d] = mfma16(vf[d], pf, O[qi][d] * alpha);
        }
    }
#pragma unroll
    for (int qi = 0; qi < NQ; ++qi) { const size_t qtok = (size_t)((qpos0 + 16 * qi + c) * dil + r);
        float lt = l[qi]; lt += __shfl_xor(lt, 16); lt += __shfl_xor(lt, 32);
        const float inv = 1.f / lt;
#pragma unroll
        for (int d = 0; d < ND; ++d) { u32x2 w; w.x = pk2(O[qi][d][0] * inv, O[qi][d][1] * inv); w.y = pk2(O[qi][d][2] * inv, O[qi][d][3] * inv); *(u32x2*)(ob + qtok * old + d * 16 + g * 4) = w; }
        if (lseb != nullptr && g == 0) lseb[qtok * 8] = m[qi] + __logf(lt); }
    __syncthreads();
}

__device__ __forceinline__ void xattn_unit(LAS unsigned char* lds, int tid, const bf16* __restrict__ qx, const bf16* __restrict__ kv, bf16* __restrict__ obuf, int u) {
    const int b = u >> 6, h = (u >> 4) & 3, qt = u & 15;
    const int lane = tid & 63, w = tid >> 6, g = lane >> 4, c = lane & 15;
    const size_t token = (size_t)b * SEQ + qt * 128 + 16 * w + c;
    const bf16* qrow = qx + token * DM + h * 512;
    const bf16* kbase = kv + (size_t)(b * MEMLEN) * 4096 + h * 512; const bf16* vbase = kbase + 2048;
    const int krow_a = (c >> 2) * 8 + (c & 3), vrow_a = g * 8 + (c >> 2), vch = (c & 3) >> 1, vhalf = (c & 1) * 8;
    int offK[2][4], offV[2][8];
#pragma unroll
    for (int t = 0; t < 2; ++t) { const int rk = krow_a + 4 * t, rv = vrow_a + 4 * t;
#pragma unroll
        for (int k = 0; k < 4; ++k) offK[t][k] = rk * 256 + (((k * 4 + g) ^ (rk & 15)) << 4);
#pragma unroll
        for (int d = 0; d < 8; ++d) offV[t][d] = rv * 256 + (((d * 2 + vch) ^ (rv & 15)) << 4) + vhalf; }
    f32x4 S[16];
#pragma unroll
    for (int i = 0; i < 16; ++i) S[i] = (f32x4){0.f, 0.f, 0.f, 0.f};
    for (int dc = 0; dc < 4; ++dc) {
        bf16x8 qf[4];
#pragma unroll
        for (int k = 0; k < 4; ++k) qf[k] = *(const bf16x8*)(qrow + dc * 128 + k * 32 + g * 8);
        for (int idx = tid; idx < 4096; idx += 512) { const int row = idx >> 4, ch = idx & 15;
            *(LAS u32x4*)(lds + row * 256 + ((ch ^ (row & 15)) << 4)) = *(const u32x4*)(kbase + (size_t)row * 4096 + dc * 128 + ch * 8); }
        __syncthreads();
#pragma unroll
        for (int kb = 0; kb < 8; ++kb) {
#pragma unroll
            for (int k = 0; k < 4; ++k) {
                S[kb * 2] = mfma16(lds16(lds + offK[0][k] + kb * 8192), qf[k], S[kb * 2]);
                S[kb * 2 + 1] = mfma16(lds16(lds + offK[1][k] + kb * 8192), qf[k], S[kb * 2 + 1]); }
            asm volatile("" : "+v"(S[kb * 2]), "+v"(S[kb * 2 + 1]) :: "memory"); }
        __syncthreads();
    }
    const float scale = 0.044194173824159216f;
    float mx = -1e30f;
#pragma unroll
    for (int i = 0; i < 16; ++i) { mx = fmaxf(mx, fmaxf(fmaxf(S[i][0], S[i][1]), fmaxf(S[i][2], S[i][3]))); }
    mx = fmaxf(mx, __shfl_xor(mx, 16)); mx = fmaxf(mx, __shfl_xor(mx, 32));
    float l = 0.f;
#pragma unroll
    for (int i = 0; i < 16; ++i)
#pragma unroll
        for (int j = 0; j < 4; ++j) { const float pv = __expf((S[i][j] - mx) * scale); S[i][j] = pv; l += pv; }
    l += __shfl_xor(l, 16); l += __shfl_xor(l, 32);
    const float inv = 1.f / l;
    bf16x8 pf[8];
#pragma unroll
    for (int kb = 0; kb < 8; ++kb) { u32x4 pw; pw.x = pk2(S[kb * 2][0], S[kb * 2][1]); pw.y = pk2(S[kb * 2][2], S[kb * 2][3]); pw.z = pk2(S[kb * 2 + 1][0], S[kb * 2 + 1][1]); pw.w = pk2(S[kb * 2 + 1][2], S[kb * 2 + 1][3]);
        pf[kb] = __builtin_bit_cast(bf16x8, pw); }
    for (int dc = 0; dc < 4; ++dc) {
        for (int idx = tid; idx < 4096; idx += 512) { const int row = idx >> 4, ch = idx & 15;
            *(LAS u32x4*)(lds + row * 256 + ((ch ^ (row & 15)) << 4)) = *(const u32x4*)(vbase + (size_t)row * 4096 + dc * 128 + ch * 8); }
        __syncthreads();
#pragma unroll
        for (int d = 0; d < 8; ++d) {
            f32x4 O = (f32x4){0.f, 0.f, 0.f, 0.f};
#pragma unroll
            for (int kb = 0; kb < 8; ++kb) O = mfma16(vtr8(lds + offV[0][d] + kb * 8192, lds + offV[1][d] + kb * 8192), pf[kb], O);
            u32x2 wv; wv.x = pk2(O[0] * inv, O[1] * inv); wv.y = pk2(O[2] * inv, O[3] * inv);
            *(u32x2*)(obuf + token * DM + h * 512 + dc * 128 + d * 16 + g * 4) = wv;
            asm volatile("" ::: "memory");
        }
        __syncthreads();
    }
}

constexpr int G_BCUM = 0, G_X1 = 65536, G_X2 = 98304, G_ZS = 131072, G_RED = 139264;
__device__ __forceinline__ void gla_gates(LAS unsigned char* lds, int tid, const bf16* __restrict__ proj, size_t tok0, int h, const float* __restrict__ Wf, const float* __restrict__ bf_,
                                          const float* __restrict__ Wb, const float* __restrict__ bb_) {
    if (tid < 256) { const int t = tid >> 2, part = tid & 3; const u32x4 v = *(const u32x4*)(proj + (tok0 + t) * LD_AB + 6144 + part * 8);
        LAS f32x4* zp = (LAS f32x4*)(lds + G_ZS + (t * 32 + part * 8) * 4);
        zp[0] = (f32x4){bflo(v.x), bfhi(v.x), bflo(v.y), bfhi(v.y)}; zp[1] = (f32x4){bflo(v.z), bfhi(v.z), bflo(v.w), bfhi(v.w)}; }
    __syncthreads();
    if (tid < 256) {
        const int dir = tid >> 7, kk = tid & 127; const float* Wg = dir ? Wb : Wf; const float* bg = dir ? bb_ : bf_;
        float w[16];
#pragma unroll
        for (int r = 0; r < 16; ++r) w[r] = Wg[r * 512 + h * 128 + kk];
        const float bias = bg[h * 128 + kk];
        float cum = 0.f; LAS float* bc = (LAS float*)(lds + G_BCUM) + dir * 8192 + kk; const LAS unsigned char* zs = lds + G_ZS + dir * 64;
        for (int s = 0; s < 64; ++s) { const int t = dir ? 63 - s : s;
            const LAS f32x4* z4 = (const LAS f32x4*)(zs + t * 128);
            const f32x4 z0 = z4[0], z1 = z4[1], z2 = z4[2], z3 = z4[3];
            float u = bias;
            u += z0[0] * w[0] + z0[1] * w[1] + z0[2] * w[2] + z0[3] * w[3];
            u += z1[0] * w[4] + z1[1] * w[5] + z1[2] * w[6] + z1[3] * w[7];
            u += z2[0] * w[8] + z2[1] * w[9] + z2[2] * w[10] + z2[3] * w[11];
            u += z3[0] * w[12] + z3[1] * w[13] + z3[2] * w[14] + z3[3] * w[15];
            const float ls = fminf(u, 0.f) - __logf(1.f + __expf(-fabsf(u)));
            cum += ls * 0.0625f; bc[t * 128] = cum; }
    }
    __syncthreads();
}
__device__ __forceinline__ void gla_stage_v(LAS unsigned char* vdst, int tid, const bf16* __restrict__ proj, size_t tok0, int h) {
    for (int idx = tid; idx < 2048; idx += 512) { const int row = idx >> 5, ch = idx & 31;
        *(LAS u32x4*)(vdst + row * 512 + ((ch ^ (row & 15)) << 4)) = *(const u32x4*)(proj + (tok0 + row) * LD_AB + 4096 + h * 256 + ch * 8); }
}
__device__ __forceinline__ void gla_stage1_unit(LAS unsigned char* lds, int tid, const bf16* __restrict__ proj, int item, const float* Wf, const float* bf_, const float* Wb, const float* bb_,
                                                bf16* __restrict__ St, float* __restrict__ Dd) {
    const int b = item >> 7, h = (item >> 5) & 3, cidx = item & 31; const size_t tok0 = (size_t)b * SEQ + cidx * 64;
    gla_gates(lds, tid, proj, tok0, h, Wf, bf_, Wb, bb_);
    {
        const int kk = tid & 127, jq = tid >> 7;
        const LAS float* bcf = (const LAS float*)(lds + G_BCUM) + kk; const LAS float* bcb = bcf + 8192;
        const float blf = bcf[63 * 128], blb = bcb[0];
#pragma unroll
        for (int cc = 0; cc < 2; ++cc) { const int jc = jq * 2 + cc; float of[8], obk[8];
#pragma unroll
            for (int e = 0; e < 8; ++e) { const int j = jc * 8 + e; const float kv = __uint_as_float((unsigned)proj[(tok0 + j) * LD_AB + 3584 + h * 128 + kk] << 16);
                of[e] = kv * __expf(blf - bcf[j * 128]); obk[e] = kv * __expf(blb - bcb[j * 128]); }
            const int lo = kk * 128 + ((jc ^ (kk & 7)) << 4);
            *(LAS u32x4*)(lds + G_X1 + lo) = (u32x4){pk2(of[0], of[1]), pk2(of[2], of[3]), pk2(of[4], of[5]), pk2(of[6], of[7])};
            *(LAS u32x4*)(lds + G_X1 + 16384 + lo) = (u32x4){pk2(obk[0], obk[1]), pk2(obk[2], obk[3]), pk2(obk[4], obk[5]), pk2(obk[6], obk[7])}; }
        if (tid < 128) { Dd[(size_t)item * 128 + kk] = __expf(blf); Dd[(size_t)(1024 + item) * 128 + kk] = __expf(blb); }
    }
    gla_stage_v(lds + G_X2, tid, proj, tok0, h);
    __syncthreads();
    const int lane = tid & 63, w = tid >> 6, g = lane >> 4, c = lane & 15;
    const int vrow_a = g * 8 + (c >> 2), vch = (c & 3) >> 1, vhalf = (c & 1) * 8;
#pragma unroll
    for (int dbi = 0; dbi < 2; ++dbi) { const int db = 2 * w + dbi; bf16x8 vf[2];
#pragma unroll
        for (int ksj = 0; ksj < 2; ++ksj) { const int r0 = ksj * 32 + vrow_a, r1 = r0 + 4, chunk = db * 2 + vch;
            vf[ksj] = vtr8(lds + G_X2 + r0 * 512 + ((chunk ^ (r0 & 15)) << 4) + vhalf, lds + G_X2 + r1 * 512 + ((chunk ^ (r1 & 15)) << 4) + vhalf); }
#pragma unroll
        for (int dir = 0; dir < 2; ++dir)
#pragma unroll
            for (int nb = 0; nb < 8; ++nb) { f32x4 acc = (f32x4){0.f, 0.f, 0.f, 0.f}; const int kk = nb * 16 + c;
#pragma unroll
                for (int ksj = 0; ksj < 2; ++ksj) acc = mfma16(vf[ksj], lds16(lds + G_X1 + dir * 16384 + kk * 128 + (((ksj * 4 + g) ^ (kk & 7)) << 4)), acc);
                bf16* sp = St + ((size_t)(dir * 1024 + item) * 256 + db * 16 + g * 4) * 128 + kk;
#ifdef DBG_ZERO_ST
                for (int j = 0; j < 4; ++j) sp[j * 128] = (bf16)0; }
#else
                for (int j = 0; j < 4; ++j) sp[j * 128] = (bf16)(pk2(acc[j], 0.f) & 0xffffu); }
#endif
    }
    __syncthreads();
}
__device__ __forceinline__ void gla_scan(bf16* __restrict__ St, const float* __restrict__ Dd, int gtid, int nthreads) {
    for (int wi = gtid; wi < 262144; wi += nthreads) {
        const int dir = wi >> 17, bh = (wi >> 12) & 31, e8 = wi & 4095, kk0 = (e8 * 8) & 127;
        float st[8];
#pragma unroll
        for (int e = 0; e < 8; ++e) st[e] = 0.f;
#pragma unroll 8
        for (int s = 0; s < 32; ++s) { const int cidx = dir ? 31 - s : s; const size_t it = (size_t)dir * 1024 + bh * 32 + cidx;
            u32x4* sp = (u32x4*)(St + it * 32768 + e8 * 8); const u32x4 uu = *sp;
            const f32x4 d0 = *(const f32x4*)(Dd + it * 128 + kk0), d1 = *(const f32x4*)(Dd + it * 128 + kk0 + 4);
            *sp = (u32x4){pk2(st[0], st[1]), pk2(st[2], st[3]), pk2(st[4], st[5]), pk2(st[6], st[7])};
            st[0] = d0[0] * st[0] + bflo(uu.x); st[1] = d0[1] * st[1] + bfhi(uu.x); st[2] = d0[2] * st[2] + bflo(uu.y); st[3] = d0[3] * st[3] + bfhi(uu.y);
            st[4] = d1[0] * st[4] + bflo(uu.z); st[5] = d1[1] * st[5] + bfhi(uu.z); st[6] = d1[2] * st[6] + bflo(uu.w); st[7] = d1[3] * st[7] + bfhi(uu.w); }
    }
}
__device__ __forceinline__ void gla_stage3_unit(LAS unsigned char* lds, int tid, const bf16* __restrict__ proj, int item, const float* Wf, const float* bf_, const float* Wb, const float* bb_,
                                                const bf16* __restrict__ St, const float* __restrict__ head_norm, bf16* __restrict__ obuf) {
    const int b = item >> 7, h = (item >> 5) & 3, cidx = item & 31; const size_t tok0 = (size_t)b * SEQ + cidx * 64;
    gla_gates(lds, tid, proj, tok0, h, Wf, bf_, Wb, bb_);
    const float qscale = 0.08838834764831845f;
    for (int task = tid; task < 1024; task += 512) { const int row = task >> 4, ch = task & 15;
        const u32x4 q8 = *(const u32x4*)(proj + (tok0 + row) * LD_AB + 3072 + h * 128 + ch * 8), k8 = *(const u32x4*)(proj + (tok0 + row) * LD_AB + 3584 + h * 128 + ch * 8);
        const LAS f32x4* bfp = (const LAS f32x4*)(lds + G_BCUM + (row * 128 + ch * 8) * 4); const LAS f32x4* bbp = (const LAS f32x4*)(lds + G_BCUM + 32768 + (row * 128 + ch * 8) * 4);
        const f32x4 f0 = bfp[0], f1 = bfp[1], b0 = bbp[0], b1 = bbp[1];
        const float qv[8] = {bflo(q8.x), bfhi(q8.x), bflo(q8.y), bfhi(q8.y), bflo(q8.z), bfhi(q8.z), bflo(q8.w), bfhi(q8.w)};
        const float kvv[8] = {bflo(k8.x), bfhi(k8.x), bflo(k8.y), bfhi(k8.y), bflo(k8.z), bfhi(k8.z), bflo(k8.w), bfhi(k8.w)};
        const float bfv[8] = {f0[0], f0[1], f0[2], f0[3], f1[0], f1[1], f1[2], f1[3]}, bbv[8] = {b0[0], b0[1], b0[2], b0[3], b1[0], b1[1], b1[2], b1[3]};
        float qgf[8], qgb[8], kdf[8], kdb[8];
#pragma unroll
        for (int e = 0; e < 8; ++e) { const float ef = __expf(bfv[e]), eb = __expf(bbv[e]); qgf[e] = qv[e] * qscale * ef; qgb[e] = qv[e] * qscale * eb; kdf[e] = kvv[e] / ef; kdb[e] = kvv[e] / eb; }
        const int lo = row * 256 + ((ch ^ (row & 15)) << 4);
        *(LAS u32x4*)(lds + G_X1 + lo) = (u32x4){pk2(qgf[0], qgf[1]), pk2(qgf[2], qgf[3]), pk2(qgf[4], qgf[5]), pk2(qgf[6], qgf[7])};
        *(LAS u32x4*)(lds + G_X1 + 16384 + lo) = (u32x4){pk2(qgb[0], qgb[1]), pk2(qgb[2], qgb[3]), pk2(qgb[4], qgb[5]), pk2(qgb[6], qgb[7])};
        *(LAS u32x4*)(lds + G_X2 + lo) = (u32x4){pk2(kdf[0], kdf[1]), pk2(kdf[2], kdf[3]), pk2(kdf[4], kdf[5]), pk2(kdf[6], kdf[7])};
        *(LAS u32x4*)(lds + G_X2 + 16384 + lo) = (u32x4){pk2(kdb[0], kdb[1]), pk2(kdb[2], kdb[3]), pk2(kdb[4], kdb[5]), pk2(kdb[6], kdb[7])}; }
    __syncthreads();
    gla_stage_v(lds + G_BCUM, tid, proj, tok0, h);
    __syncthreads();
    const int lane = tid & 63, w = tid >> 6, g = lane >> 4, c = lane & 15, ib = w & 3, dh = w >> 2;
    const int krow_a = (c >> 2) * 8 + (c & 3), vrow_a = g * 8 + (c >> 2), vch = (c & 3) >> 1, vhalf = (c & 1) * 8;
    bf16x8 qg[2][4];
#pragma unroll
    for (int dir = 0; dir < 2; ++dir)
#pragma unroll
        for (int k = 0; k < 4; ++k) qg[dir][k] = lds16(lds + G_X1 + dir * 16384 + (ib * 16 + c) * 256 + (((k * 4 + g) ^ c) << 4));
    bf16x8 pf[2];
#pragma unroll
    for (int jb = 0; jb < 2; ++jb) { const int ra = jb * 32 + krow_a, rb = ra + 4;
        f32x4 sf0 = (f32x4){0.f, 0.f, 0.f, 0.f}, sf1 = sf0, sb0 = sf0, sb1 = sf0;
#pragma unroll
        for (int k = 0; k < 4; ++k) { const int chunk = k * 4 + g; const int oa = ra * 256 + ((chunk ^ (ra & 15)) << 4), obb = rb * 256 + ((chunk ^ (rb & 15)) << 4);
            sf0 = mfma16(lds16(lds + G_X2 + oa), qg[0][k], sf0); sf1 = mfma16(lds16(lds + G_X2 + obb), qg[0][k], sf1);
            sb0 = mfma16(lds16(lds + G_X2 + 16384 + oa), qg[1][k], sb0); sb1 = mfma16(lds16(lds + G_X2 + 16384 + obb), qg[1][k], sb1); }
        float pv[8]; const int iidx = ib * 16 + c;
#pragma unroll
        for (int jj = 0; jj < 8; ++jj) { const int jidx = jb * 32 + g * 8 + jj; const float vf_ = jj < 4 ? sf0[jj & 3] : sf1[jj & 3], vb_ = jj < 4 ? sb0[jj & 3] : sb1[jj & 3]; pv[jj] = (jidx <= iidx) ? vf_ : vb_; }
        u32x4 pw; pw.x = pk2(pv[0], pv[1]); pw.y = pk2(pv[2], pv[3]); pw.z = pk2(pv[4], pv[5]); pw.w = pk2(pv[6], pv[7]);
        pf[jb] = __builtin_bit_cast(bf16x8, pw); }
    f32x4 O[8]; float ssq = 0.f;
#pragma unroll
    for (int d = 0; d < 8; ++d) { const int dvb = dh * 8 + d; f32x4 acc = (f32x4){0.f, 0.f, 0.f, 0.f};
#pragma unroll
        for (int jb = 0; jb < 2; ++jb) { const int r0 = jb * 32 + vrow_a, r1 = r0 + 4, chunk = dvb * 2 + vch;
            acc = mfma16(vtr8(lds + G_BCUM + r0 * 512 + ((chunk ^ (r0 & 15)) << 4) + vhalf, lds + G_BCUM + r1 * 512 + ((chunk ^ (r1 & 15)) << 4) + vhalf), pf[jb], acc); }
#ifndef DBG_NO_INTER
#pragma unroll
        for (int dir = 0; dir < 2; ++dir) { const bf16* sp = St + ((size_t)(dir * 1024 + item) * 256 + dvb * 16 + c) * 128 + g * 8;
#pragma unroll
            for (int k = 0; k < 4; ++k) acc = mfma16(*(const bf16x8*)(sp + k * 32), qg[dir][k], acc); }
#endif
        O[d] = acc; ssq += (acc[0] * acc[0] + acc[1] * acc[1]) + (acc[2] * acc[2] + acc[3] * acc[3]); }
    ssq += __shfl_xor(ssq, 16); ssq += __shfl_xor(ssq, 32);
    LAS float* red = (LAS float*)(lds + G_RED);
    if (g == 0) red[w * 16 + c] = ssq;
    __syncthreads();
    const float tot = red[w * 16 + c] + red[(w ^ 4) * 16 + c];
    const float rstd = rsqrtf(tot * (1.f / 256.f) + EPS);
    const size_t token = tok0 + ib * 16 + c;
#pragma unroll
    for (int d = 0; d < 8; ++d) { const int dv0 = (dh * 8 + d) * 16 + g * 4;
        const f32x4 hn = *(const f32x4*)(head_norm + h * 256 + dv0); const u32x2 r2 = *(const u32x2*)(proj + token * LD_AB + 5120 + h * 256 + dv0);
        const float rv[4] = {bflo(r2.x), bfhi(r2.x), bflo(r2.y), bfhi(r2.y)}; float ov[4];
#pragma unroll
        for (int j = 0; j < 4; ++j) ov[j] = O[d][j] * rstd * hn[j] * pg8::silu_f(rv[j]);
        u32x2 wv; wv.x = pk2(ov[0], ov[1]); wv.y = pk2(ov[2], ov[3]); *(u32x2*)(obuf + token * DM + 1024 + h * 256 + dv0) = wv; }
    __syncthreads();
}
__device__ __forceinline__ void combine_a(const bf16* __restrict__ oc, const float* __restrict__ lse, bf16* __restrict__ obuf, int gtid, int nthreads) {
#pragma unroll 4
    for (int task = gtid; task < MTOK * 128; task += nthreads) { const int token = task >> 7, h = (task >> 4) & 7, ch = task & 15;
        const float l0 = lse[(size_t)token * 8 + h], l1 = lse[(size_t)(MTOK + token) * 8 + h], l2 = lse[(size_t)(2 * MTOK + token) * 8 + h];
        const float mx = fmaxf(l0, fmaxf(l1, l2)); float w0 = __expf(l0 - mx), w1 = __expf(l1 - mx), w2 = __expf(l2 - mx); const float inv = 1.f / (w0 + w1 + w2); w0 *= inv; w1 *= inv; w2 *= inv;
        const size_t off = (size_t)token * 1024 + h * 128 + ch * 8;
        const u32x4 a = *(const u32x4*)(oc + off), bq = *(const u32x4*)(oc + (size_t)MTOK * 1024 + off), cq = *(const u32x4*)(oc + (size_t)2 * MTOK * 1024 + off);
        u32x4 o;
        o.x = pk2(w0 * bflo(a.x) + w1 * bflo(bq.x) + w2 * bflo(cq.x), w0 * bfhi(a.x) + w1 * bfhi(bq.x) + w2 * bfhi(cq.x));
        o.y = pk2(w0 * bflo(a.y) + w1 * bflo(bq.y) + w2 * bflo(cq.y), w0 * bfhi(a.y) + w1 * bfhi(bq.y) + w2 * bfhi(cq.y));
        o.z = pk2(w0 * bflo(a.z) + w1 * bflo(bq.z) + w2 * bflo(cq.z), w0 * bfhi(a.z) + w1 * bfhi(bq.z) + w2 * bfhi(cq.z));
        o.w = pk2(w0 * bflo(a.w) + w1 * bflo(bq.w) + w2 * bflo(cq.w), w0 * bfhi(a.w) + w1 * bfhi(bq.w) + w2 * bfhi(cq.w));
        *(u32x4*)(obuf + (size_t)token * DM + h * 128 + ch * 8) = o; }
}

#define XB_TMO      128
#define XB_XCNT(j)  (256  + 64 * (j))
#define XB_XSUB(j)  (1280 + 64 * (j))
#define XB_XGEN(j)  (2304 + 64 * (j))
#define XB_TOP      3328
#define XB_TOPGEN   3392
#define XCD_BAR_WORDS 3456
#define XB_SPIN_CAP (1u << 18)

__device__ __forceinline__ unsigned xb_ld(unsigned* p)              { return __hip_atomic_load(p, __ATOMIC_RELAXED, __HIP_MEMORY_SCOPE_AGENT); }
__device__ __forceinline__ unsigned xb_add(unsigned* p, unsigned v) { return __hip_atomic_fetch_add(p, v, __ATOMIC_RELAXED, __HIP_MEMORY_SCOPE_AGENT); }
__device__ __forceinline__ unsigned xb_xcc_id() { return (unsigned)__builtin_amdgcn_s_getreg((3 << 11) | 20) & 0xFu; }
#define XB_SPIN(cond, bar) do { unsigned _sp = 0; while (cond) { __builtin_amdgcn_s_sleep(1); \
    if ((++_sp & 255u) == 0u) { if (xb_ld(&(bar)[XB_TMO])) break; if (_sp > XB_SPIN_CAP) { atomicAdd(&(bar)[XB_TMO], 1u); break; } } } } while (0)

struct XcdBarrier {
    unsigned* bar; unsigned x;
    volatile LAS unsigned* st;
};

__device__ __forceinline__ XcdBarrier xcd_barrier_post(unsigned* bar, volatile LAS unsigned* st) {
    XcdBarrier b; b.bar = bar; b.x = xb_xcc_id(); b.st = st;
    if (threadIdx.x == 0) (void)xb_add(&bar[XB_XCNT(b.x)], 1u);
    return b;
}
__device__ __forceinline__ void xcd_barrier_complete(unsigned* bar, unsigned x, unsigned& nloc, unsigned& nx) {
    const unsigned G = gridDim.x * gridDim.y * gridDim.z;
    unsigned sum, cnt, mine, sp = 0u;
    for (;;) {
        sum = 0u; cnt = 0u; mine = 0u;
#pragma unroll
        for (unsigned j = 0; j < 16; ++j) { const unsigned c = xb_ld(&bar[XB_XCNT(j)]); sum += c; cnt += (c > 0u) ? 1u : 0u; mine = (j == x) ? c : mine; }
        if (sum == G) break;
        __builtin_amdgcn_s_sleep(1);
        if ((++sp & 255u) == 0u) { if (xb_ld(&bar[XB_TMO])) break; if (sp > XB_SPIN_CAP) { atomicAdd(&bar[XB_TMO], 1u); break; } }
    }
    nloc = mine > 0u ? mine : 1u; nx = cnt > 0u ? cnt : 1u;
}

__device__ __forceinline__ void xcd_barrier(const XcdBarrier& b) {
    asm volatile("s_waitcnt vmcnt(0)" ::: "memory");
    __syncthreads();
    if (threadIdx.x == 0) {
        unsigned* bar = b.bar;
        __builtin_amdgcn_s_waitcnt(0);
        unsigned nloc = b.st[0], nx = b.st[1];
        if (nloc == 0u) { xcd_barrier_complete(bar, b.x, nloc, nx); b.st[0] = nloc; b.st[1] = nx; }
        const unsigned old = xb_add(&bar[XB_XSUB(b.x)], 1u);
        const unsigned gen = old / nloc;
        if (old + 1u == (gen + 1u) * nloc) {
            __builtin_amdgcn_fence(__ATOMIC_RELEASE, "agent");
            asm volatile("s_waitcnt vmcnt(0)" ::: "memory");
            const unsigned og = xb_add(&bar[XB_TOP], 1u);
            const unsigned tg = og / nx;
            if (og + 1u == (tg + 1u) * nx) xb_add(&bar[XB_TOPGEN], 1u);
            else XB_SPIN(xb_ld(&bar[XB_TOPGEN]) == tg, bar);
            __builtin_amdgcn_fence(__ATOMIC_ACQUIRE, "agent");
            xb_add(&bar[XB_XGEN(b.x)], 1u);
            asm volatile("s_waitcnt vmcnt(0)" ::: "memory");
        } else {
            XB_SPIN(xb_ld(&bar[XB_XGEN(b.x)]) == gen, bar);
            __builtin_amdgcn_fence(__ATOMIC_ACQUIRE, "agent");
            asm volatile("s_waitcnt vmcnt(0)" ::: "memory");
        }
    }
    __syncthreads();
}

__device__ __forceinline__ void gsync_cg(cg::grid_group& grid) {
    asm volatile("s_waitcnt vmcnt(0) lgkmcnt(0)" ::: "memory");
    grid.sync();
    __builtin_amdgcn_fence(__ATOMIC_ACQUIRE, "agent");
    asm volatile("s_waitcnt vmcnt(0)" ::: "memory");
}
#define gsync(grid_) xcd_barrier(xbar)

__device__ __forceinline__ int fresh_tid() { int t = threadIdx.x; asm volatile("" : "+v"(t)); return t; }
#ifndef DBG_STOP
#define DBG_STOP 0
#endif
#define DBG_CHECK(k) do { if (DBG_STOP == (k)) { for (int m_ = gw; m_ < MTOK; m_ += ngw) norm_row(X + (size_t)m_ * DM, p.in[36], nullptr, X + (size_t)m_ * DM, fresh_tid() & 63); return true; } } while (0)
template <int layer>
__device__ __forceinline__ bool run_layer(const Params& p, LAS unsigned char* lds, cg::grid_group& grid, const XcdBarrier& xbar, int wave, int G, int bid, int gw, int ngw, int nthreads) {
    unsigned char* ws = p.ws;
    bf16* Hb = (bf16*)(ws + WS_H); bf16* PROJ = (bf16*)(ws + WS_PROJ); bf16* OBUF = (bf16*)(ws + WS_OBUF); bf16* OC = (bf16*)(ws + WS_OC); float* LSE = (float*)(ws + WS_LSE);
    bf16* ST = (bf16*)(ws + WS_ST); float* DD = (float*)(ws + WS_DD); bf16* KV = (bf16*)(ws + WS_KV);
    float* X = p.out; float* SSQ = (float*)(p.ws + WS_SSQ);
        { pg8::Gemm g{Hb, (const bf16*)(ws + WS_FF1IN), MTOK, 2 * DFF, DM}; pg8::StaticOrder S; S.init(MTOK, 2 * DFF, G, bid); pg8::EpiSwiglu E{PROJ, DFF, SSQ + (size_t)(layer * 4 + 0) * (MTOK * 8)};
          pg8::gemm_phase<pg8::EpiSwiglu, pg8::StaticOrder, true, true>(lds, g, S, E);
#ifdef EXP_DUP_FFNIN
          if (layer == 0) pg8::gemm_phase<pg8::EpiSwiglu, pg8::StaticOrder, true, true>(lds, g, S, E);
#endif
        }
        gsync(grid);
        { pg8::Gemm g{PROJ, (const bf16*)(ws + WS_FF1OUT), MTOK, DM, DFF}; pg8::StaticOrder S; S.init(MTOK, DM, G, bid); pg8::EpiResid<true, false> E{Hb, nullptr, SSQ + (size_t)(layer * 4 + 1) * (MTOK * 8), (LAS float*)(lds + 131072)};
          pg8::gemm_phase<pg8::EpiResid<true, false>, pg8::StaticOrder, true, true>(lds, g, S, E); }
        gsync(grid);
        if (layer == 0) {
            { pg8::Gemm g{Hb, (const bf16*)(ws + WS_MIXIN), MTOK, LD_AB, DM}; pg8::StaticOrder S; S.init(MTOK, LD_AB, G, bid); pg8::EpiPlain E{PROJ, LD_AB, SSQ + (size_t)(layer * 4 + 1) * (MTOK * 8)};
              pg8::gemm_phase<pg8::EpiPlain, pg8::StaticOrder, true, true>(lds, g, S, E); }
            gsync(grid);
#ifdef EXP_DUP_MA
            for (int rep_ = 0; rep_ < 2; ++rep_) {
#else
            {
#endif
#ifndef DBG_NO_A
            { const int tid = fresh_tid();
            for (int u = bid; u < 3072; u += G) {
                const int cfg = u >> 10; int v = u & 1023; const int h = v & 7; v >>= 3; const int b = v >> 4, rest = v & 15;
                const int dil = cfg == 0 ? 1 : (cfg == 1 ? 4 : 16), tiles = 16 / dil, r = rest / tiles, tile = rest % tiles, L = SEQ / dil, q0 = tile * 128;
                const bf16* base = PROJ + (size_t)b * SEQ * LD_AB + h * 128;
                const float slope = exp2f(-(float)(h + 1)) * (float)dil;
                banded_unit<128, 5, 1>(lds, tid, base, base + 1024, base + 2048, LD_AB, dil, r, L, q0 + 16 * wave, q0 - 64, 272, 16 * wave, 64, slope, 0.08838834764831845f, -1e30f, 0.f,
                                    OC + (size_t)cfg * MTOK * 1024 + (size_t)b * SEQ * 1024 + h * 128, 1024, LSE + (size_t)cfg * MTOK * 8 + (size_t)b * SEQ * 8 + h);
            } }
#endif
#ifndef DBG_NO_GLA
            { const int tid = fresh_tid(); for (int u = bid; u < 1024; u += G) gla_stage1_unit(lds, tid, PROJ, u, p.in[7], p.in[8], p.in[9], p.in[10], ST, DD); }
#endif
            }
            gsync(grid);
#if !defined(DBG_NO_GLA) && !defined(DBG_NO_SCAN)
            gla_scan(ST, DD, bid * 512 + fresh_tid(), nthreads);
#endif
            gsync(grid);
#ifdef EXP_DUP_MC
            for (int rep_ = 0; rep_ < 2; ++rep_) {
#else
            {
#endif
#ifndef DBG_NO_GLA
            { const int tid = fresh_tid(); for (int u = bid; u < 1024; u += G) gla_stage3_unit(lds, tid, PROJ, u, p.in[7], p.in[8], p.in[9], p.in[10], ST, p.in[11], OBUF); }
#else
            for (int t_ = bid * 512 + fresh_tid(); t_ < MTOK * 128; t_ += nthreads) *(u32x4*)(OBUF + (size_t)(t_ >> 7) * DM + 1024 + (t_ & 127) * 8) = (u32x4){0u, 0u, 0u, 0u};
#endif
#ifndef DBG_NO_A
            combine_a(OC, LSE, OBUF, bid * 512 + fresh_tid(), nthreads);
#else
            for (int t_ = bid * 512 + fresh_tid(); t_ < MTOK * 128; t_ += nthreads) *(u32x4*)(OBUF + (size_t)(t_ >> 7) * DM + (t_ & 127) * 8) = (u32x4){0u, 0u, 0u, 0u};
#endif
            }
            gsync(grid);
        } else {
            { pg8::Gemm g{Hb, (const bf16*)(ws + WS_MIXIN), MTOK, LD_C, DM}; pg8::StaticOrder S; S.init(MTOK, LD_C, G, bid); pg8::EpiPlain E{PROJ, LD_C, SSQ + (size_t)(layer * 4 + 1) * (MTOK * 8)};
              pg8::gemm_phase<pg8::EpiPlain, pg8::StaticOrder, true, true>(lds, g, S, E); }
            gsync(grid);
#ifdef EXP_DUP_C
            for (int rep_ = 0; rep_ < 2; ++rep_)
#endif
            { const int tid = fresh_tid();
            for (int u = bid; u < 1024; u += G) {
                const int qt = u & 31, gk = (u >> 5) & 3, b = u >> 7, head = gk * 8 + wave;
                const bf16* base = PROJ + (size_t)b * SEQ * LD_C;
                banded_unit<64, 10, 4>(lds, tid, base + head * 64, base + 2048 + gk * 64, base + 2304 + gk * 64, LD_C, 1, 0, SEQ, qt * 64, qt * 64 - 128, 320, 0, 128,
                                   exp2f(-0.25f * (float)(head + 1)), 0.125f, p.in[26][head], 1.f, OBUF + (size_t)b * SEQ * DM + head * 64, DM, nullptr);
            } }
            gsync(grid);
        }
        { pg8::Gemm g{OBUF, (const bf16*)(ws + WS_MIXOUT), MTOK, DM, DM}; pg8::StaticOrder S; S.init(MTOK, DM, G, bid); pg8::EpiResid<false, false> E{Hb, nullptr, SSQ + (size_t)(layer * 4 + 2) * (MTOK * 8), (LAS float*)(lds + 131072)};
          pg8::gemm_phase<pg8::EpiResid<false, false>, pg8::StaticOrder, true, true>(lds, g, S, E); }
        gsync(grid);
        { pg8::Gemm g{Hb, (const bf16*)(ws + WS_WQ), MTOK, DM, DM}; pg8::StaticOrder S; S.init(MTOK, DM, G, bid); pg8::EpiPlain E{PROJ, DM, SSQ + (size_t)(layer * 4 + 2) * (MTOK * 8)};
          pg8::gemm_phase<pg8::EpiPlain, pg8::StaticOrder, true, true>(lds, g, S, E); }
        gsync(grid);
        { const int tid = fresh_tid(); for (int u = bid; u < 512; u += G) xattn_unit(lds, tid, PROJ, KV + (size_t)layer * NBATCH * MEMLEN * 4096, OBUF, u); }
#ifdef EXP_DUP_XATTN
        { const int tid = fresh_tid(); for (int u = bid; u < 512; u += G) xattn_unit(lds, tid, PROJ, KV + (size_t)layer * NBATCH * MEMLEN * 4096, OBUF, u); }
#endif
        gsync(grid);
        { pg8::Gemm g{OBUF, (const bf16*)(ws + WS_WO), MTOK, DM, DM}; pg8::StaticOrder S; S.init(MTOK, DM, G, bid); pg8::EpiResid<false, false> E{Hb, nullptr, SSQ + (size_t)(layer * 4 + 3) * (MTOK * 8), (LAS float*)(lds + 131072)};
          pg8::gemm_phase<pg8::EpiResid<false, false>, pg8::StaticOrder, true, true>(lds, g, S, E); }
        gsync(grid);
        { pg8::Gemm g{Hb, (const bf16*)(ws + WS_FF2IN), MTOK, 2 * DFF, DM}; pg8::StaticOrder S; S.init(MTOK, 2 * DFF, G, bid); pg8::EpiSwiglu E{PROJ, DFF, SSQ + (size_t)(layer * 4 + 3) * (MTOK * 8)};
          pg8::gemm_phase<pg8::EpiSwiglu, pg8::StaticOrder, true, true>(lds, g, S, E); }
        gsync(grid);
        { pg8::Gemm g{PROJ, (const bf16*)(ws + WS_FF2OUT), MTOK, DM, DFF}; pg8::StaticOrder S; S.init(MTOK, DM, G, bid); pg8::EpiResid<true, layer == 1> E{Hb, X, SSQ + (size_t)(layer * 4 + 4) * (MTOK * 8), (LAS float*)(lds + 131072)};
          pg8::gemm_phase<pg8::EpiResid<true, layer == 1>, pg8::StaticOrder, true, true>(lds, g, S, E); }
        gsync(grid);
        if (layer == 0) {
            convert_weights<1>(p, lds, gw, ngw, wave, fresh_tid() & 63);
            gsync(grid);
        } else {
            const int ftl = fresh_tid() & 63;
            int m = gw;
            for (; m + ngw < MTOK; m += 2 * ngw) norm_row2(X + (size_t)m * DM, X + (size_t)(m + ngw) * DM, p.in[36], nullptr, nullptr, X + (size_t)m * DM, X + (size_t)(m + ngw) * DM, ftl);
            for (; m < MTOK; m += ngw) norm_row(X + (size_t)m * DM, p.in[36], nullptr, X + (size_t)m * DM, ftl);
        }
    return false;
}

__global__ void __launch_bounds__(512, 2) mega_fwd(Params p) {
    extern __shared__ __attribute__((aligned(16))) unsigned char lds_raw[];
    LAS unsigned char* lds = (LAS unsigned char*)lds_raw;
    cg::grid_group grid = cg::this_grid();
    volatile LAS unsigned* xst = (volatile LAS unsigned*)(lds + LDS_BYTES - 64);
    if (threadIdx.x == 0) { xst[0] = 0u; xst[1] = 0u; }
    __syncthreads();
    const XcdBarrier xbar = xcd_barrier_post((unsigned*)(p.ws + WS_CTL), xst);
    const int wave = __builtin_amdgcn_readfirstlane((int)threadIdx.x >> 6);
    const int G = gridDim.x, bid = blockIdx.x, gw = bid * 8 + wave, ngw = G * 8, nthreads = G * 512;
    unsigned char* ws = p.ws;
    bf16* Hb = (bf16*)(ws + WS_H); bf16* PROJ = (bf16*)(ws + WS_PROJ); bf16* OBUF = (bf16*)(ws + WS_OBUF); bf16* OC = (bf16*)(ws + WS_OC); float* LSE = (float*)(ws + WS_LSE);
    bf16* ST = (bf16*)(ws + WS_ST); float* DD = (float*)(ws + WS_DD); bf16* KV = (bf16*)(ws + WS_KV); bf16* MEMH = (bf16*)(ws + WS_MEMH);
    float* X = p.out; float* SSQ = (float*)(p.ws + WS_SSQ);

    convert_weights<0>(p, lds, gw, ngw, wave, fresh_tid() & 63);
#ifdef EXP_DUP_CONVERT
    convert_weights<0>(p, lds, gw, ngw, wave, fresh_tid() & 63);
#endif
#ifdef EXP_SYNCS
    for (int i_ = 0; i_ < 20; ++i_) gsync(grid);
#endif
    norm_rows(p.in[1], p.in[14], MEMH, NBATCH * MEMLEN, gw, ngw, fresh_tid() & 63);
    norm_rows(p.in[1], p.in[29], MEMH + (size_t)NBATCH * MEMLEN * DM, NBATCH * MEMLEN, gw, ngw, fresh_tid() & 63);
    cast_rows_ssq(p.in[0], Hb, SSQ, MTOK, gw, ngw, fresh_tid() & 63);
    gsync_cg(grid);
    {
        pg8::Gemm g0{MEMH, (const bf16*)(ws + WS_WKV0), NBATCH * MEMLEN, 4096, DM}; pg8::StaticOrder S0; S0.init(NBATCH * MEMLEN, 4096, G, bid);
        pg8::EpiPlain E0{KV, 4096, nullptr};
        pg8::gemm_phase<pg8::EpiPlain, pg8::StaticOrder, true, true>(lds, g0, S0, E0);
        pg8::Gemm g1{MEMH + (size_t)NBATCH * MEMLEN * DM, (const bf16*)(ws + WS_WKV1), NBATCH * MEMLEN, 4096, DM}; pg8::StaticOrder S1; S1.init(NBATCH * MEMLEN, 4096, G, (bid + G / 2) % G);
        pg8::EpiPlain E1{KV + (size_t)NBATCH * MEMLEN * 4096, 4096, nullptr};
        pg8::gemm_phase<pg8::EpiPlain, pg8::StaticOrder, true, true>(lds, g1, S1, E1);
    }
    if (run_layer<0>(p, lds, grid, xbar, wave, G, bid, gw, ngw, nthreads)) return;
    if (run_layer<1>(p, lds, grid, xbar, wave, G, bid, gw, ngw, nthreads)) return;
}

extern "C" void kernel_launch(void* const* d_in, const int* in_sizes, int n_in, void* d_out, int out_size, void* d_ws, size_t ws_size, hipStream_t stream) {
    static int grid = 0;
    if (grid == 0) {
        if (n_in != 37 || out_size != MTOK * DM || ws_size < WS_END) { fprintf(stderr, "kernel_launch: unexpected shapes (n_in %d out %d ws %zu)\n", n_in, out_size, ws_size); grid = -1; return; }
        int dev = 0, cus = 0, per_cu = 0;
        hipGetDevice(&dev);
        hipDeviceGetAttribute(&cus, hipDeviceAttributeMultiprocessorCount, dev);
        hipFuncSetAttribute((const void*)mega_fwd, hipFuncAttributeMaxDynamicSharedMemorySize, LDS_BYTES);
        if (hipOccupancyMaxActiveBlocksPerMultiprocessor(&per_cu, (const void*)mega_fwd, 512, LDS_BYTES) != hipSuccess || per_cu < 1) per_cu = 1;
        (void)hipGetLastError();
        grid = cus * per_cu;
    }
    if (grid < 0) return;
    if (hipMemsetAsync((char*)d_ws + WS_CTL, 0, 16384, stream) != hipSuccess) { fprintf(stderr, "kernel_launch: memset of the barrier words failed\n"); return; }
    Params p{};
    for (int i = 0; i < 37; ++i) p.in[i] = (const float*)d_in[i];
    p.out = (float*)d_out; p.ws = (unsigned char*)d_ws;
    void* args[] = {&p};
    hipError_t e = hipLaunchCooperativeKernel((const void*)mega_fwd, dim3(grid), dim3(512), args, LDS_BYTES, stream);
    if (e != hipSuccess) fprintf(stderr, "cooperative launch failed: %s (grid %d)\n", hipGetErrorString(e), grid);
}
```

```cpp
#include <hip/hip_runtime.h>
#include <hip/hip_cooperative_groups.h>
#include <cstdio>
#include <cstdint>
namespace cg = cooperative_groups;
namespace pg8 {
#define PG8_LAS __attribute__((address_space(3)))
typedef unsigned short bf16_t;
typedef short bf16x8 __attribute__((ext_vector_type(8)));
typedef float f32x4 __attribute__((ext_vector_type(4)));
typedef unsigned u32x4 __attribute__((ext_vector_type(4)));
constexpr int BM = 256, BK = 64, HALF = 128, HTB = HALF * BK * 2  , STAGE_BYTES = 8 * HTB, NXCD = 8, WGM = 8;

__host__ __device__ __forceinline__ int lds_byte(int r, int c) { const int st = (r >> 4) * 2 + (c >> 5), rr = r & 15, cc = c & 31, ob = rr * 64 + cc * 2; return st * 1024 + (ob ^ (((ob >> 9) & 1) << 5)); }
__host__ __device__ __forceinline__ void stage_rc(int b, int& R, int& C) { const int st = b / 1024, sb = b % 1024, swz = sb ^ (((sb >> 9) & 1) << 5); R = (st >> 1) * 16 + swz / 64; C = (st & 1) * 32 + (swz % 64) / 2; }
__host__ __device__ __forceinline__ int perm32(int rho) { const int n = rho >> 4, i = rho & 15; return 8 * (i >> 2) + 4 * n + (i & 3); }

struct Unit { int pm, pn; };
struct Gemm { const bf16_t* A; const bf16_t* Bt; int M, N, K; };

struct StaticOrder {
    int nM, nN, nwg, G, c;
    __host__ __device__ void init(int M, int N, int G_, int c_) { nM = M / BM; nN = N / BM; nwg = nM * nN; G = G_; c = c_; }
    __host__ __device__ bool next(int i, Unit& u) const {
        const long L = (long)i * G + c; if (L >= nwg) return false;
        int wgid = (int)L; { const int q = nwg / NXCD, r = nwg % NXCD, xcd = wgid % NXCD, off = wgid / NXCD; wgid = (xcd < r ? xcd * (q + 1) : r * (q + 1) + (xcd - r) * q) + off; }
        const int nig = WGM * nN, gid = wgid / nig, fm = gid * WGM, gsz = (nM - fm) < WGM ? (nM - fm) : WGM;
        u.pm = fm + ((wgid % nig) % gsz); u.pn = (wgid % nig) / gsz; return true;
    }
    __device__ __forceinline__ void a_ready(const Unit&) const {}
    __device__ __forceinline__ void done(const Unit&) const {}
};

typedef float f32x2_cv __attribute__((ext_vector_type(2))); typedef __bf16 bf16x2_cv __attribute__((ext_vector_type(2)));
__device__ __forceinline__ unsigned cvt_pk_bf16(float lo, float hi) { const f32x2_cv v = {lo, hi}; const bf16x2_cv b = __builtin_convertvector(v, bf16x2_cv); return __builtin_bit_cast(unsigned, b); }
template <class Epi, class Sched, bool ALIGN_EPI = false, bool SP2 = false>
__device__ __forceinline__ void gemm_phase(PG8_LAS unsigned char* lds, const Gemm g, const Sched& S, const Epi& E) {
    int tid_l = threadIdx.x; asm volatile("" : "+v"(tid_l));
    const int tid = tid_l, wid = __builtin_amdgcn_readfirstlane(tid >> 6), lane = tid & 63, wr = wid >> 2, wc = wid & 3, fr = lane & 15, fq = lane >> 4;
    const int K = g.K, nt = K / BK;
    unsigned voffA[2], voffB[2];
#pragma unroll
    for (int i = 0; i < 2; ++i) { int R, C; stage_rc(tid * 16 + i * 8192, R, C); const int Rb = Epi::PERM ? ((R & ~31) + perm32(R & 31)) : R;
        voffA[i] = (unsigned)(R * K + C) * 2u; voffB[i] = (unsigned)(Rb * K + C) * 2u; }
    const size_t kstep = (size_t)(BK * 2);
    const size_t hstep = (size_t)HALF * K * 2;
    const size_t tstep = 2 * hstep;
    const unsigned ldsw = (unsigned)wid * 1024u;
    const int aoff = lds_byte(wr * 64 + fr, fq * 8), boff = lds_byte(wc * 32 + fr, fq * 8);
#define PG8_SA(b, h) (((b) * 2 + (h)) * HTB)
#define PG8_SB(b, h) ((4 + (b) * 2 + (h)) * HTB)
#define PG8_STAGE(bufoff, gbase, voff) do { _Pragma("unroll") for (int _i = 0; _i < 2; ++_i) \
        __builtin_amdgcn_global_load_lds((const unsigned*)((const char*)(gbase) + (voff)[_i]), (PG8_LAS unsigned*)(lds + (bufoff) + ldsw + _i * 8192), 16, 0, 0); } while (0)
#define PG8_LDA(dst, b, h) do { _Pragma("unroll") for (int m = 0; m < 4; ++m) _Pragma("unroll") for (int k = 0; k < 2; ++k) dst[m][k] = *(const PG8_LAS bf16x8*)(lds + PG8_SA(b, h) + aoff + m * 2048 + k * 1024); } while (0)
#define PG8_LDB(dst, b, h) do { _Pragma("unroll") for (int n = 0; n < 2; ++n) _Pragma("unroll") for (int k = 0; k < 2; ++k) dst[n][k] = *(const PG8_LAS bf16x8*)(lds + PG8_SB(b, h) + boff + n * 2048 + k * 1024); } while (0)
#define PG8_MMA(ai, bj, At, Bt) do { __builtin_amdgcn_s_setprio(1); _Pragma("unroll") for (int m = 0; m < 4; ++m) _Pragma("unroll") for (int n = 0; n < 2; ++n) _Pragma("unroll") for (int k = 0; k < 2; ++k) \
        acc[ai][bj][m][n] = __builtin_amdgcn_mfma_f32_16x16x32_bf16(Bt[n][k], At[m][k], acc[ai][bj][m][n], 0, 0, 0); __builtin_amdgcn_s_setprio(0); } while (0)
#define PG8_WAIT_V(n) asm volatile("s_waitcnt vmcnt(" #n ")" ::: "memory")
#define PG8_WAIT_L(n) asm volatile("s_waitcnt lgkmcnt(" #n ")" ::: "memory")
#define PG8_BAR __builtin_amdgcn_s_barrier()
#define PG8_SCHED __builtin_amdgcn_sched_barrier(0)
    Unit cur, nxt; int ui = 0;
    if (!S.next(0, cur)) return;
    f32x4 acc[2][2][4][2];
#pragma unroll
    for (int a = 0; a < 2; ++a)
#pragma unroll
        for (int b = 0; b < 2; ++b)
#pragma unroll
            for (int m = 0; m < 4; ++m)
#pragma unroll
                for (int n = 0; n < 2; ++n) acc[a][b][m][n] = (f32x4){0.f, 0.f, 0.f, 0.f};
    bf16x8 At[4][2], B0[2][2], B1[2][2];
    const char* cA = (const char*)g.A + (size_t)cur.pm * tstep; const char* cB = (const char*)g.Bt + (size_t)cur.pn * tstep;
    S.a_ready(cur);
    if constexpr (SP2) {
        PG8_STAGE(PG8_SB(0, 0), cB, voffB); PG8_STAGE(PG8_SB(0, 1), cB + hstep, voffB); PG8_STAGE(PG8_SA(0, 0), cA, voffA); PG8_STAGE(PG8_SA(0, 1), cA + hstep, voffA);
        if (wr == 1) PG8_BAR;
        PG8_WAIT_V(2); PG8_BAR;
        PG8_STAGE(PG8_SB(1, 0), cB + kstep, voffB); PG8_STAGE(PG8_SA(1, 0), cA + kstep, voffA); PG8_STAGE(PG8_SB(1, 1), cB + hstep + kstep, voffB);
        PG8_WAIT_V(6); PG8_BAR;
    } else {
        PG8_STAGE(PG8_SB(0, 0), cB, voffB); PG8_STAGE(PG8_SA(0, 0), cA, voffA); PG8_STAGE(PG8_SB(0, 1), cB + hstep, voffB); PG8_STAGE(PG8_SA(0, 1), cA + hstep, voffA);
        if (wr == 1) PG8_BAR;
        PG8_WAIT_V(4); PG8_BAR;
        PG8_STAGE(PG8_SB(1, 0), cB + kstep, voffB); PG8_STAGE(PG8_SA(1, 0), cA + kstep, voffA); PG8_STAGE(PG8_SB(1, 1), cB + hstep + kstep, voffB);
        PG8_WAIT_V(6); PG8_BAR;
    }
    for (;;) {
        const bool has_next = S.next(ui + 1, nxt);
        const char* nA = has_next ? (const char*)g.A + (size_t)nxt.pm * tstep : cA; const char* nB = has_next ? (const char*)g.Bt + (size_t)nxt.pn * tstep : cB;
        for (int t = 0; t < nt; t += 2) {
            const bool last = (t == nt - 2);
            const char* a1 = cA + (size_t)(t + 1) * kstep;
            const char* a2 = last ? nA : cA + (size_t)(t + 2) * kstep; const char* b2 = last ? nB : cB + (size_t)(t + 2) * kstep;
            const char* a3 = a2 + kstep; const char* b3 = b2 + kstep;
            if (last && has_next) S.a_ready(nxt);
            if constexpr (SP2) {
            PG8_LDB(B0, 0, 0); PG8_LDB(B1, 0, 1); PG8_SCHED; PG8_LDA(At, 0, 0); PG8_STAGE(PG8_SA(1, 1), a1 + hstep, voffA);
            PG8_WAIT_V(8); PG8_WAIT_L(0); PG8_BAR; PG8_MMA(0, 0, At, B0); PG8_MMA(0, 1, At, B1); PG8_BAR; PG8_SCHED;
            PG8_LDA(At, 0, 1); PG8_STAGE(PG8_SB(0, 0), b2, voffB); PG8_STAGE(PG8_SB(0, 1), b2 + hstep, voffB); PG8_STAGE(PG8_SA(0, 0), a2, voffA);
            PG8_WAIT_V(8); PG8_WAIT_L(0); PG8_BAR; PG8_MMA(1, 0, At, B0); PG8_MMA(1, 1, At, B1); PG8_BAR; PG8_SCHED;
            PG8_LDB(B0, 1, 0); PG8_LDB(B1, 1, 1); PG8_SCHED; PG8_LDA(At, 1, 0); PG8_STAGE(PG8_SA(0, 1), a2 + hstep, voffA);
            PG8_WAIT_V(8); PG8_WAIT_L(0); PG8_BAR; PG8_MMA(0, 0, At, B0); PG8_MMA(0, 1, At, B1); PG8_BAR; PG8_SCHED;
            PG8_LDA(At, 1, 1); PG8_STAGE(PG8_SB(1, 0), b3, voffB); PG8_STAGE(PG8_SB(1, 1), b3 + hstep, voffB); PG8_STAGE(PG8_SA(1, 0), a3, voffA);
            PG8_WAIT_V(8); PG8_WAIT_L(0); PG8_BAR; PG8_MMA(1, 0, At, B0); PG8_MMA(1, 1, At, B1); PG8_BAR; PG8_SCHED;
            } else {
            PG8_LDB(B0, 0, 0); PG8_SCHED; PG8_LDA(At, 0, 0); PG8_STAGE(PG8_SA(1, 1), a1 + hstep, voffA);
            PG8_WAIT_L(8); PG8_BAR; PG8_WAIT_L(0); PG8_MMA(0, 0, At, B0); PG8_BAR; PG8_SCHED;
            PG8_LDB(B1, 0, 1); PG8_STAGE(PG8_SB(0, 0), b2, voffB);
            PG8_BAR; PG8_WAIT_L(0); PG8_MMA(0, 1, At, B1); PG8_BAR;
            PG8_LDA(At, 0, 1); PG8_STAGE(PG8_SA(0, 0), a2, voffA);
            PG8_BAR; PG8_WAIT_L(0); PG8_MMA(1, 0, At, B0); PG8_BAR; PG8_SCHED;
            PG8_STAGE(PG8_SB(0, 1), b2 + hstep, voffB);
            PG8_WAIT_V(6); PG8_BAR; PG8_MMA(1, 1, At, B1); PG8_BAR;
            PG8_LDB(B0, 1, 0); PG8_SCHED; PG8_LDA(At, 1, 0); PG8_STAGE(PG8_SA(0, 1), a2 + hstep, voffA);
            PG8_WAIT_L(8); PG8_BAR; PG8_WAIT_L(0); PG8_MMA(0, 0, At, B0); PG8_BAR; PG8_SCHED;
            PG8_LDB(B1, 1, 1); PG8_STAGE(PG8_SB(1, 0), b3, voffB);
            PG8_BAR; PG8_WAIT_L(0); PG8_MMA(0, 1, At, B1); PG8_BAR;
            PG8_LDA(At, 1, 1); PG8_STAGE(PG8_SA(1, 0), a3, voffA);
            PG8_BAR; PG8_WAIT_L(0); PG8_MMA(1, 0, At, B0); PG8_BAR; PG8_SCHED;
            PG8_STAGE(PG8_SB(1, 1), b3 + hstep, voffB);
            PG8_WAIT_V(6); PG8_BAR; PG8_MMA(1, 1, At, B1); PG8_BAR;
            }
        }
        if constexpr (ALIGN_EPI) { if (wr == 0) PG8_BAR; }
        if constexpr (!Epi::AFTER_DRAIN) { E(acc, cur, wr, wc, fr, fq); S.done(cur); }
        if (!has_next) break;
#pragma unroll
        for (int a = 0; a < 2; ++a)
#pragma unroll
            for (int b = 0; b < 2; ++b)
#pragma unroll
                for (int m = 0; m < 4; ++m)
#pragma unroll
                    for (int n = 0; n < 2; ++n) acc[a][b][m][n] = (f32x4){0.f, 0.f, 0.f, 0.f};
        cur = nxt; cA = nA; cB = nB; ++ui;
        if constexpr (ALIGN_EPI) { if (wr == 1) PG8_BAR; }
    }
    PG8_WAIT_V(0);
    if constexpr (!ALIGN_EPI) { if (wr == 0) PG8_BAR; }
    PG8_BAR;
    if constexpr (Epi::AFTER_DRAIN) { E.fused(acc, cur, wr, wc, fr, fq, lds, wid, lane); S.done(cur); }
#undef PG8_SA
#undef PG8_SB
#undef PG8_STAGE
#undef PG8_LDA
#undef PG8_LDB
#undef PG8_MMA
#undef PG8_WAIT_V
#undef PG8_WAIT_L
#undef PG8_BAR
#undef PG8_SCHED
}
}

namespace pg8 {
struct EpiPlain {
    static constexpr bool PERM = true, AFTER_DRAIN = false;
    bf16_t* O; int ldc; const float* ssq;
    __device__ __forceinline__ void operator()(const f32x4 (&acc)[2][2][4][2], const Unit& u, int wr, int wc, int fr, int fq) const {
        const int row0 = u.pm * BM + wr * 64 + fr, col0 = u.pn * BM + wc * 32 + 8 * fq;
#pragma unroll
        for (int ai = 0; ai < 2; ++ai)
#pragma unroll
            for (int m = 0; m < 4; ++m) { const int row = row0 + ai * HALF + m * 16; bf16_t* rowp = O + (size_t)row * ldc + col0;
                float rs = 1.f; if (ssq) { const f32x4 p0 = *(const f32x4*)(ssq + (size_t)row * 8), p1 = *(const f32x4*)(ssq + (size_t)row * 8 + 4); rs = rsqrtf((((p0[0] + p0[1]) + (p0[2] + p0[3])) + ((p1[0] + p1[1]) + (p1[2] + p1[3]))) * (1.f / 2048.f) + 1e-6f); }
#pragma unroll
                for (int bj = 0; bj < 2; ++bj) { const f32x4 v0 = acc[ai][bj][m][0] * rs, v1 = acc[ai][bj][m][1] * rs;
                    u32x4 w; w.x = cvt_pk_bf16(v0[0], v0[1]); w.y = cvt_pk_bf16(v0[2], v0[3]); w.z = cvt_pk_bf16(v1[0], v1[1]); w.w = cvt_pk_bf16(v1[2], v1[3]);
                    *(u32x4*)(rowp + bj * HALF) = w; } }
    }
};
__device__ __forceinline__ float silu_f(float x) { return x * __builtin_amdgcn_rcpf(1.f + __builtin_amdgcn_exp2f(x * -1.4426950408889634f)); }
struct EpiSwiglu {
    static constexpr bool PERM = true, AFTER_DRAIN = false;
    bf16_t* O; int ldc; const float* ssq;
    __device__ __forceinline__ void operator()(const f32x4 (&acc)[2][2][4][2], const Unit& u, int wr, int wc, int fr, int fq) const {
        const int row0 = u.pm * BM + wr * 64 + fr, col0 = u.pn * HALF + wc * 32 + 8 * fq;
#pragma unroll
        for (int ai = 0; ai < 2; ++ai)
#pragma unroll
            for (int m = 0; m < 4; ++m) { const int row = row0 + ai * HALF + m * 16; bf16_t* rowp = O + (size_t)row * ldc + col0;
                const f32x4 p0 = *(const f32x4*)(ssq + (size_t)row * 8), p1 = *(const f32x4*)(ssq + (size_t)row * 8 + 4); const float rs = rsqrtf((((p0[0] + p0[1]) + (p0[2] + p0[3])) + ((p1[0] + p1[1]) + (p1[2] + p1[3]))) * (1.f / 2048.f) + 1e-6f);
                const f32x4 g0 = acc[ai][0][m][0] * rs, g1 = acc[ai][0][m][1] * rs, u0 = acc[ai][1][m][0] * rs, u1 = acc[ai][1][m][1] * rs;
                u32x4 w;
                w.x = cvt_pk_bf16(silu_f(g0[0]) * u0[0], silu_f(g0[1]) * u0[1]); w.y = cvt_pk_bf16(silu_f(g0[2]) * u0[2], silu_f(g0[3]) * u0[3]);
                w.z = cvt_pk_bf16(silu_f(g1[0]) * u1[0], silu_f(g1[1]) * u1[1]); w.w = cvt_pk_bf16(silu_f(g1[2]) * u1[2], silu_f(g1[3]) * u1[3]);
                *(u32x4*)rowp = w; }
    }
};
template <bool HALF_ALPHA, bool F32OUT> struct EpiResid {
    static constexpr bool PERM = true, AFTER_DRAIN = false;
    bf16_t* xb; float* fout; float* ssqp; PG8_LAS float* red;
    __device__ __forceinline__ void operator()(const f32x4 (&acc)[2][2][4][2], const Unit& u, int wr, int wc, int fr, int fq) const {
        const int col0 = u.pn * BM + wc * 32 + 8 * fq; const float alpha = HALF_ALPHA ? 0.5f : 1.0f;
#pragma unroll
        for (int ai = 0; ai < 2; ++ai)
#pragma unroll
            for (int m = 0; m < 4; ++m) { const int rl = ai * HALF + wr * 64 + m * 16 + fr; const size_t off = (size_t)(u.pm * BM + rl) * 2048 + col0; float sq = 0.f;
#pragma unroll
                for (int bj = 0; bj < 2; ++bj) { const size_t o = off + bj * HALF; const u32x4 bw = *(const u32x4*)(xb + o);
                    const f32x4 b0 = {__uint_as_float(bw.x << 16), __uint_as_float(bw.x & 0xffff0000u), __uint_as_float(bw.y << 16), __uint_as_float(bw.y & 0xffff0000u)};
                    const f32x4 b1 = {__uint_as_float(bw.z << 16), __uint_as_float(bw.z & 0xffff0000u), __uint_as_float(bw.w << 16), __uint_as_float(bw.w & 0xffff0000u)};
                    const f32x4 v0 = b0 + acc[ai][bj][m][0] * alpha, v1 = b1 + acc[ai][bj][m][1] * alpha;
                    if (F32OUT) { *(f32x4*)(fout + o) = v0; *(f32x4*)(fout + o + 4) = v1; }
                    else { u32x4 w; w.x = cvt_pk_bf16(v0[0], v0[1]); w.y = cvt_pk_bf16(v0[2], v0[3]); w.z = cvt_pk_bf16(v1[0], v1[1]); w.w = cvt_pk_bf16(v1[2], v1[3]); *(u32x4*)(xb + o) = w;
                        sq += ((v0[0] * v0[0] + v0[1] * v0[1]) + (v0[2] * v0[2] + v0[3] * v0[3])) + ((v1[0] * v1[0] + v1[1] * v1[1]) + (v1[2] * v1[2] + v1[3] * v1[3])); } }
                if (!F32OUT) { sq += __shfl_xor(sq, 16); sq += __shfl_xor(sq, 32); if (fq == 0) red[rl * 4 + wc] = sq; } }
        if (!F32OUT) {
            asm volatile("s_waitcnt lgkmcnt(0)" ::: "memory"); __builtin_amdgcn_s_barrier(); asm volatile("" ::: "memory");
            const int t = (wr * 4 + wc) * 64 + fq * 16 + fr;
            if (t < 256) { const f32x4 v = *(const PG8_LAS f32x4*)(red + t * 4); ssqp[(size_t)(u.pm * BM + t) * 8 + u.pn] = (v[0] + v[1]) + (v[2] + v[3]); } }
    }
};
}

#define LAS __attribute__((address_space(3)))
typedef unsigned short bf16;
typedef float f32x4 __attribute__((ext_vector_type(4)));
typedef short bf16x8 __attribute__((ext_vector_type(8)));
typedef short s16x4 __attribute__((ext_vector_type(4)));
typedef unsigned u32x4 __attribute__((ext_vector_type(4)));
typedef unsigned u32x2 __attribute__((ext_vector_type(2)));

constexpr int MTOK = 16384, DM = 2048, SEQ = 2048, NBATCH = 8, DFF = 5504, MEMLEN = 256;
constexpr int LD_AB = 6400, LD_C = 2560;
constexpr float EPS = 1e-6f;
constexpr size_t MiB = 1u << 20;
constexpr size_t WS_FF1IN = 0, WS_FF1OUT = 44 * MiB, WS_FF2IN = 66 * MiB, WS_FF2OUT = 110 * MiB, WS_MIXIN = 132 * MiB, WS_MIXOUT = 157 * MiB,
                 WS_WQ = 165 * MiB, WS_WO = 173 * MiB, WS_WKV0 = 181 * MiB, WS_WKV1 = 197 * MiB, WS_H = 213 * MiB, WS_PROJ = 277 * MiB, WS_OBUF = 477 * MiB,
                 WS_OC = 541 * MiB, WS_LSE = 637 * MiB, WS_ST = 639 * MiB, WS_DD = 767 * MiB, WS_KV = 768 * MiB, WS_MEMH = 800 * MiB, WS_CTL = 816 * MiB, WS_SSQ = 817 * MiB, WS_END = 822 * MiB;
constexpr int LDS_BYTES = 147456;

struct Params { const float* in[37]; float* out; unsigned char* ws; };

__device__ __forceinline__ unsigned pk2(float lo, float hi) { return pg8::cvt_pk_bf16(lo, hi); }
__device__ __forceinline__ float bflo(unsigned w) { return __uint_as_float(w << 16); }
__device__ __forceinline__ float bfhi(unsigned w) { return __uint_as_float(w & 0xffff0000u); }
__device__ __forceinline__ float wave_sum(float v) {
#pragma unroll
    for (int o = 1; o < 64; o <<= 1) v += __shfl_xor(v, o);
    return v;
}
__device__ __forceinline__ f32x4 mfma16(bf16x8 a, bf16x8 b, f32x4 c) { return __builtin_amdgcn_mfma_f32_16x16x32_bf16(a, b, c, 0, 0, 0); }
__device__ __forceinline__ bf16x8 lds16(const LAS unsigned char* p) { return *(const LAS bf16x8*)p; }
__device__ __forceinline__ bf16x8 vtr8(const LAS unsigned char* p0, const LAS unsigned char* p1) {
    const s16x4 lo = __builtin_bit_cast(s16x4, __builtin_amdgcn_ds_read_tr16_b64_v4i16((LAS s16x4*)p0));
    const s16x4 hi = __builtin_bit_cast(s16x4, __builtin_amdgcn_ds_read_tr16_b64_v4i16((LAS s16x4*)p1));
    return (bf16x8){lo[0], lo[1], lo[2], lo[3], hi[0], hi[1], hi[2], hi[3]};
}

__device__ __forceinline__ void transpose_item(const float* __restrict__ W, const float* __restrict__ gain, int K, int N, bf16* __restrict__ WT, int mode, LAS float* scr, int item, int lane) {
    const int nblk = N / 32, kb = item / nblk, nb = item % nblk, k0 = 64 * kb, n0 = 32 * nb;
    int drow0 = n0;
    if (mode == 1) { const int up = n0 >= DFF ? 1 : 0, j = n0 - up * DFF; drow0 = (j >> 7) * 256 + (j & 127) + up * 128; }
#pragma unroll 8
    for (int i = 0; i < 32; ++i) { const int kk = 2 * i + (lane >> 5); const float gk = gain ? gain[k0 + kk] : 1.f; scr[kk * 33 + (lane & 31)] = W[(size_t)(k0 + kk) * N + n0 + (lane & 31)] * gk; }
    asm volatile("s_waitcnt lgkmcnt(0)" ::: "memory");
    const int c = lane & 7;
#pragma unroll
    for (int j = 0; j < 4; ++j) { const int n = (lane >> 3) + 8 * j; const LAS float* s = scr + (8 * c) * 33 + n;
        u32x4 o; o.x = pk2(s[0 * 33], s[1 * 33]); o.y = pk2(s[2 * 33], s[3 * 33]); o.z = pk2(s[4 * 33], s[5 * 33]); o.w = pk2(s[6 * 33], s[7 * 33]);
        *(u32x4*)(WT + (size_t)(drow0 + n) * K + k0 + 8 * c) = o; }
    asm volatile("s_waitcnt lgkmcnt(0)" ::: "memory");
}
struct TD { const float* W; const float* gain; int K, N, mode; size_t dst; };
__device__ __forceinline__ TD get_td(const Params& p, int layer, int i) {
    TD t; t.mode = 0; t.K = DM; t.N = DM; t.W = nullptr; t.gain = nullptr; t.dst = 0;
    if (layer == 0) {
        switch (i) {
            case 0: t.W = p.in[3]; t.gain = p.in[2]; t.N = 2 * DFF; t.mode = 1; t.dst = WS_FF1IN; break;
            case 1: t.W = p.in[4]; t.K = DFF; t.dst = WS_FF1OUT; break;
            case 2: t.W = p.in[6]; t.gain = p.in[5]; t.N = 6176; t.dst = WS_MIXIN; break;
            case 3: t.W = p.in[12]; t.dst = WS_MIXOUT; break;
            case 4: t.W = p.in[15]; t.gain = p.in[13]; t.dst = WS_WQ; break;
            case 5: t.W = p.in[16]; t.N = 4096; t.dst = WS_WKV0; break;
            case 6: t.W = p.in[17]; t.dst = WS_WO; break;
            case 7: t.W = p.in[19]; t.gain = p.in[18]; t.N = 2 * DFF; t.mode = 1; t.dst = WS_FF2IN; break;
            case 8: t.W = p.in[20]; t.K = DFF; t.dst = WS_FF2OUT; break;
            default: t.W = p.in[31]; t.N = 4096; t.dst = WS_WKV1; break;
        }
    } else {
        switch (i) {
            case 0: t.W = p.in[22]; t.gain = p.in[21]; t.N = 2 * DFF; t.mode = 1; t.dst = WS_FF1IN; break;
            case 1: t.W = p.in[23]; t.K = DFF; t.dst = WS_FF1OUT; break;
            case 2: t.W = p.in[25]; t.gain = p.in[24]; t.N = 2560; t.dst = WS_MIXIN; break;
            case 3: t.W = p.in[27]; t.dst = WS_MIXOUT; break;
            case 4: t.W = p.in[30]; t.gain = p.in[28]; t.dst = WS_WQ; break;
            case 5: t.W = p.in[32]; t.dst = WS_WO; break;
            case 6: t.W = p.in[34]; t.gain = p.in[33]; t.N = 2 * DFF; t.mode = 1; t.dst = WS_FF2IN; break;
            default: t.W = p.in[35]; t.K = DFF; t.dst = WS_FF2OUT; break;
        }
    }
    return t;
}
template <int layer>
__device__ __forceinline__ void convert_weights(const Params& p, LAS unsigned char* lds, int gw, int ngw, int wave, int lane) {
    LAS float* scr = (LAS float*)(lds + wave * 16384);
    constexpr int nmat = layer == 0 ? 10 : 8;
#pragma unroll
    for (int i = 0; i < nmat; ++i) {
        const TD t = get_td(p, layer, i);
        const float* W = t.W; bf16* WT = (bf16*)(p.ws + t.dst);
        const int items = (t.K / 64) * (t.N / 32);
        for (int it = gw; it < items; it += ngw) transpose_item(W, t.gain, t.K, t.N, WT, t.mode, scr, it, lane);
    }
}
__device__ __forceinline__ void norm_row(const float* xrow, const float* gain, bf16* orow, float* of, int lane) {
    const f32x4* xr = (const f32x4*)xrow + lane;
    f32x4 v[8]; float s = 0.f;
#pragma unroll
    for (int j = 0; j < 8; ++j) { v[j] = xr[64 * j]; s += (v[j].x * v[j].x + v[j].y * v[j].y) + (v[j].z * v[j].z + v[j].w * v[j].w); }
    const float rstd = rsqrtf(wave_sum(s) * (1.f / DM) + EPS);
    const f32x4* gr = (const f32x4*)gain + lane;
#pragma unroll
    for (int j = 0; j < 8; ++j) { const f32x4 g = gr[64 * j]; const f32x4 y = v[j] * rstd * g;
        if (of) ((f32x4*)of)[64 * j + lane] = y;
        else { u32x2 w; w.x = pk2(y.x, y.y); w.y = pk2(y.z, y.w); ((u32x2*)orow)[64 * j + lane] = w; } }
}
__device__ __forceinline__ void cast_rows_ssq(const float* x, bf16* xb, float* ssq, int nrows, int gw, int ngw, int lane) {
    for (int m = gw; m < nrows; m += ngw) { const f32x4* xr = (const f32x4*)(x + (size_t)m * DM) + lane; float s_ = 0.f; f32x4 v[8];
#pragma unroll
        for (int j = 0; j < 8; ++j) v[j] = xr[64 * j];
#pragma unroll
        for (int j = 0; j < 8; ++j) { s_ += (v[j].x * v[j].x + v[j].y * v[j].y) + (v[j].z * v[j].z + v[j].w * v[j].w);
            u32x2 w; w.x = pk2(v[j].x, v[j].y); w.y = pk2(v[j].z, v[j].w); ((u32x2*)(xb + (size_t)m * DM))[64 * j + lane] = w; }
        s_ = wave_sum(s_); if (lane < 8) ssq[(size_t)m * 8 + lane] = lane == 0 ? s_ : 0.f; }
}
__device__ __forceinline__ void norm_row2(const float* xa, const float* xb_, const float* gain, bf16* oa, bf16* ob_, float* fa, float* fb, int lane) {
    const f32x4* ra = (const f32x4*)xa + lane; const f32x4* rb = (const f32x4*)xb_ + lane;
    f32x4 va[8], vb[8]; float sa = 0.f, sb = 0.f;
#pragma unroll
    for (int j = 0; j < 8; ++j) { va[j] = ra[64 * j]; vb[j] = rb[64 * j]; }
#pragma unroll
    for (int j = 0; j < 8; ++j) { sa += (va[j].x * va[j].x + va[j].y * va[j].y) + (va[j].z * va[j].z + va[j].w * va[j].w); sb += (vb[j].x * vb[j].x + vb[j].y * vb[j].y) + (vb[j].z * vb[j].z + vb[j].w * vb[j].w); }
    const float rsa = rsqrtf(wave_sum(sa) * (1.f / DM) + EPS), rsb = rsqrtf(wave_sum(sb) * (1.f / DM) + EPS);
    const f32x4* gr = (const f32x4*)gain + lane;
#pragma unroll
    for (int j = 0; j < 8; ++j) { const f32x4 g = gr[64 * j]; const f32x4 ya = va[j] * rsa * g, yb = vb[j] * rsb * g;
        if (fa) { ((f32x4*)fa)[64 * j + lane] = ya; ((f32x4*)fb)[64 * j + lane] = yb; }
        else { u32x2 wa, wb; wa.x = pk2(ya.x, ya.y); wa.y = pk2(ya.z, ya.w); wb.x = pk2(yb.x, yb.y); wb.y = pk2(yb.z, yb.w); ((u32x2*)oa)[64 * j + lane] = wa; ((u32x2*)ob_)[64 * j + lane] = wb; } }
}
__device__ __forceinline__ void norm_rows(const float* x, const float* gain, bf16* out, int nrows, int gw, int ngw, int lane) {
    int m = gw;
    for (; m + ngw < nrows; m += 2 * ngw) norm_row2(x + (size_t)m * DM, x + (size_t)(m + ngw) * DM, gain, out + (size_t)m * DM, out + (size_t)(m + ngw) * DM, nullptr, nullptr, lane);
    for (; m < nrows; m += ngw) norm_row(x + (size_t)m * DM, gain, out + (size_t)m * DM, nullptr, lane);
}

template <int HD, int NB, int NQ>
__device__ __forceinline__ void banded_unit(LAS unsigned char* lds, int tid, const bf16* __restrict__ qb, const bf16* __restrict__ kbp, const bf16* __restrict__ vbp, int ld,
                                            int dil, int r, int L, int qpos0, int ks, int nrows, int wave_row_off, int W, float slope, float scale, float m_init, float l_init,
                                            bf16* __restrict__ ob, int old, float* __restrict__ lseb) {
    constexpr int CH = HD / 8, ROWB = HD * 2, SWZ = (CH - 1) & 15, NK = HD / 32, ND = HD / 16;
    LAS unsigned char* Kt = lds; LAS unsigned char* Vt = lds + nrows * ROWB;
    for (int idx = tid; idx < nrows * CH; idx += 512) {
        const int row = idx / CH, ch = idx % CH, kp = ks + row;
        u32x4 k4 = (u32x4){0u, 0u, 0u, 0u}, v4 = (u32x4){0u, 0u, 0u, 0u};
        if (kp >= 0 && kp < L) { const size_t off = (size_t)(kp * dil + r) * ld + ch * 8; k4 = *(const u32x4*)(kbp + off); v4 = *(const u32x4*)(vbp + off); }
        const int lo = row * ROWB + ((ch ^ (row & SWZ)) << 4);
        *(LAS u32x4*)(Kt + lo) = k4; *(LAS u32x4*)(Vt + lo) = v4;
    }
    __syncthreads();
    const int lane = tid & 63, g = lane >> 4, c = lane & 15;
    bf16x8 qf[NQ][NK]; f32x4 O[NQ][ND]; float m[NQ], l[NQ];
#pragma unroll
    for (int qi = 0; qi < NQ; ++qi) { const size_t qtok = (size_t)((qpos0 + 16 * qi + c) * dil + r);
#pragma unroll
        for (int k = 0; k < NK; ++k) qf[qi][k] = *(const bf16x8*)(qb + qtok * ld + k * 32 + g * 8);
#pragma unroll
        for (int d = 0; d < ND; ++d) O[qi][d] = (f32x4){0.f, 0.f, 0.f, 0.f};
        m[qi] = m_init; l[qi] = (g == 0) ? l_init : 0.f; }
    const int krow_a = (c >> 2) * 8 + (c & 3), vrow_a = g * 8 + (c >> 2), vch = (c & 3) >> 1, vhalf = (c & 1) * 8;
    for (int kb = 0; kb < NB; ++kb) {
        const int R0 = wave_row_off + kb * 32;
        const int ra = R0 + krow_a, rb = ra + 4;
        bf16x8 ka[NK], kbf[NK];
#pragma unroll
        for (int k = 0; k < NK; ++k) { const int chunk = k * 4 + g;
            ka[k] = lds16(Kt + ra * ROWB + ((chunk ^ (ra & SWZ)) << 4)); kbf[k] = lds16(Kt + rb * ROWB + ((chunk ^ (rb & SWZ)) << 4)); }
        const int r0 = R0 + vrow_a, r1 = r0 + 4;
        bf16x8 vf[ND];
#pragma unroll
        for (int d = 0; d < ND; ++d) { const int chunk = d * 2 + vch;
            vf[d] = vtr8(Vt + r0 * ROWB + ((chunk ^ (r0 & SWZ)) << 4) + vhalf, Vt + r1 * ROWB + ((chunk ^ (r1 & SWZ)) << 4) + vhalf); }
        const int kp0 = ks + R0 + g * 8;
#pragma unroll
        for (int qi = 0; qi < NQ; ++qi) {
            const int qb0 = qpos0 + 16 * qi;
            if (NQ > 1 && !((ks + R0 + 31 >= qb0 - W) && (ks + R0 <= qb0 + 15 + W))) continue;
            const int qpos = qb0 + c;
            f32x4 s0 = (f32x4){0.f, 0.f, 0.f, 0.f}, s1 = s0;
#pragma unroll
            for (int k = 0; k < NK; ++k) { s0 = mfma16(ka[k], qf[qi][k], s0); s1 = mfma16(kbf[k], qf[qi][k], s1); }
            float sv[8]; float bm = -1e30f;
#pragma unroll
            for (int jj = 0; jj < 8; ++jj) { const int kp = kp0 + jj; const int dd = kp - qpos; const int ad = dd < 0 ? -dd : dd; const bool valid = (ad <= W) && (kp >= 0) && (kp < L);
                const float raw = jj < 4 ? s0[jj & 3] : s1[jj & 3];
                sv[jj] = valid ? raw * scale - slope * (float)ad : -1e30f; bm = fmaxf(bm, sv[jj]); }
            bm = fmaxf(bm, __shfl_xor(bm, 16)); bm = fmaxf(bm, __shfl_xor(bm, 32));
            const float m_new = fmaxf(m[qi], bm), alpha = __expf(m[qi] - m_new);
            float ps = 0.f;
#pragma unroll
            for (int jj = 0; jj < 8; ++jj) { sv[jj] = __expf(sv[jj] - m_new); ps += sv[jj]; }
            l[qi] = l[qi] * alpha + ps; m[qi] = m_new;
            u32x4 pw; pw.x = pk2(sv[0], sv[1]); pw.y = pk2(sv[2], sv[3]); pw.z = pk2(sv[4], sv[5]); pw.w = pk2(sv[6], sv[7]);
            const bf16x8 pf = __builtin_bit_cast(bf16x8, pw);
#pragma unroll
            for (int d = 0; d < ND; ++d) O[qi][d] = mfma16(vf[d], pf, O[qi][d] * alpha);
        }
    }
#pragma unroll
    for (int qi = 0; qi < NQ; ++qi) { const size_t qtok = (size_t)((qpos0 + 16 * qi + c) * dil + r);
        float lt = l[qi]; lt += __shfl_xor(lt, 16); lt += __shfl_xor(lt, 32);
        const float inv = 1.f / lt;
#pragma unroll
        for (int d = 0; d < ND; ++d) { u32x2 w; w.x = pk2(O[qi][d][0] * inv, O[qi][d][1] * inv); w.y = pk2(O[qi][d][2] * inv, O[qi][d][3] * inv); *(u32x2*)(ob + qtok * old + d * 16 + g * 4) = w; }
        if (lseb != nullptr && g == 0) lseb[qtok * 8] = m[qi] + __logf(lt); }
    __syncthreads();
}

__device__ __forceinline__ void xa_dma(const bf16* __restrict__ base, int dc, LAS unsigned char* buf, int w, unsigned voff) {
    const char* ub = (const char*)base + (size_t)dc * 256;
#pragma unroll
    for (int j = 0; j < 8; ++j)
        __builtin_amdgcn_global_load_lds((const unsigned*)(ub + (size_t)j * 262144 + voff), (LAS unsigned*)(buf + (j * 8 + w) * 1024), 16, 0, 0);
}
__device__ __forceinline__ void xattn_unit(LAS unsigned char* lds, int tid, const bf16* __restrict__ qx, const bf16* __restrict__ kv, bf16* __restrict__ obuf, int u) {
    const int b = u >> 6, h = (u >> 4) & 3, qt = u & 15;
    const int lane = tid & 63, w = __builtin_amdgcn_readfirstlane(tid >> 6), g = lane >> 4, c = lane & 15;
    const size_t token = (size_t)b * SEQ + qt * 128 + 16 * w + c;
    const bf16* qrow = qx + token * DM + h * 512;
    const bf16* kbase = kv + (size_t)(b * MEMLEN) * 4096 + h * 512; const bf16* vbase = kbase + 2048;
    const int krow_a = (c >> 2) * 8 + (c & 3), vrow_a = g * 8 + (c >> 2), vch = (c & 3) >> 1, vhalf = (c & 1) * 8;
    const int drow = 4 * w + (lane >> 4);
    const unsigned voff = (unsigned)(drow * 8192 + (((lane & 15) ^ (drow & 15)) << 4));
    int offK[2][4], offV[2][8];
#pragma unroll
    for (int t = 0; t < 2; ++t) { const int rk = krow_a + 4 * t, rv = vrow_a + 4 * t;
#pragma unroll
        for (int k = 0; k < 4; ++k) offK[t][k] = rk * 256 + (((k * 4 + g) ^ (rk & 15)) << 4);
#pragma unroll
        for (int d = 0; d < 8; ++d) offV[t][d] = rv * 256 + (((d * 2 + vch) ^ (rv & 15)) << 4) + vhalf; }
    f32x4 S[16];
#pragma unroll
    for (int i = 0; i < 16; ++i) S[i] = (f32x4){0.f, 0.f, 0.f, 0.f};
    xa_dma(kbase, 0, lds, w, voff);
    asm volatile("s_waitcnt vmcnt(0)" ::: "memory"); __syncthreads();
    for (int dc = 0; dc < 4; ++dc) {
        LAS unsigned char* cur = lds + (dc & 1) * 65536;
        bf16x8 qf[4];
#pragma unroll
        for (int k = 0; k < 4; ++k) qf[k] = *(const bf16x8*)(qrow + dc * 128 + k * 32 + g * 8);
#pragma unroll
        for (int kb = 0; kb < 8; ++kb) {
#pragma unroll
            for (int k = 0; k < 4; ++k) {
                S[kb * 2] = mfma16(lds16(cur + offK[0][k] + kb * 8192), qf[k], S[kb * 2]);
                S[kb * 2 + 1] = mfma16(lds16(cur + offK[1][k] + kb * 8192), qf[k], S[kb * 2 + 1]); }
            asm volatile("" : "+v"(S[kb * 2]), "+v"(S[kb * 2 + 1]) :: "memory");
            if (kb == 0) xa_dma(dc < 3 ? kbase : vbase, (dc + 1) & 3, lds + ((dc + 1) & 1) * 65536, w, voff);
        }
        asm volatile("s_waitcnt vmcnt(0)" ::: "memory"); __syncthreads();
    }
    const float scale = 0.044194173824159216f;
    float mx = -1e30f;
#pragma unroll
    for (int i = 0; i < 16; ++i) { mx = fmaxf(mx, fmaxf(fmaxf(S[i][0], S[i][1]), fmaxf(S[i][2], S[i][3]))); }
    mx = fmaxf(mx, __shfl_xor(mx, 16)); mx = fmaxf(mx, __shfl_xor(mx, 32));
    float l = 0.f;
#pragma unroll
    for (int i = 0; i < 16; ++i)
#pragma unroll
        for (int j = 0; j < 4; ++j) { const float pv = __expf((S[i][j] - mx) * scale); S[i][j] = pv; l += pv; }
    l += __shfl_xor(l, 16); l += __shfl_xor(l, 32);
    const float inv = 1.f / l;
    bf16x8 pf[8];
#pragma unroll
    for (int kb = 0; kb < 8; ++kb) { u32x4 pw; pw.x = pk2(S[kb * 2][0], S[kb * 2][1]); pw.y = pk2(S[kb * 2][2], S[kb * 2][3]); pw.z = pk2(S[kb * 2 + 1][0], S[kb * 2 + 1][1]); pw.w = pk2(S[kb * 2 + 1][2], S[kb * 2 + 1][3]);
        pf[kb] = __builtin_bit_cast(bf16x8, pw); }
    for (int dc = 0; dc < 4; ++dc) {
        LAS unsigned char* cur = lds + (dc & 1) * 65536;
        if (dc < 3) xa_dma(vbase, dc + 1, lds + ((dc + 1) & 1) * 65536, w, voff);
#pragma unroll
        for (int d = 0; d < 8; ++d) {
            f32x4 O = (f32x4){0.f, 0.f, 0.f, 0.f};
#pragma unroll
            for (int kb = 0; kb < 8; ++kb) O = mfma16(vtr8(cur + offV[0][d] + kb * 8192, cur + offV[1][d] + kb * 8192), pf[kb], O);
            u32x2 wv; wv.x = pk2(O[0] * inv, O[1] * inv); wv.y = pk2(O[2] * inv, O[3] * inv);
            *(u32x2*)(obuf + token * DM + h * 512 + dc * 128 + d * 16 + g * 4) = wv;
            asm volatile("" ::: "memory");
        }
        asm volatile("s_waitcnt vmcnt(0)" ::: "memory"); __syncthreads();
    }
}

constexpr int G_BCUM = 0, G_X1 = 65536, G_X2 = 98304, G_ZS = 131072, G_RED = 139264;
__device__ __forceinline__ void gla_gates(LAS unsigned char* lds, int tid, const bf16* __restrict__ proj, size_t tok0, int h, const float* __restrict__ Wf, const float* __restrict__ bf_,
                                          const float* __restrict__ Wb, const float* __restrict__ bb_) {
    if (tid < 256) { const int t = tid >> 2, part = tid & 3; const u32x4 v = *(const u32x4*)(proj + (tok0 + t) * LD_AB + 6144 + part * 8);
        LAS f32x4* zp = (LAS f32x4*)(lds + G_ZS + (t * 32 + part * 8) * 4);
        zp[0] = (f32x4){bflo(v.x), bfhi(v.x), bflo(v.y), bfhi(v.y)}; zp[1] = (f32x4){bflo(v.z), bfhi(v.z), bflo(v.w), bfhi(v.w)}; }
    __syncthreads();
    if (tid < 256) {
        const int dir = tid >> 7, kk = tid & 127; const float* Wg = dir ? Wb : Wf; const float* bg = dir ? bb_ : bf_;
        float w[16];
#pragma unroll
        for (int r = 0; r < 16; ++r) w[r] = Wg[r * 512 + h * 128 + kk];
        const float bias = bg[h * 128 + kk];
        float cum = 0.f; LAS float* bc = (LAS float*)(lds + G_BCUM) + dir * 8192 + kk; const LAS unsigned char* zs = lds + G_ZS + dir * 64;
        for (int s = 0; s < 64; ++s) { const int t = dir ? 63 - s : s;
            const LAS f32x4* z4 = (const LAS f32x4*)(zs + t * 128);
            const f32x4 z0 = z4[0], z1 = z4[1], z2 = z4[2], z3 = z4[3];
            float u = bias;
            u += z0[0] * w[0] + z0[1] * w[1] + z0[2] * w[2] + z0[3] * w[3];
            u += z1[0] * w[4] + z1[1] * w[5] + z1[2] * w[6] + z1[3] * w[7];
            u += z2[0] * w[8] + z2[1] * w[9] + z2[2] * w[10] + z2[3] * w[11];
            u += z3[0] * w[12] + z3[1] * w[13] + z3[2] * w[14] + z3[3] * w[15];
            const float ls = fminf(u, 0.f) - __logf(1.f + __expf(-fabsf(u)));
            cum += ls * 0.0625f; bc[t * 128] = cum; }
    }
    __syncthreads();
}
__device__ __forceinline__ void gla_stage_v(LAS unsigned char* vdst, int tid, const bf16* __restrict__ proj, size_t tok0, int h) {
    for (int idx = tid; idx < 2048; idx += 512) { const int row = idx >> 5, ch = idx & 31;
        *(LAS u32x4*)(vdst + row * 512 + ((ch ^ (row & 15)) << 4)) = *(const u32x4*)(proj + (tok0 + row) * LD_AB + 4096 + h * 256 + ch * 8); }
}
__device__ __forceinline__ void gla_stage1_unit(LAS unsigned char* lds, int tid, const bf16* __restrict__ proj, int item, const float* Wf, const float* bf_, const float* Wb, const float* bb_,
                                                bf16* __restrict__ St, float* __restrict__ Dd) {
    const int b = item >> 7, h = (item >> 5) & 3, cidx = item & 31; const size_t tok0 = (size_t)b * SEQ + cidx * 64;
    gla_gates(lds, tid, proj, tok0, h, Wf, bf_, Wb, bb_);
    {
        const int kk = tid & 127, jq = tid >> 7;
        const LAS float* bcf = (const LAS float*)(lds + G_BCUM) + kk; const LAS float* bcb = bcf + 8192;
        const float blf = bcf[63 * 128], blb = bcb[0];
#pragma unroll
        for (int cc = 0; cc < 2; ++cc) { const int jc = jq * 2 + cc; float of[8], obk[8];
#pragma unroll
            for (int e = 0; e < 8; ++e) { const int j = jc * 8 + e; const float kv = __uint_as_float((unsigned)proj[(tok0 + j) * LD_AB + 3584 + h * 128 + kk] << 16);
                of[e] = kv * __expf(blf - bcf[j * 128]); obk[e] = kv * __expf(blb - bcb[j * 128]); }
            const int lo = kk * 128 + ((jc ^ (kk & 7)) << 4);
            *(LAS u32x4*)(lds + G_X1 + lo) = (u32x4){pk2(of[0], of[1]), pk2(of[2], of[3]), pk2(of[4], of[5]), pk2(of[6], of[7])};
            *(LAS u32x4*)(lds + G_X1 + 16384 + lo) = (u32x4){pk2(obk[0], obk[1]), pk2(obk[2], obk[3]), pk2(obk[4], obk[5]), pk2(obk[6], obk[7])}; }
        if (tid < 128) { Dd[(size_t)item * 128 + kk] = __expf(blf); Dd[(size_t)(1024 + item) * 128 + kk] = __expf(blb); }
    }
    gla_stage_v(lds + G_X2, tid, proj, tok0, h);
    __syncthreads();
    const int lane = tid & 63, w = tid >> 6, g = lane >> 4, c = lane & 15;
    const int vrow_a = g * 8 + (c >> 2), vch = (c & 3) >> 1, vhalf = (c & 1) * 8;
#pragma unroll
    for (int dbi = 0; dbi < 2; ++dbi) { const int db = 2 * w + dbi; bf16x8 vf[2];
#pragma unroll
        for (int ksj = 0; ksj < 2; ++ksj) { const int r0 = ksj * 32 + vrow_a, r1 = r0 + 4, chunk = db * 2 + vch;
            vf[ksj] = vtr8(lds + G_X2 + r0 * 512 + ((chunk ^ (r0 & 15)) << 4) + vhalf, lds + G_X2 + r1 * 512 + ((chunk ^ (r1 & 15)) << 4) + vhalf); }
#pragma unroll
        for (int dir = 0; dir < 2; ++dir)
#pragma unroll
            for (int nb = 0; nb < 8; ++nb) { f32x4 acc = (f32x4){0.f, 0.f, 0.f, 0.f}; const int kk = nb * 16 + c;
#pragma unroll
                for (int ksj = 0; ksj < 2; ++ksj) acc = mfma16(vf[ksj], lds16(lds + G_X1 + dir * 16384 + kk * 128 + (((ksj * 4 + g) ^ (kk & 7)) << 4)), acc);
                bf16* sp = St + ((size_t)(dir * 1024 + item) * 256 + db * 16 + g * 4) * 128 + kk;
#ifdef DBG_ZERO_ST
                for (int j = 0; j < 4; ++j) sp[j * 128] = (bf16)0; }
#else
                for (int j = 0; j < 4; ++j) sp[j * 128] = (bf16)(pk2(acc[j], 0.f) & 0xffffu); }
#endif
    }
    __syncthreads();
}
__device__ __forceinline__ void gla_scan(bf16* __restrict__ St, const float* __restrict__ Dd, int gtid, int nthreads) {
    for (int wi = gtid; wi < 262144; wi += nthreads) {
        const int dir = wi >> 17, bh = (wi >> 12) & 31, e8 = wi & 4095, kk0 = (e8 * 8) & 127;
        float st[8];
#pragma unroll
        for (int e = 0; e < 8; ++e) st[e] = 0.f;
#pragma unroll 8
        for (int s = 0; s < 32; ++s) { const int cidx = dir ? 31 - s : s; const size_t it = (size_t)dir * 1024 + bh * 32 + cidx;
            u32x4* sp = (u32x4*)(St + it * 32768 + e8 * 8); const u32x4 uu = *sp;
            const f32x4 d0 = *(const f32x4*)(Dd + it * 128 + kk0), d1 = *(const f32x4*)(Dd + it * 128 + kk0 + 4);
            *sp = (u32x4){pk2(st[0], st[1]), pk2(st[2], st[3]), pk2(st[4], st[5]), pk2(st[6], st[7])};
            st[0] = d0[0] * st[0] + bflo(uu.x); st[1] = d0[1] * st[1] + bfhi(uu.x); st[2] = d0[2] * st[2] + bflo(uu.y); st[3] = d0[3] * st[3] + bfhi(uu.y);
            st[4] = d1[0] * st[4] + bflo(uu.z); st[5] = d1[1] * st[5] + bfhi(uu.z); st[6] = d1[2] * st[6] + bflo(uu.w); st[7] = d1[3] * st[7] + bfhi(uu.w); }
    }
}
__device__ __forceinline__ void gla_stage3_unit(LAS unsigned char* lds, int tid, const bf16* __restrict__ proj, int item, const float* Wf, const float* bf_, const float* Wb, const float* bb_,
                                                const bf16* __restrict__ St, const float* __restrict__ head_norm, bf16* __restrict__ obuf) {
    const int b = item >> 7, h = (item >> 5) & 3, cidx = item & 31; const size_t tok0 = (size_t)b * SEQ + cidx * 64;
    gla_gates(lds, tid, proj, tok0, h, Wf, bf_, Wb, bb_);
    const float qscale = 0.08838834764831845f;
    for (int task = tid; task < 1024; task += 512) { const int row = task >> 4, ch = task & 15;
        const u32x4 q8 = *(const u32x4*)(proj + (tok0 + row) * LD_AB + 3072 + h * 128 + ch * 8), k8 = *(const u32x4*)(proj + (tok0 + row) * LD_AB + 3584 + h * 128 + ch * 8);
        const LAS f32x4* bfp = (const LAS f32x4*)(lds + G_BCUM + (row * 128 + ch * 8) * 4); const LAS f32x4* bbp = (const LAS f32x4*)(lds + G_BCUM + 32768 + (row * 128 + ch * 8) * 4);
        const f32x4 f0 = bfp[0], f1 = bfp[1], b0 = bbp[0], b1 = bbp[1];
        const float qv[8] = {bflo(q8.x), bfhi(q8.x), bflo(q8.y), bfhi(q8.y), bflo(q8.z), bfhi(q8.z), bflo(q8.w), bfhi(q8.w)};
        const float kvv[8] = {bflo(k8.x), bfhi(k8.x), bflo(k8.y), bfhi(k8.y), bflo(k8.z), bfhi(k8.z), bflo(k8.w), bfhi(k8.w)};
        const float bfv[8] = {f0[0], f0[1], f0[2], f0[3], f1[0], f1[1], f1[2], f1[3]}, bbv[8] = {b0[0], b0[1], b0[2], b0[3], b1[0], b1[1], b1[2], b1[3]};
        float qgf[8], qgb[8], kdf[8], kdb[8];
#pragma unroll
        for (int e = 0; e < 8; ++e) { const float ef = __expf(bfv[e]), eb = __expf(bbv[e]); qgf[e] = qv[e] * qscale * ef; qgb[e] = qv[e] * qscale * eb; kdf[e] = kvv[e] / ef; kdb[e] = kvv[e] / eb; }
        const int lo = row * 256 + ((ch ^ (row & 15)) << 4);
        *(LAS u32x4*)(lds + G_X1 + lo) = (u32x4){pk2(qgf[0], qgf[1]), pk2(qgf[2], qgf[3]), pk2(qgf[4], qgf[5]), pk2(qgf[6], qgf[7])};
        *(LAS u32x4*)(lds + G_X1 + 16384 + lo) = (u32x4){pk2(qgb[0], qgb[1]), pk2(qgb[2], qgb[3]), pk2(qgb[4], qgb[5]), pk2(qgb[6], qgb[7])};
        *(LAS u32x4*)(lds + G_X2 + lo) = (u32x4){pk2(kdf[0], kdf[1]), pk2(kdf[2], kdf[3]), pk2(kdf[4], kdf[5]), pk2(kdf[6], kdf[7])};
        *(LAS u32x4*)(lds + G_X2 + 16384 + lo) = (u32x4){pk2(kdb[0], kdb[1]), pk2(kdb[2], kdb[3]), pk2(kdb[4], kdb[5]), pk2(kdb[6], kdb[7])}; }
    __syncthreads();
    gla_stage_v(lds + G_BCUM, tid, proj, tok0, h);
    __syncthreads();
    const int lane = tid & 63, w = tid >> 6, g = lane >> 4, c = lane & 15, ib = w & 3, dh = w >> 2;
    const int krow_a = (c >> 2) * 8 + (c & 3), vrow_a = g * 8 + (c >> 2), vch = (c & 3) >> 1, vhalf = (c & 1) * 8;
    bf16x8 qg[2][4];
#pragma unroll
    for (int dir = 0; dir < 2; ++dir)
#pragma unroll
        for (int k = 0; k < 4; ++k) qg[dir][k] = lds16(lds + G_X1 + dir * 16384 + (ib * 16 + c) * 256 + (((k * 4 + g) ^ c) << 4));
    bf16x8 pf[2];
#pragma unroll
    for (int jb = 0; jb < 2; ++jb) { const int ra = jb * 32 + krow_a, rb = ra + 4;
        f32x4 sf0 = (f32x4){0.f, 0.f, 0.f, 0.f}, sf1 = sf0, sb0 = sf0, sb1 = sf0;
#pragma unroll
        for (int k = 0; k < 4; ++k) { const int chunk = k * 4 + g; const int oa = ra * 256 + ((chunk ^ (ra & 15)) << 4), obb = rb * 256 + ((chunk ^ (rb & 15)) << 4);
            sf0 = mfma16(lds16(lds + G_X2 + oa), qg[0][k], sf0); sf1 = mfma16(lds16(lds + G_X2 + obb), qg[0][k], sf1);
            sb0 = mfma16(lds16(lds + G_X2 + 16384 + oa), qg[1][k], sb0); sb1 = mfma16(lds16(lds + G_X2 + 16384 + obb), qg[1][k], sb1); }
        float pv[8]; const int iidx = ib * 16 + c;
#pragma unroll
        for (int jj = 0; jj < 8; ++jj) { const int jidx = jb * 32 + g * 8 + jj; const float vf_ = jj < 4 ? sf0[jj & 3] : sf1[jj & 3], vb_ = jj < 4 ? sb0[jj & 3] : sb1[jj & 3]; pv[jj] = (jidx <= iidx) ? vf_ : vb_; }
        u32x4 pw; pw.x = pk2(pv[0], pv[1]); pw.y = pk2(pv[2], pv[3]); pw.z = pk2(pv[4], pv[5]); pw.w = pk2(pv[6], pv[7]);
        pf[jb] = __builtin_bit_cast(bf16x8, pw); }
    f32x4 O[8]; float ssq = 0.f;
#pragma unroll
    for (int d = 0; d < 8; ++d) { const int dvb = dh * 8 + d; f32x4 acc = (f32x4){0.f, 0.f, 0.f, 0.f};
#pragma unroll
        for (int jb = 0; jb < 2; ++jb) { const int r0 = jb * 32 + vrow_a, r1 = r0 + 4, chunk = dvb * 2 + vch;
            acc = mfma16(vtr8(lds + G_BCUM + r0 * 512 + ((chunk ^ (r0 & 15)) << 4) + vhalf, lds + G_BCUM + r1 * 512 + ((chunk ^ (r1 & 15)) << 4) + vhalf), pf[jb], acc); }
#ifndef DBG_NO_INTER
#pragma unroll
        for (int dir = 0; dir < 2; ++dir) { const bf16* sp = St + ((size_t)(dir * 1024 + item) * 256 + dvb * 16 + c) * 128 + g * 8;
#pragma unroll
            for (int k = 0; k < 4; ++k) acc = mfma16(*(const bf16x8*)(sp + k * 32), qg[dir][k], acc); }
#endif
        O[d] = acc; ssq += (acc[0] * acc[0] + acc[1] * acc[1]) + (acc[2] * acc[2] + acc[3] * acc[3]); }
    ssq += __shfl_xor(ssq, 16); ssq += __shfl_xor(ssq, 32);
    LAS float* red = (LAS float*)(lds + G_RED);
    if (g == 0) red[w * 16 + c] = ssq;
    __syncthreads();
    const float tot = red[w * 16 + c] + red[(w ^ 4) * 16 + c];
    const float rstd = rsqrtf(tot * (1.f / 256.f) + EPS);
    const size_t token = tok0 + ib * 16 + c;
#pragma unroll
    for (int d = 0; d < 8; ++d) { const int dv0 = (dh * 8 + d) * 16 + g * 4;
        const f32x4 hn = *(const f32x4*)(head_norm + h * 256 + dv0); const u32x2 r2 = *(const u32x2*)(proj + token * LD_AB + 5120 + h * 256 + dv0);
        const float rv[4] = {bflo(r2.x), bfhi(r2.x), bflo(r2.y), bfhi(r2.y)}; float ov[4];
#pragma unroll
        for (int j = 0; j < 4; ++j) ov[j] = O[d][j] * rstd * hn[j] * pg8::silu_f(rv[j]);
        u32x2 wv; wv.x = pk2(ov[0], ov[1]); wv.y = pk2(ov[2], ov[3]); *(u32x2*)(obuf + token * DM + 1024 + h * 256 + dv0) = wv; }
    __syncthreads();
}
__device__ __forceinline__ void combine_a(const bf16* __restrict__ oc, const float* __restrict__ lse, bf16* __restrict__ obuf, int gtid, int nthreads) {
#pragma unroll 4
    for (int task = gtid; task < MTOK * 128; task += nthreads) { const int token = task >> 7, h = (task >> 4) & 7, ch = task & 15;
        const float l0 = lse[(size_t)token * 8 + h], l1 = lse[(size_t)(MTOK + token) * 8 + h], l2 = lse[(size_t)(2 * MTOK + token) * 8 + h];
        const float mx = fmaxf(l0, fmaxf(l1, l2)); float w0 = __expf(l0 - mx), w1 = __expf(l1 - mx), w2 = __expf(l2 - mx); const float inv = 1.f / (w0 + w1 + w2); w0 *= inv; w1 *= inv; w2 *= inv;
        const size_t off = (size_t)token * 1024 + h * 128 + ch * 8;
        const u32x4 a = *(const u32x4*)(oc + off), bq = *(const u32x4*)(oc + (size_t)MTOK * 1024 + off), cq = *(const u32x4*)(oc + (size_t)2 * MTOK * 1024 + off);
        u32x4 o;
        o.x = pk2(w0 * bflo(a.x) + w1 * bflo(bq.x) + w2 * bflo(cq.x), w0 * bfhi(a.x) + w1 * bfhi(bq.x) + w2 * bfhi(cq.x));
        o.y = pk2(w0 * bflo(a.y) + w1 * bflo(bq.y) + w2 * bflo(cq.y), w0 * bfhi(a.y) + w1 * bfhi(bq.y) + w2 * bfhi(cq.y));
        o.z = pk2(w0 * bflo(a.z) + w1 * bflo(bq.z) + w2 * bflo(cq.z), w0 * bfhi(a.z) + w1 * bfhi(bq.z) + w2 * bfhi(cq.z));
        o.w = pk2(w0 * bflo(a.w) + w1 * bflo(bq.w) + w2 * bflo(cq.w), w0 * bfhi(a.w) + w1 * bfhi(bq.w) + w2 * bfhi(cq.w));
        *(u32x4*)(obuf + (size_t)token * DM + h * 128 + ch * 8) = o; }
}

#define XB_TMO      128
#define XB_XCNT(j)  (256  + 64 * (j))
#define XB_XSUB(j)  (1280 + 64 * (j))
#define XB_XGEN(j)  (2304 + 64 * (j))
#define XB_TOP      3328
#define XB_TOPGEN   3392
#define XCD_BAR_WORDS 3456
#define XB_SPIN_CAP (1u << 18)

__device__ __forceinline__ unsigned xb_ld(unsigned* p)              { return __hip_atomic_load(p, __ATOMIC_RELAXED, __HIP_MEMORY_SCOPE_AGENT); }
__device__ __forceinline__ unsigned xb_add(unsigned* p, unsigned v) { return __hip_atomic_fetch_add(p, v, __ATOMIC_RELAXED, __HIP_MEMORY_SCOPE_AGENT); }
__device__ __forceinline__ unsigned xb_xcc_id() { return (unsigned)__builtin_amdgcn_s_getreg((3 << 11) | 20) & 0xFu; }
#define XB_SPIN(cond, bar) do { unsigned _sp = 0; while (cond) { __builtin_amdgcn_s_sleep(1); \
    if ((++_sp & 255u) == 0u) { if (xb_ld(&(bar)[XB_TMO])) break; if (_sp > XB_SPIN_CAP) { atomicAdd(&(bar)[XB_TMO], 1u); break; } } } } while (0)

struct XcdBarrier {
    unsigned* bar; unsigned x;
    volatile LAS unsigned* st;
};

__device__ __forceinline__ XcdBarrier xcd_barrier_post(unsigned* bar, volatile LAS unsigned* st) {
    XcdBarrier b; b.bar = bar; b.x = xb_xcc_id(); b.st = st;
    if (threadIdx.x == 0) (void)xb_add(&bar[XB_XCNT(b.x)], 1u);
    return b;
}
__device__ __forceinline__ void xcd_barrier_complete(unsigned* bar, unsigned x, unsigned& nloc, unsigned& nx) {
    const unsigned G = gridDim.x * gridDim.y * gridDim.z;
    unsigned sum, cnt, mine, sp = 0u;
    for (;;) {
        sum = 0u; cnt = 0u; mine = 0u;
#pragma unroll
        for (unsigned j = 0; j < 16; ++j) { const unsigned c = xb_ld(&bar[XB_XCNT(j)]); sum += c; cnt += (c > 0u) ? 1u : 0u; mine = (j == x) ? c : mine; }
        if (sum == G) break;
        __builtin_amdgcn_s_sleep(1);
        if ((++sp & 255u) == 0u) { if (xb_ld(&bar[XB_TMO])) break; if (sp > XB_SPIN_CAP) { atomicAdd(&bar[XB_TMO], 1u); break; } }
    }
    nloc = mine > 0u ? mine : 1u; nx = cnt > 0u ? cnt : 1u;
}

__device__ __forceinline__ void xcd_barrier(const XcdBarrier& b) {
    asm volatile("s_waitcnt vmcnt(0)" ::: "memory");
    __syncthreads();
    if (threadIdx.x == 0) {
        unsigned* bar = b.bar;
        __builtin_amdgcn_s_waitcnt(0);
        unsigned nloc = b.st[0], nx = b.st[1];
        if (nloc == 0u) { xcd_barrier_complete(bar, b.x, nloc, nx); b.st[0] = nloc; b.st[1] = nx; }
        const unsigned old = xb_add(&bar[XB_XSUB(b.x)], 1u);
        const unsigned gen = old / nloc;
        if (old + 1u == (gen + 1u) * nloc) {
            __builtin_amdgcn_fence(__ATOMIC_RELEASE, "agent");
            asm volatile("s_waitcnt vmcnt(0)" ::: "memory");
            const unsigned og = xb_add(&bar[XB_TOP], 1u);
            const unsigned tg = og / nx;
            if (og + 1u == (tg + 1u) * nx) xb_add(&bar[XB_TOPGEN], 1u);
            else XB_SPIN(xb_ld(&bar[XB_TOPGEN]) == tg, bar);
            __builtin_amdgcn_fence(__ATOMIC_ACQUIRE, "agent");
            xb_add(&bar[XB_XGEN(b.x)], 1u);
            asm volatile("s_waitcnt vmcnt(0)" ::: "memory");
        } else {
            XB_SPIN(xb_ld(&bar[XB_XGEN(b.x)]) == gen, bar);
            __builtin_amdgcn_fence(__ATOMIC_ACQUIRE, "agent");
            asm volatile("s_waitcnt vmcnt(0)" ::: "memory");
        }
    }
    __syncthreads();
}

__device__ __forceinline__ void gsync_cg(cg::grid_group& grid) {
    asm volatile("s_waitcnt vmcnt(0) lgkmcnt(0)" ::: "memory");
    grid.sync();
    __builtin_amdgcn_fence(__ATOMIC_ACQUIRE, "agent");
    asm volatile("s_waitcnt vmcnt(0)" ::: "memory");
}
#define gsync(grid_) xcd_barrier(xbar)

__device__ __forceinline__ int fresh_tid() { int t = threadIdx.x; asm volatile("" : "+v"(t)); return t; }
#ifndef DBG_STOP
#define DBG_STOP 0
#endif
#define DBG_CHECK(k) do { if (DBG_STOP == (k)) { for (int m_ = gw; m_ < MTOK; m_ += ngw) norm_row(X + (size_t)m_ * DM, p.in[36], nullptr, X + (size_t)m_ * DM, fresh_tid() & 63); return true; } } while (0)
template <int layer>
__device__ __forceinline__ bool run_layer(const Params& p, LAS unsigned char* lds, cg::grid_group& grid, const XcdBarrier& xbar, int wave, int G, int bid, int gw, int ngw, int nthreads) {
    unsigned char* ws = p.ws;
    bf16* Hb = (bf16*)(ws + WS_H); bf16* PROJ = (bf16*)(ws + WS_PROJ); bf16* OBUF = (bf16*)(ws + WS_OBUF); bf16* OC = (bf16*)(ws + WS_OC); float* LSE = (float*)(ws + WS_LSE);
    bf16* ST = (bf16*)(ws + WS_ST); float* DD = (float*)(ws + WS_DD); bf16* KV = (bf16*)(ws + WS_KV);
    float* X = p.out; float* SSQ = (float*)(p.ws + WS_SSQ);
        { pg8::Gemm g{Hb, (const bf16*)(ws + WS_FF1IN), MTOK, 2 * DFF, DM}; pg8::StaticOrder S; S.init(MTOK, 2 * DFF, G, bid); pg8::EpiSwiglu E{PROJ, DFF, SSQ + (size_t)(layer * 4 + 0) * (MTOK * 8)};
          pg8::gemm_phase<pg8::EpiSwiglu, pg8::StaticOrder, true, true>(lds, g, S, E);
#ifdef EXP_DUP_FFNIN
          if (layer == 0) pg8::gemm_phase<pg8::EpiSwiglu, pg8::StaticOrder, true, true>(lds, g, S, E);
#endif
        }
        gsync(grid);
        { pg8::Gemm g{PROJ, (const bf16*)(ws + WS_FF1OUT), MTOK, DM, DFF}; pg8::StaticOrder S; S.init(MTOK, DM, G, bid); pg8::EpiResid<true, false> E{Hb, nullptr, SSQ + (size_t)(layer * 4 + 1) * (MTOK * 8), (LAS float*)(lds + 131072)};
          pg8::gemm_phase<pg8::EpiResid<true, false>, pg8::StaticOrder, true, true>(lds, g, S, E); }
        gsync(grid);
        if (layer == 0) {
            { pg8::Gemm g{Hb, (const bf16*)(ws + WS_MIXIN), MTOK, LD_AB, DM}; pg8::StaticOrder S; S.init(MTOK, LD_AB, G, bid); pg8::EpiPlain E{PROJ, LD_AB, SSQ + (size_t)(layer * 4 + 1) * (MTOK * 8)};
              pg8::gemm_phase<pg8::EpiPlain, pg8::StaticOrder, true, true>(lds, g, S, E); }
            gsync(grid);
#ifdef EXP_DUP_MA
            for (int rep_ = 0; rep_ < 2; ++rep_) {
#else
            {
#endif
#ifndef DBG_NO_A
            { const int tid = fresh_tid();
            for (int u = bid; u < 3072; u += G) {
                const int cfg = u >> 10; int v = u & 1023; const int h = v & 7; v >>= 3; const int b = v >> 4, rest = v & 15;
                const int dil = cfg == 0 ? 1 : (cfg == 1 ? 4 : 16), tiles = 16 / dil, r = rest / tiles, tile = rest % tiles, L = SEQ / dil, q0 = tile * 128;
                const bf16* base = PROJ + (size_t)b * SEQ * LD_AB + h * 128;
                const float slope = exp2f(-(float)(h + 1)) * (float)dil;
                banded_unit<128, 5, 1>(lds, tid, base, base + 1024, base + 2048, LD_AB, dil, r, L, q0 + 16 * wave, q0 - 64, 272, 16 * wave, 64, slope, 0.08838834764831845f, -1e30f, 0.f,
                                    OC + (size_t)cfg * MTOK * 1024 + (size_t)b * SEQ * 1024 + h * 128, 1024, LSE + (size_t)cfg * MTOK * 8 + (size_t)b * SEQ * 8 + h);
            } }
#endif
#ifndef DBG_NO_GLA
            { const int tid = fresh_tid(); for (int u = bid; u < 1024; u += G) gla_stage1_unit(lds, tid, PROJ, u, p.in[7], p.in[8], p.in[9], p.in[10], ST, DD); }
#endif
            }
            gsync(grid);
#if !defined(DBG_NO_GLA) && !defined(DBG_NO_SCAN)
            gla_scan(ST, DD, bid * 512 + fresh_tid(), nthreads);
#endif
            gsync(grid);
#ifdef EXP_DUP_MC
            for (int rep_ = 0; rep_ < 2; ++rep_) {
#else
            {
#endif
#ifndef DBG_NO_GLA
            { const int tid = fresh_tid(); for (int u = bid; u < 1024; u += G) gla_stage3_unit(lds, tid, PROJ, u, p.in[7], p.in[8], p.in[9], p.in[10], ST, p.in[11], OBUF); }
#else
            for (int t_ = bid * 512 + fresh_tid(); t_ < MTOK * 128; t_ += nthreads) *(u32x4*)(OBUF + (size_t)(t_ >> 7) * DM + 1024 + (t_ & 127) * 8) = (u32x4){0u, 0u, 0u, 0u};
#endif
#ifndef DBG_NO_A
            combine_a(OC, LSE, OBUF, bid * 512 + fresh_tid(), nthreads);
#else
            for (int t_ = bid * 512 + fresh_tid(); t_ < MTOK * 128; t_ += nthreads) *(u32x4*)(OBUF + (size_t)(t_ >> 7) * DM + (t_ & 127) * 8) = (u32x4){0u, 0u, 0u, 0u};
#endif
            }
            gsync(grid);
        } else {
            { pg8::Gemm g{Hb, (const bf16*)(ws + WS_MIXIN), MTOK, LD_C, DM}; pg8::StaticOrder S; S.init(MTOK, LD_C, G, bid); pg8::EpiPlain E{PROJ, LD_C, SSQ + (size_t)(layer * 4 + 1) * (MTOK * 8)};
              pg8::gemm_phase<pg8::EpiPlain, pg8::StaticOrder, true, true>(lds, g, S, E); }
            gsync(grid);
#ifdef EXP_DUP_C
            for (int rep_ = 0; rep_ < 2; ++rep_)
#endif
            { const int tid = fresh_tid();
            for (int u = bid; u < 1024; u += G) {
                const int qt = u & 31, gk = (u >> 5) & 3, b = u >> 7, head = gk * 8 + wave;
                const bf16* base = PROJ + (size_t)b * SEQ * LD_C;
                banded_unit<64, 10, 4>(lds, tid, base + head * 64, base + 2048 + gk * 64, base + 2304 + gk * 64, LD_C, 1, 0, SEQ, qt * 64, qt * 64 - 128, 320, 0, 128,
                                   exp2f(-0.25f * (float)(head + 1)), 0.125f, p.in[26][head], 1.f, OBUF + (size_t)b * SEQ * DM + head * 64, DM, nullptr);
            } }
            gsync(grid);
        }
        { pg8::Gemm g{OBUF, (const bf16*)(ws + WS_MIXOUT), MTOK, DM, DM}; pg8::StaticOrder S; S.init(MTOK, DM, G, bid); pg8::EpiResid<false, false> E{Hb, nullptr, SSQ + (size_t)(layer * 4 + 2) * (MTOK * 8), (LAS float*)(lds + 131072)};
          pg8::gemm_phase<pg8::EpiResid<false, false>, pg8::StaticOrder, true, true>(lds, g, S, E); }
        gsync(grid);
        { pg8::Gemm g{Hb, (const bf16*)(ws + WS_WQ), MTOK, DM, DM}; pg8::StaticOrder S; S.init(MTOK, DM, G, bid); pg8::EpiPlain E{PROJ, DM, SSQ + (size_t)(layer * 4 + 2) * (MTOK * 8)};
          pg8::gemm_phase<pg8::EpiPlain, pg8::StaticOrder, true, true>(lds, g, S, E); }
        gsync(grid);
        { const int tid = fresh_tid(); for (int u = bid; u < 512; u += G) xattn_unit(lds, tid, PROJ, KV + (size_t)layer * NBATCH * MEMLEN * 4096, OBUF, u); }
#ifdef EXP_DUP_XATTN
        { const int tid = fresh_tid(); for (int u = bid; u < 512; u += G) xattn_unit(lds, tid, PROJ, KV + (size_t)layer * NBATCH * MEMLEN * 4096, OBUF, u); }
#endif
        gsync(grid);
        { pg8::Gemm g{OBUF, (const bf16*)(ws + WS_WO), MTOK, DM, DM}; pg8::StaticOrder S; S.init(MTOK, DM, G, bid); pg8::EpiResid<false, false> E{Hb, nullptr, SSQ + (size_t)(layer * 4 + 3) * (MTOK * 8), (LAS float*)(lds + 131072)};
          pg8::gemm_phase<pg8::EpiResid<false, false>, pg8::StaticOrder, true, true>(lds, g, S, E); }
        gsync(grid);
        { pg8::Gemm g{Hb, (const bf16*)(ws + WS_FF2IN), MTOK, 2 * DFF, DM}; pg8::StaticOrder S; S.init(MTOK, 2 * DFF, G, bid); pg8::EpiSwiglu E{PROJ, DFF, SSQ + (size_t)(layer * 4 + 3) * (MTOK * 8)};
          pg8::gemm_phase<pg8::EpiSwiglu, pg8::StaticOrder, true, true>(lds, g, S, E); }
        gsync(grid);
        { pg8::Gemm g{PROJ, (const bf16*)(ws + WS_FF2OUT), MTOK, DM, DFF}; pg8::StaticOrder S; S.init(MTOK, DM, G, bid); pg8::EpiResid<true, layer == 1> E{Hb, X, SSQ + (size_t)(layer * 4 + 4) * (MTOK * 8), (LAS float*)(lds + 131072)};
          pg8::gemm_phase<pg8::EpiResid<true, layer == 1>, pg8::StaticOrder, true, true>(lds, g, S, E); }
        gsync(grid);
        if (layer == 0) {
            convert_weights<1>(p, lds, gw, ngw, wave, fresh_tid() & 63);
            gsync(grid);
        } else {
            const int ftl = fresh_tid() & 63;
            int m = gw;
            for (; m + ngw < MTOK; m += 2 * ngw) norm_row2(X + (size_t)m * DM, X + (size_t)(m + ngw) * DM, p.in[36], nullptr, nullptr, X + (size_t)m * DM, X + (size_t)(m + ngw) * DM, ftl);
            for (; m < MTOK; m += ngw) norm_row(X + (size_t)m * DM, p.in[36], nullptr, X + (size_t)m * DM, ftl);
        }
    return false;
}

__global__ void __launch_bounds__(512, 2) mega_fwd(Params p) {
    extern __shared__ __attribute__((aligned(16))) unsigned char lds_raw[];
    LAS unsigned char* lds = (LAS unsigned char*)lds_raw;
    cg::grid_group grid = cg::this_grid();
    volatile LAS unsigned* xst = (volatile LAS unsigned*)(lds + LDS_BYTES - 64);
    if (threadIdx.x == 0) { xst[0] = 0u; xst[1] = 0u; }
    __syncthreads();
    const XcdBarrier xbar = xcd_barrier_post((unsigned*)(p.ws + WS_CTL), xst);
    const int wave = __builtin_amdgcn_readfirstlane((int)threadIdx.x >> 6);
    const int G = gridDim.x, bid = blockIdx.x, gw = bid * 8 + wave, ngw = G * 8, nthreads = G * 512;
    unsigned char* ws = p.ws;
    bf16* Hb = (bf16*)(ws + WS_H); bf16* PROJ = (bf16*)(ws + WS_PROJ); bf16* OBUF = (bf16*)(ws + WS_OBUF); bf16* OC = (bf16*)(ws + WS_OC); float* LSE = (float*)(ws + WS_LSE);
    bf16* ST = (bf16*)(ws + WS_ST); float* DD = (float*)(ws + WS_DD); bf16* KV = (bf16*)(ws + WS_KV); bf16* MEMH = (bf16*)(ws + WS_MEMH);
    float* X = p.out; float* SSQ = (float*)(p.ws + WS_SSQ);

    convert_weights<0>(p, lds, gw, ngw, wave, fresh_tid() & 63);
#ifdef EXP_DUP_CONVERT
    convert_weights<0>(p, lds, gw, ngw, wave, fresh_tid() & 63);
#endif
#ifdef EXP_SYNCS
    for (int i_ = 0; i_ < 20; ++i_) gsync(grid);
#endif
    norm_rows(p.in[1], p.in[14], MEMH, NBATCH * MEMLEN, gw, ngw, fresh_tid() & 63);
    norm_rows(p.in[1], p.in[29], MEMH + (size_t)NBATCH * MEMLEN * DM, NBATCH * MEMLEN, gw, ngw, fresh_tid() & 63);
    cast_rows_ssq(p.in[0], Hb, SSQ, MTOK, gw, ngw, fresh_tid() & 63);
    gsync_cg(grid);
    {
        pg8::Gemm g0{MEMH, (const bf16*)(ws + WS_WKV0), NBATCH * MEMLEN, 4096, DM}; pg8::StaticOrder S0; S0.init(NBATCH * MEMLEN, 4096, G, bid);
        pg8::EpiPlain E0{KV, 4096, nullptr};
        pg8::gemm_phase<pg8::EpiPlain, pg8::StaticOrder, true, true>(lds, g0, S0, E0);
        pg8::Gemm g1{MEMH + (size_t)NBATCH * MEMLEN * DM, (const bf16*)(ws + WS_WKV1), NBATCH * MEMLEN, 4096, DM}; pg8::StaticOrder S1; S1.init(NBATCH * MEMLEN, 4096, G, (bid + G / 2) % G);
        pg8::EpiPlain E1{KV + (size_t)NBATCH * MEMLEN * 4096, 4096, nullptr};
        pg8::gemm_phase<pg8::EpiPlain, pg8::StaticOrder, true, true>(lds, g1, S1, E1);
    }
    if (run_layer<0>(p, lds, grid, xbar, wave, G, bid, gw, ngw, nthreads)) return;
    if (run_layer<1>(p, lds, grid, xbar, wave, G, bid, gw, ngw, nthreads)) return;
}

extern "C" void kernel_launch(void* const* d_in, const int* in_sizes, int n_in, void* d_out, int out_size, void* d_ws, size_t ws_size, hipStream_t stream) {
    static int grid = 0;
    if (grid == 0) {
        if (n_in != 37 || out_size != MTOK * DM || ws_size < WS_END) { fprintf(stderr, "kernel_launch: unexpected shapes (n_in %d out %d ws %zu)\n", n_in, out_size, ws_size); grid = -1; return; }
        int dev = 0, cus = 0, per_cu = 0;
        hipGetDevice(&dev);
        hipDeviceGetAttribute(&cus, hipDeviceAttributeMultiprocessorCount, dev);
        hipFuncSetAttribute((const void*)mega_fwd, hipFuncAttributeMaxDynamicSharedMemorySize, LDS_BYTES);
        if (hipOccupancyMaxActiveBlocksPerMultiprocessor(&per_cu, (const void*)mega_fwd, 512, LDS_BYTES) != hipSuccess || per_cu < 1) per_cu = 1;
        (void)hipGetLastError();
        grid = cus * per_cu;
    }
    if (grid < 0) return;
    if (hipMemsetAsync((char*)d_ws + WS_CTL, 0, 16384, stream) != hipSuccess) { fprintf(stderr, "kernel_launch: memset of the barrier words failed\n"); return; }
    Params p{};
    for (int i = 0; i < 37; ++i) p.in[i] = (const float*)d_in[i];
    p.out = (float*)d_out; p.ws = (unsigned char*)d_ws;
    void* args[] = {&p};
    hipError_t e = hipLaunchCooperativeKernel((const void*)mega_fwd, dim3(grid), dim3(512), args, LDS_BYTES, stream);
    if (e != hipSuccess) fprintf(stderr, "cooperative launch failed: %s (grid %d)\n", hipGetErrorString(e), grid);
}
```

```cpp
#include <hip/hip_runtime.h>
#include <hip/hip_cooperative_groups.h>
#include <cstdio>
#include <cstdint>
namespace cg = cooperative_groups;
namespace pg8 {
#define PG8_LAS __attribute__((address_space(3)))
typedef unsigned short bf16_t;
typedef short bf16x8 __attribute__((ext_vector_type(8)));
typedef float f32x4 __attribute__((ext_vector_type(4)));
typedef unsigned u32x4 __attribute__((ext_vector_type(4)));
constexpr int BM = 256, BK = 64, HALF = 128, HTB = HALF * BK * 2  , STAGE_BYTES = 8 * HTB, NXCD = 8, WGM = 8;

__host__ __device__ __forceinline__ int lds_byte(int r, int c) { const int st = (r >> 4) * 2 + (c >> 5), rr = r & 15, cc = c & 31, ob = rr * 64 + cc * 2; return st * 1024 + (ob ^ (((ob >> 9) & 1) << 5)); }
__host__ __device__ __forceinline__ void stage_rc(int b, int& R, int& C) { const int st = b / 1024, sb = b % 1024, swz = sb ^ (((sb >> 9) & 1) << 5); R = (st >> 1) * 16 + swz / 64; C = (st & 1) * 32 + (swz % 64) / 2; }
__host__ __device__ __forceinline__ int perm32(int rho) { const int n = rho >> 4, i = rho & 15; return 8 * (i >> 2) + 4 * n + (i & 3); }

struct Unit { int pm, pn; };
struct Gemm { const bf16_t* A; const bf16_t* Bt; int M, N, K; };

struct StaticOrder {
    int nM, nN, nwg, G, c;
    __host__ __device__ void init(int M, int N, int G_, int c_) { nM = M / BM; nN = N / BM; nwg = nM * nN; G = G_; c = c_; }
    __host__ __device__ bool next(int i, Unit& u) const {
        const long L = (long)i * G + c; if (L >= nwg) return false;
        int wgid = (int)L; { const int q = nwg / NXCD, r = nwg % NXCD, xcd = wgid % NXCD, off = wgid / NXCD; wgid = (xcd < r ? xcd * (q + 1) : r * (q + 1) + (xcd - r) * q) + off; }
        const int nig = WGM * nN, gid = wgid / nig, fm = gid * WGM, gsz = (nM - fm) < WGM ? (nM - fm) : WGM;
        u.pm = fm + ((wgid % nig) % gsz); u.pn = (wgid % nig) / gsz; return true;
    }
    __device__ __forceinline__ void a_ready(const Unit&) const {}
    __device__ __forceinline__ void done(const Unit&) const {}
};

typedef float f32x2_cv __attribute__((ext_vector_type(2))); typedef __bf16 bf16x2_cv __attribute__((ext_vector_type(2)));
__device__ __forceinline__ unsigned cvt_pk_bf16(float lo, float hi) { const f32x2_cv v = {lo, hi}; const bf16x2_cv b = __builtin_convertvector(v, bf16x2_cv); return __builtin_bit_cast(unsigned, b); }
template <class Epi, class Sched, bool ALIGN_EPI = false, bool SP2 = false>
__device__ __forceinline__ void gemm_phase(PG8_LAS unsigned char* lds, const Gemm g, const Sched& S, const Epi& E) {
    int tid_l = threadIdx.x; asm volatile("" : "+v"(tid_l));
    const int tid = tid_l, wid = __builtin_amdgcn_readfirstlane(tid >> 6), lane = tid & 63, wr = wid >> 2, wc = wid & 3, fr = lane & 15, fq = lane >> 4;
    const int K = g.K, nt = K / BK;
    unsigned voffA[2], voffB[2];
#pragma unroll
    for (int i = 0; i < 2; ++i) { int R, C; stage_rc(tid * 16 + i * 8192, R, C); const int Rb = Epi::PERM ? ((R & ~31) + perm32(R & 31)) : R;
        voffA[i] = (unsigned)(R * K + C) * 2u; voffB[i] = (unsigned)(Rb * K + C) * 2u; }
    const size_t kstep = (size_t)(BK * 2);
    const size_t hstep = (size_t)HALF * K * 2;
    const size_t tstep = 2 * hstep;
    const unsigned ldsw = (unsigned)wid * 1024u;
    const int aoff = lds_byte(wr * 64 + fr, fq * 8), boff = lds_byte(wc * 32 + fr, fq * 8);
#define PG8_SA(b, h) (((b) * 2 + (h)) * HTB)
#define PG8_SB(b, h) ((4 + (b) * 2 + (h)) * HTB)
#define PG8_STAGE(bufoff, gbase, voff) do { _Pragma("unroll") for (int _i = 0; _i < 2; ++_i) \
        __builtin_amdgcn_global_load_lds((const unsigned*)((const char*)(gbase) + (voff)[_i]), (PG8_LAS unsigned*)(lds + (bufoff) + ldsw + _i * 8192), 16, 0, 0); } while (0)
#define PG8_LDA(dst, b, h) do { _Pragma("unroll") for (int m = 0; m < 4; ++m) _Pragma("unroll") for (int k = 0; k < 2; ++k) dst[m][k] = *(const PG8_LAS bf16x8*)(lds + PG8_SA(b, h) + aoff + m * 2048 + k * 1024); } while (0)
#define PG8_LDB(dst, b, h) do { _Pragma("unroll") for (int n = 0; n < 2; ++n) _Pragma("unroll") for (int k = 0; k < 2; ++k) dst[n][k] = *(const PG8_LAS bf16x8*)(lds + PG8_SB(b, h) + boff + n * 2048 + k * 1024); } while (0)
#define PG8_MMA(ai, bj, At, Bt) do { __builtin_amdgcn_s_setprio(1); _Pragma("unroll") for (int m = 0; m < 4; ++m) _Pragma("unroll") for (int n = 0; n < 2; ++n) _Pragma("unroll") for (int k = 0; k < 2; ++k) \
        acc[ai][bj][m][n] = __builtin_amdgcn_mfma_f32_16x16x32_bf16(Bt[n][k], At[m][k], acc[ai][bj][m][n], 0, 0, 0); __builtin_amdgcn_s_setprio(0); } while (0)
#define PG8_WAIT_V(n) asm volatile("s_waitcnt vmcnt(" #n ")" ::: "memory")
#define PG8_WAIT_L(n) asm volatile("s_waitcnt lgkmcnt(" #n ")" ::: "memory")
#define PG8_BAR __builtin_amdgcn_s_barrier()
#define PG8_SCHED __builtin_amdgcn_sched_barrier(0)
    Unit cur, nxt; int ui = 0;
    if (!S.next(0, cur)) return;
    f32x4 acc[2][2][4][2];
#pragma unroll
    for (int a = 0; a < 2; ++a)
#pragma unroll
        for (int b = 0; b < 2; ++b)
#pragma unroll
            for (int m = 0; m < 4; ++m)
#pragma unroll
                for (int n = 0; n < 2; ++n) acc[a][b][m][n] = (f32x4){0.f, 0.f, 0.f, 0.f};
    bf16x8 At[4][2], B0[2][2], B1[2][2];
    const char* cA = (const char*)g.A + (size_t)cur.pm * tstep; const char* cB = (const char*)g.Bt + (size_t)cur.pn * tstep;
    S.a_ready(cur);
    if constexpr (SP2) {
        PG8_STAGE(PG8_SB(0, 0), cB, voffB); PG8_STAGE(PG8_SB(0, 1), cB + hstep, voffB); PG8_STAGE(PG8_SA(0, 0), cA, voffA); PG8_STAGE(PG8_SA(0, 1), cA + hstep, voffA);
        if (wr == 1) PG8_BAR;
        PG8_WAIT_V(2); PG8_BAR;
        PG8_STAGE(PG8_SB(1, 0), cB + kstep, voffB); PG8_STAGE(PG8_SA(1, 0), cA + kstep, voffA); PG8_STAGE(PG8_SB(1, 1), cB + hstep + kstep, voffB);
        PG8_WAIT_V(6); PG8_BAR;
    } else {
        PG8_STAGE(PG8_SB(0, 0), cB, voffB); PG8_STAGE(PG8_SA(0, 0), cA, voffA); PG8_STAGE(PG8_SB(0, 1), cB + hstep, voffB); PG8_STAGE(PG8_SA(0, 1), cA + hstep, voffA);
        if (wr == 1) PG8_BAR;
        PG8_WAIT_V(4); PG8_BAR;
        PG8_STAGE(PG8_SB(1, 0), cB + kstep, voffB); PG8_STAGE(PG8_SA(1, 0), cA + kstep, voffA); PG8_STAGE(PG8_SB(1, 1), cB + hstep + kstep, voffB);
        PG8_WAIT_V(6); PG8_BAR;
    }
    for (;;) {
        const bool has_next = S.next(ui + 1, nxt);
        const char* nA = has_next ? (const char*)g.A + (size_t)nxt.pm * tstep : cA; const char* nB = has_next ? (const char*)g.Bt + (size_t)nxt.pn * tstep : cB;
        for (int t = 0; t < nt; t += 2) {
            const bool last = (t == nt - 2);
            const char* a1 = cA + (size_t)(t + 1) * kstep;
            const char* a2 = last ? nA : cA + (size_t)(t + 2) * kstep; const char* b2 = last ? nB : cB + (size_t)(t + 2) * kstep;
            const char* a3 = a2 + kstep; const char* b3 = b2 + kstep;
            if (last && has_next) S.a_ready(nxt);
            if constexpr (SP2) {
            PG8_LDB(B0, 0, 0); PG8_LDB(B1, 0, 1); PG8_SCHED; PG8_LDA(At, 0, 0); PG8_STAGE(PG8_SA(1, 1), a1 + hstep, voffA);
            PG8_WAIT_V(8); PG8_WAIT_L(0); PG8_BAR; PG8_MMA(0, 0, At, B0); PG8_MMA(0, 1, At, B1); PG8_BAR; PG8_SCHED;
            PG8_LDA(At, 0, 1); PG8_STAGE(PG8_SB(0, 0), b2, voffB); PG8_STAGE(PG8_SB(0, 1), b2 + hstep, voffB); PG8_STAGE(PG8_SA(0, 0), a2, voffA);
            PG8_WAIT_V(8); PG8_WAIT_L(0); PG8_BAR; PG8_MMA(1, 0, At, B0); PG8_MMA(1, 1, At, B1); PG8_BAR; PG8_SCHED;
            PG8_LDB(B0, 1, 0); PG8_LDB(B1, 1, 1); PG8_SCHED; PG8_LDA(At, 1, 0); PG8_STAGE(PG8_SA(0, 1), a2 + hstep, voffA);
            PG8_WAIT_V(8); PG8_WAIT_L(0); PG8_BAR; PG8_MMA(0, 0, At, B0); PG8_MMA(0, 1, At, B1); PG8_BAR; PG8_SCHED;
            PG8_LDA(At, 1, 1); PG8_STAGE(PG8_SB(1, 0), b3, voffB); PG8_STAGE(PG8_SB(1, 1), b3 + hstep, voffB); PG8_STAGE(PG8_SA(1, 0), a3, voffA);
            PG8_WAIT_V(8); PG8_WAIT_L(0); PG8_BAR; PG8_MMA(1, 0, At, B0); PG8_MMA(1, 1, At, B1); PG8_BAR; PG8_SCHED;
            } else {
            PG8_LDB(B0, 0, 0); PG8_SCHED; PG8_LDA(At, 0, 0); PG8_STAGE(PG8_SA(1, 1), a1 + hstep, voffA);
            PG8_WAIT_L(8); PG8_BAR; PG8_WAIT_L(0); PG8_MMA(0, 0, At, B0); PG8_BAR; PG8_SCHED;
            PG8_LDB(B1, 0, 1); PG8_STAGE(PG8_SB(0, 0), b2, voffB);
            PG8_BAR; PG8_WAIT_L(0); PG8_MMA(0, 1, At, B1); PG8_BAR;
            PG8_LDA(At, 0, 1); PG8_STAGE(PG8_SA(0, 0), a2, voffA);
            PG8_BAR; PG8_WAIT_L(0); PG8_MMA(1, 0, At, B0); PG8_BAR; PG8_SCHED;
            PG8_STAGE(PG8_SB(0, 1), b2 + hstep, voffB);
            PG8_WAIT_V(6); PG8_BAR; PG8_MMA(1, 1, At, B1); PG8_BAR;
            PG8_LDB(B0, 1, 0); PG8_SCHED; PG8_LDA(At, 1, 0); PG8_STAGE(PG8_SA(0, 1), a2 + hstep, voffA);
            PG8_WAIT_L(8); PG8_BAR; PG8_WAIT_L(0); PG8_MMA(0, 0, At, B0); PG8_BAR; PG8_SCHED;
            PG8_LDB(B1, 1, 1); PG8_STAGE(PG8_SB(1, 0), b3, voffB);
            PG8_BAR; PG8_WAIT_L(0); PG8_MMA(0, 1, At, B1); PG8_BAR;
            PG8_LDA(At, 1, 1); PG8_STAGE(PG8_SA(1, 0), a3, voffA);
            PG8_BAR; PG8_WAIT_L(0); PG8_MMA(1, 0, At, B0); PG8_BAR; PG8_SCHED;
            PG8_STAGE(PG8_SB(1, 1), b3 + hstep, voffB);
            PG8_WAIT_V(6); PG8_BAR; PG8_MMA(1, 1, At, B1); PG8_BAR;
            }
        }
        if constexpr (ALIGN_EPI) { if (wr == 0) PG8_BAR; }
        if constexpr (!Epi::AFTER_DRAIN) { E(acc, cur, wr, wc, fr, fq); S.done(cur); }
        if (!has_next) break;
#pragma unroll
        for (int a = 0; a < 2; ++a)
#pragma unroll
            for (int b = 0; b < 2; ++b)
#pragma unroll
                for (int m = 0; m < 4; ++m)
#pragma unroll
                    for (int n = 0; n < 2; ++n) acc[a][b][m][n] = (f32x4){0.f, 0.f, 0.f, 0.f};
        cur = nxt; cA = nA; cB = nB; ++ui;
        if constexpr (ALIGN_EPI) { if (wr == 1) PG8_BAR; }
    }
    PG8_WAIT_V(0);
    if constexpr (!ALIGN_EPI) { if (wr == 0) PG8_BAR; }
    PG8_BAR;
    if constexpr (Epi::AFTER_DRAIN) { E.fused(acc, cur, wr, wc, fr, fq, lds, wid, lane); S.done(cur); }
#undef PG8_SA
#undef PG8_SB
#undef PG8_STAGE
#undef PG8_LDA
#undef PG8_LDB
#undef PG8_MMA
#undef PG8_WAIT_V
#undef PG8_WAIT_L
#undef PG8_BAR
#undef PG8_SCHED
}
}

namespace pg8 {
struct OneUnit {
    Unit u0;
    __device__ __forceinline__ bool next(int i, Unit& u) const { if (i != 0) return false; u = u0; return true; }
    __device__ __forceinline__ void a_ready(const Unit&) const {}
    __device__ __forceinline__ void done(const Unit&) const {}
};
struct EpiPlain {
    static constexpr bool PERM = true, AFTER_DRAIN = false;
    bf16_t* O; int ldc; const float* ssq;
    __device__ __forceinline__ void operator()(const f32x4 (&acc)[2][2][4][2], const Unit& u, int wr, int wc, int fr, int fq) const {
        const int row0 = u.pm * BM + wr * 64 + fr, col0 = u.pn * BM + wc * 32 + 8 * fq;
#pragma unroll
        for (int ai = 0; ai < 2; ++ai)
#pragma unroll
            for (int m = 0; m < 4; ++m) { const int row = row0 + ai * HALF + m * 16; bf16_t* rowp = O + (size_t)row * ldc + col0;
                float rs = 1.f; if (ssq) { const f32x4 p0 = *(const f32x4*)(ssq + (size_t)row * 8), p1 = *(const f32x4*)(ssq + (size_t)row * 8 + 4); rs = rsqrtf((((p0[0] + p0[1]) + (p0[2] + p0[3])) + ((p1[0] + p1[1]) + (p1[2] + p1[3]))) * (1.f / 2048.f) + 1e-6f); }
#pragma unroll
                for (int bj = 0; bj < 2; ++bj) { const f32x4 v0 = acc[ai][bj][m][0] * rs, v1 = acc[ai][bj][m][1] * rs;
                    u32x4 w; w.x = cvt_pk_bf16(v0[0], v0[1]); w.y = cvt_pk_bf16(v0[2], v0[3]); w.z = cvt_pk_bf16(v1[0], v1[1]); w.w = cvt_pk_bf16(v1[2], v1[3]);
                    *(u32x4*)(rowp + bj * HALF) = w; } }
    }
};
__device__ __forceinline__ float silu_f(float x) { return x * __builtin_amdgcn_rcpf(1.f + __builtin_amdgcn_exp2f(x * -1.4426950408889634f)); }
struct EpiSwiglu {
    static constexpr bool PERM = true, AFTER_DRAIN = false;
    bf16_t* O; int ldc; const float* ssq;
    __device__ __forceinline__ void operator()(const f32x4 (&acc)[2][2][4][2], const Unit& u, int wr, int wc, int fr, int fq) const {
        const int row0 = u.pm * BM + wr * 64 + fr, col0 = u.pn * HALF + wc * 32 + 8 * fq;
#pragma unroll
        for (int ai = 0; ai < 2; ++ai)
#pragma unroll
            for (int m = 0; m < 4; ++m) { const int row = row0 + ai * HALF + m * 16; bf16_t* rowp = O + (size_t)row * ldc + col0;
                const f32x4 p0 = *(const f32x4*)(ssq + (size_t)row * 8), p1 = *(const f32x4*)(ssq + (size_t)row * 8 + 4); const float rs = rsqrtf((((p0[0] + p0[1]) + (p0[2] + p0[3])) + ((p1[0] + p1[1]) + (p1[2] + p1[3]))) * (1.f / 2048.f) + 1e-6f);
                const f32x4 g0 = acc[ai][0][m][0] * rs, g1 = acc[ai][0][m][1] * rs, u0 = acc[ai][1][m][0] * rs, u1 = acc[ai][1][m][1] * rs;
                u32x4 w;
                w.x = cvt_pk_bf16(silu_f(g0[0]) * u0[0], silu_f(g0[1]) * u0[1]); w.y = cvt_pk_bf16(silu_f(g0[2]) * u0[2], silu_f(g0[3]) * u0[3]);
                w.z = cvt_pk_bf16(silu_f(g1[0]) * u1[0], silu_f(g1[1]) * u1[1]); w.w = cvt_pk_bf16(silu_f(g1[2]) * u1[2], silu_f(g1[3]) * u1[3]);
                *(u32x4*)rowp = w; }
    }
};
template <bool HALF_ALPHA, bool F32OUT> struct EpiResid {
    static constexpr bool PERM = true, AFTER_DRAIN = false;
    bf16_t* xb; float* fout; float* ssqp; PG8_LAS float* red;
    __device__ __forceinline__ void operator()(const f32x4 (&acc)[2][2][4][2], const Unit& u, int wr, int wc, int fr, int fq) const {
        const int col0 = u.pn * BM + wc * 32 + 8 * fq; const float alpha = HALF_ALPHA ? 0.5f : 1.0f;
#pragma unroll
        for (int ai = 0; ai < 2; ++ai)
#pragma unroll
            for (int m = 0; m < 4; ++m) { const int rl = ai * HALF + wr * 64 + m * 16 + fr; const size_t off = (size_t)(u.pm * BM + rl) * 2048 + col0; float sq = 0.f;
#pragma unroll
                for (int bj = 0; bj < 2; ++bj) { const size_t o = off + bj * HALF; const u32x4 bw = *(const u32x4*)(xb + o);
                    const f32x4 b0 = {__uint_as_float(bw.x << 16), __uint_as_float(bw.x & 0xffff0000u), __uint_as_float(bw.y << 16), __uint_as_float(bw.y & 0xffff0000u)};
                    const f32x4 b1 = {__uint_as_float(bw.z << 16), __uint_as_float(bw.z & 0xffff0000u), __uint_as_float(bw.w << 16), __uint_as_float(bw.w & 0xffff0000u)};
                    const f32x4 v0 = b0 + acc[ai][bj][m][0] * alpha, v1 = b1 + acc[ai][bj][m][1] * alpha;
                    if (F32OUT) { *(f32x4*)(fout + o) = v0; *(f32x4*)(fout + o + 4) = v1; }
                    else { u32x4 w; w.x = cvt_pk_bf16(v0[0], v0[1]); w.y = cvt_pk_bf16(v0[2], v0[3]); w.z = cvt_pk_bf16(v1[0], v1[1]); w.w = cvt_pk_bf16(v1[2], v1[3]); *(u32x4*)(xb + o) = w;
                        sq += ((v0[0] * v0[0] + v0[1] * v0[1]) + (v0[2] * v0[2] + v0[3] * v0[3])) + ((v1[0] * v1[0] + v1[1] * v1[1]) + (v1[2] * v1[2] + v1[3] * v1[3])); } }
                if (!F32OUT) { sq += __shfl_xor(sq, 16); sq += __shfl_xor(sq, 32); if (fq == 0) red[rl * 4 + wc] = sq; } }
        if (!F32OUT) {
            asm volatile("s_waitcnt lgkmcnt(0)" ::: "memory"); __builtin_amdgcn_s_barrier(); asm volatile("" ::: "memory");
            const int t = (wr * 4 + wc) * 64 + fq * 16 + fr;
            if (t < 256) { const f32x4 v = *(const PG8_LAS f32x4*)(red + t * 4); ssqp[(size_t)(u.pm * BM + t) * 8 + u.pn] = (v[0] + v[1]) + (v[2] + v[3]); } }
    }
};
}

#define LAS __attribute__((address_space(3)))
typedef unsigned short bf16;
typedef float f32x4 __attribute__((ext_vector_type(4)));
typedef short bf16x8 __attribute__((ext_vector_type(8)));
typedef short s16x4 __attribute__((ext_vector_type(4)));
typedef unsigned u32x4 __attribute__((ext_vector_type(4)));
typedef unsigned u32x2 __attribute__((ext_vector_type(2)));

constexpr int MTOK = 16384, DM = 2048, SEQ = 2048, NBATCH = 8, DFF = 5504, MEMLEN = 256;
constexpr int LD_AB = 6400, LD_C = 2560;
constexpr float EPS = 1e-6f;
constexpr size_t MiB = 1u << 20;
constexpr size_t WS_FF1IN = 0, WS_FF1OUT = 44 * MiB, WS_FF2IN = 66 * MiB, WS_FF2OUT = 110 * MiB, WS_MIXIN = 132 * MiB, WS_MIXOUT = 157 * MiB,
                 WS_WQ = 165 * MiB, WS_WO = 173 * MiB, WS_WKV0 = 181 * MiB, WS_WKV1 = 197 * MiB, WS_H = 213 * MiB, WS_PROJ = 277 * MiB, WS_OBUF = 477 * MiB,
                 WS_OC = 541 * MiB, WS_LSE = 637 * MiB, WS_ST = 639 * MiB, WS_DD = 767 * MiB, WS_KV = 768 * MiB, WS_MEMH = 800 * MiB, WS_CTL = 816 * MiB, WS_SSQ = 817 * MiB, WS_END = 822 * MiB;
constexpr int LDS_BYTES = 147456;

struct Params { const float* in[37]; float* out; unsigned char* ws; };

__device__ __forceinline__ unsigned pk2(float lo, float hi) { return pg8::cvt_pk_bf16(lo, hi); }
__device__ __forceinline__ float bflo(unsigned w) { return __uint_as_float(w << 16); }
__device__ __forceinline__ float bfhi(unsigned w) { return __uint_as_float(w & 0xffff0000u); }
__device__ __forceinline__ float wave_sum(float v) {
#pragma unroll
    for (int o = 1; o < 64; o <<= 1) v += __shfl_xor(v, o);
    return v;
}
__device__ __forceinline__ f32x4 mfma16(bf16x8 a, bf16x8 b, f32x4 c) { return __builtin_amdgcn_mfma_f32_16x16x32_bf16(a, b, c, 0, 0, 0); }
__device__ __forceinline__ bf16x8 lds16(const LAS unsigned char* p) { return *(const LAS bf16x8*)p; }
__device__ __forceinline__ bf16x8 vtr8(const LAS unsigned char* p0, const LAS unsigned char* p1) {
    const s16x4 lo = __builtin_bit_cast(s16x4, __builtin_amdgcn_ds_read_tr16_b64_v4i16((LAS s16x4*)p0));
    const s16x4 hi = __builtin_bit_cast(s16x4, __builtin_amdgcn_ds_read_tr16_b64_v4i16((LAS s16x4*)p1));
    return (bf16x8){lo[0], lo[1], lo[2], lo[3], hi[0], hi[1], hi[2], hi[3]};
}

__device__ __forceinline__ void transpose_item(const float* __restrict__ W, const float* __restrict__ gain, int K, int N, bf16* __restrict__ WT, int mode, LAS float* scr, int item, int lane) {
    const int nblk = N / 32, kb = item / nblk, nb = item % nblk, k0 = 64 * kb, n0 = 32 * nb;
    int drow0 = n0;
    if (mode == 1) { const int up = n0 >= DFF ? 1 : 0, j = n0 - up * DFF; drow0 = (j >> 7) * 256 + (j & 127) + up * 128; }
#pragma unroll 8
    for (int i = 0; i < 32; ++i) { const int kk = 2 * i + (lane >> 5); const float gk = gain ? gain[k0 + kk] : 1.f; scr[kk * 33 + (lane & 31)] = W[(size_t)(k0 + kk) * N + n0 + (lane & 31)] * gk; }
    asm volatile("s_waitcnt lgkmcnt(0)" ::: "memory");
    const int c = lane & 7;
#pragma unroll
    for (int j = 0; j < 4; ++j) { const int n = (lane >> 3) + 8 * j; const LAS float* s = scr + (8 * c) * 33 + n;
        u32x4 o; o.x = pk2(s[0 * 33], s[1 * 33]); o.y = pk2(s[2 * 33], s[3 * 33]); o.z = pk2(s[4 * 33], s[5 * 33]); o.w = pk2(s[6 * 33], s[7 * 33]);
        *(u32x4*)(WT + (size_t)(drow0 + n) * K + k0 + 8 * c) = o; }
    asm volatile("s_waitcnt lgkmcnt(0)" ::: "memory");
}
struct TD { const float* W; const float* gain; int K, N, mode; size_t dst; };
__device__ __forceinline__ TD get_td(const Params& p, int layer, int i) {
    TD t; t.mode = 0; t.K = DM; t.N = DM; t.W = nullptr; t.gain = nullptr; t.dst = 0;
    if (layer == 0) {
        switch (i) {
            case 0: t.W = p.in[3]; t.gain = p.in[2]; t.N = 2 * DFF; t.mode = 1; t.dst = WS_FF1IN; break;
            case 1: t.W = p.in[4]; t.K = DFF; t.dst = WS_FF1OUT; break;
            case 2: t.W = p.in[6]; t.gain = p.in[5]; t.N = 6176; t.dst = WS_MIXIN; break;
            case 3: t.W = p.in[12]; t.dst = WS_MIXOUT; break;
            case 4: t.W = p.in[15]; t.gain = p.in[13]; t.dst = WS_WQ; break;
            case 5: t.W = p.in[16]; t.N = 4096; t.dst = WS_WKV0; break;
            case 6: t.W = p.in[17]; t.dst = WS_WO; break;
            case 7: t.W = p.in[19]; t.gain = p.in[18]; t.N = 2 * DFF; t.mode = 1; t.dst = WS_FF2IN; break;
            case 8: t.W = p.in[20]; t.K = DFF; t.dst = WS_FF2OUT; break;
            default: t.W = p.in[31]; t.N = 4096; t.dst = WS_WKV1; break;
        }
    } else {
        switch (i) {
            case 0: t.W = p.in[22]; t.gain = p.in[21]; t.N = 2 * DFF; t.mode = 1; t.dst = WS_FF1IN; break;
            case 1: t.W = p.in[23]; t.K = DFF; t.dst = WS_FF1OUT; break;
            case 2: t.W = p.in[25]; t.gain = p.in[24]; t.N = 2560; t.dst = WS_MIXIN; break;
            case 3: t.W = p.in[27]; t.dst = WS_MIXOUT; break;
            case 4: t.W = p.in[30]; t.gain = p.in[28]; t.dst = WS_WQ; break;
            case 5: t.W = p.in[32]; t.dst = WS_WO; break;
            case 6: t.W = p.in[34]; t.gain = p.in[33]; t.N = 2 * DFF; t.mode = 1; t.dst = WS_FF2IN; break;
            default: t.W = p.in[35]; t.K = DFF; t.dst = WS_FF2OUT; break;
        }
    }
    return t;
}
template <int layer>
__device__ __forceinline__ void convert_weights(const Params& p, LAS unsigned char* lds, int gw, int ngw, int wave, int lane) {
    LAS float* scr = (LAS float*)(lds + wave * 16384);
    constexpr int nmat = layer == 0 ? 10 : 8;
#pragma unroll
    for (int i = 0; i < nmat; ++i) {
        const TD t = get_td(p, layer, i);
        const float* W = t.W; bf16* WT = (bf16*)(p.ws + t.dst);
        const int items = (t.K / 64) * (t.N / 32);
        for (int it = gw; it < items; it += ngw) transpose_item(W, t.gain, t.K, t.N, WT, t.mode, scr, it, lane);
    }
}
__device__ __forceinline__ void norm_row(const float* xrow, const float* gain, bf16* orow, float* of, int lane) {
    const f32x4* xr = (const f32x4*)xrow + lane;
    f32x4 v[8]; float s = 0.f;
#pragma unroll
    for (int j = 0; j < 8; ++j) { v[j] = xr[64 * j]; s += (v[j].x * v[j].x + v[j].y * v[j].y) + (v[j].z * v[j].z + v[j].w * v[j].w); }
    const float rstd = rsqrtf(wave_sum(s) * (1.f / DM) + EPS);
    const f32x4* gr = (const f32x4*)gain + lane;
#pragma unroll
    for (int j = 0; j < 8; ++j) { const f32x4 g = gr[64 * j]; const f32x4 y = v[j] * rstd * g;
        if (of) ((f32x4*)of)[64 * j + lane] = y;
        else { u32x2 w; w.x = pk2(y.x, y.y); w.y = pk2(y.z, y.w); ((u32x2*)orow)[64 * j + lane] = w; } }
}
__device__ __forceinline__ void cast_rows_ssq(const float* x, bf16* xb, float* ssq, int nrows, int gw, int ngw, int lane) {
    for (int m = gw; m < nrows; m += ngw) { const f32x4* xr = (const f32x4*)(x + (size_t)m * DM) + lane; float s_ = 0.f; f32x4 v[8];
#pragma unroll
        for (int j = 0; j < 8; ++j) v[j] = xr[64 * j];
#pragma unroll
        for (int j = 0; j < 8; ++j) { s_ += (v[j].x * v[j].x + v[j].y * v[j].y) + (v[j].z * v[j].z + v[j].w * v[j].w);
            u32x2 w; w.x = pk2(v[j].x, v[j].y); w.y = pk2(v[j].z, v[j].w); ((u32x2*)(xb + (size_t)m * DM))[64 * j + lane] = w; }
        s_ = wave_sum(s_); if (lane < 8) ssq[(size_t)m * 8 + lane] = lane == 0 ? s_ : 0.f; }
}
__device__ __forceinline__ void norm_row2(const float* xa, const float* xb_, const float* gain, bf16* oa, bf16* ob_, float* fa, float* fb, int lane) {
    const f32x4* ra = (const f32x4*)xa + lane; const f32x4* rb = (const f32x4*)xb_ + lane;
    f32x4 va[8], vb[8]; float sa = 0.f, sb = 0.f;
#pragma unroll
    for (int j = 0; j < 8; ++j) { va[j] = ra[64 * j]; vb[j] = rb[64 * j]; }
#pragma unroll
    for (int j = 0; j < 8; ++j) { sa += (va[j].x * va[j].x + va[j].y * va[j].y) + (va[j].z * va[j].z + va[j].w * va[j].w); sb += (vb[j].x * vb[j].x + vb[j].y * vb[j].y) + (vb[j].z * vb[j].z + vb[j].w * vb[j].w); }
    const float rsa = rsqrtf(wave_sum(sa) * (1.f / DM) + EPS), rsb = rsqrtf(wave_sum(sb) * (1.f / DM) + EPS);
    const f32x4* gr = (const f32x4*)gain + lane;
#pragma unroll
    for (int j = 0; j < 8; ++j) { const f32x4 g = gr[64 * j]; const f32x4 ya = va[j] * rsa * g, yb = vb[j] * rsb * g;
        if (fa) { ((f32x4*)fa)[64 * j + lane] = ya; ((f32x4*)fb)[64 * j + lane] = yb; }
        else { u32x2 wa, wb; wa.x = pk2(ya.x, ya.y); wa.y = pk2(ya.z, ya.w); wb.x = pk2(yb.x, yb.y); wb.y = pk2(yb.z, yb.w); ((u32x2*)oa)[64 * j + lane] = wa; ((u32x2*)ob_)[64 * j + lane] = wb; } }
}
__device__ __forceinline__ void norm_rows(const float* x, const float* gain, bf16* out, int nrows, int gw, int ngw, int lane) {
    int m = gw;
    for (; m + ngw < nrows; m += 2 * ngw) norm_row2(x + (size_t)m * DM, x + (size_t)(m + ngw) * DM, gain, out + (size_t)m * DM, out + (size_t)(m + ngw) * DM, nullptr, nullptr, lane);
    for (; m < nrows; m += ngw) norm_row(x + (size_t)m * DM, gain, out + (size_t)m * DM, nullptr, lane);
}

template <int HD, int NB, int NQ>
__device__ __forceinline__ void banded_unit(LAS unsigned char* lds, int tid, const bf16* __restrict__ qb, const bf16* __restrict__ kbp, const bf16* __restrict__ vbp, int ld,
                                            int dil, int r, int L, int qpos0, int ks, int nrows, int wave_row_off, int W, float slope, float scale, float m_init, float l_init,
                                            bf16* __restrict__ ob, int old, float* __restrict__ lseb) {
    constexpr int CH = HD / 8, ROWB = HD * 2, SWZ = (CH - 1) & 15, NK = HD / 32, ND = HD / 16;
    LAS unsigned char* Kt = lds; LAS unsigned char* Vt = lds + nrows * ROWB;
    for (int idx = tid; idx < nrows * CH; idx += 512) {
        const int row = idx / CH, ch = idx % CH, kp = ks + row;
        u32x4 k4 = (u32x4){0u, 0u, 0u, 0u}, v4 = (u32x4){0u, 0u, 0u, 0u};
        if (kp >= 0 && kp < L) { const size_t off = (size_t)(kp * dil + r) * ld + ch * 8; k4 = *(const u32x4*)(kbp + off); v4 = *(const u32x4*)(vbp + off); }
        const int lo = row * ROWB + ((ch ^ (row & SWZ)) << 4);
        *(LAS u32x4*)(Kt + lo) = k4; *(LAS u32x4*)(Vt + lo) = v4;
    }
    __syncthreads();
    const int lane = tid & 63, g = lane >> 4, c = lane & 15;
    bf16x8 qf[NQ][NK]; f32x4 O[NQ][ND]; float m[NQ], l[NQ];
#pragma unroll
    for (int qi = 0; qi < NQ; ++qi) { const size_t qtok = (size_t)((qpos0 + 16 * qi + c) * dil + r);
#pragma unroll
        for (int k = 0; k < NK; ++k) qf[qi][k] = *(const bf16x8*)(qb + qtok * ld + k * 32 + g * 8);
#pragma unroll
        for (int d = 0; d < ND; ++d) O[qi][d] = (f32x4){0.f, 0.f, 0.f, 0.f};
        m[qi] = m_init; l[qi] = (g == 0) ? l_init : 0.f; }
    const int krow_a = (c >> 2) * 8 + (c & 3), vrow_a = g * 8 + (c >> 2), vch = (c & 3) >> 1, vhalf = (c & 1) * 8;
    for (int kb = 0; kb < NB; ++kb) {
        const int R0 = wave_row_off + kb * 32;
        const int ra = R0 + krow_a, rb = ra + 4;
        bf16x8 ka[NK], kbf[NK];
#pragma unroll
        for (int k = 0; k < NK; ++k) { const int chunk = k * 4 + g;
            ka[k] = lds16(Kt + ra * ROWB + ((chunk ^ (ra & SWZ)) << 4)); kbf[k] = lds16(Kt + rb * ROWB + ((chunk ^ (rb & SWZ)) << 4)); }
        const int r0 = R0 + vrow_a, r1 = r0 + 4;
        bf16x8 vf[ND];
#pragma unroll
        for (int d = 0; d < ND; ++d) { const int chunk = d * 2 + vch;
            vf[d] = vtr8(Vt + r0 * ROWB + ((chunk ^ (r0 & SWZ)) << 4) + vhalf, Vt + r1 * ROWB + ((chunk ^ (r1 & SWZ)) << 4) + vhalf); }
        const int kp0 = ks + R0 + g * 8;
#pragma unroll
        for (int qi = 0; qi < NQ; ++qi) {
            const int qb0 = qpos0 + 16 * qi;
            if (NQ > 1 && !((ks + R0 + 31 >= qb0 - W) && (ks + R0 <= qb0 + 15 + W))) continue;
            const int qpos = qb0 + c;
            f32x4 s0 = (f32x4){0.f, 0.f, 0.f, 0.f}, s1 = s0;
#pragma unroll
            for (int k = 0; k < NK; ++k) { s0 = mfma16(ka[k], qf[qi][k], s0); s1 = mfma16(kbf[k], qf[qi][k], s1); }
            float sv[8]; float bm = -1e30f;
#pragma unroll
            for (int jj = 0; jj < 8; ++jj) { const int kp = kp0 + jj; const int dd = kp - qpos; const int ad = dd < 0 ? -dd : dd; const bool valid = (ad <= W) && (kp >= 0) && (kp < L);
                const float raw = jj < 4 ? s0[jj & 3] : s1[jj & 3];
                sv[jj] = valid ? raw * scale - slope * (float)ad : -1e30f; bm = fmaxf(bm, sv[jj]); }
            bm = fmaxf(bm, __shfl_xor(bm, 16)); bm = fmaxf(bm, __shfl_xor(bm, 32));
            const float m_new = fmaxf(m[qi], bm), alpha = __expf(m[qi] - m_new);
            float ps = 0.f;
#pragma unroll
            for (int jj = 0; jj < 8; ++jj) { sv[jj] = __expf(sv[jj] - m_new); ps += sv[jj]; }
            l[qi] = l[qi] * alpha + ps; m[qi] = m_new;
            u32x4 pw; pw.x = pk2(sv[0], sv[1]); pw.y = pk2(sv[2], sv[3]); pw.z = pk2(sv[4], sv[5]); pw.w = pk2(sv[6], sv[7]);
            const bf16x8 pf = __builtin_bit_cast(bf16x8, pw);
#pragma unroll
            for (int d = 0; d < ND; ++d) O[qi][d] = mfma16(vf[d], pf, O[qi][d] * alpha);
        }
    }
#pragma unroll
    for (int qi = 0; qi < NQ; ++qi) { const size_t qtok = (size_t)((qpos0 + 16 * qi + c) * dil + r);
        float lt = l[qi]; lt += __shfl_xor(lt, 16); lt += __shfl_xor(lt, 32);
        const float inv = 1.f / lt;
#pragma unroll
        for (int d = 0; d < ND; ++d) { u32x2 w; w.x = pk2(O[qi][d][0] * inv, O[qi][d][1] * inv); w.y = pk2(O[qi][d][2] * inv, O[qi][d][3] * inv); *(u32x2*)(ob + qtok * old + d * 16 + g * 4) = w; }
        if (lseb != nullptr && g == 0) lseb[qtok * 8] = m[qi] + __logf(lt); }
    __syncthreads();
}

__device__ __forceinline__ void xa_dma(const bf16* __restrict__ base, int dc, LAS unsigned char* buf, int w, unsigned voff) {
    const char* ub = (const char*)base + (size_t)dc * 256;
#pragma unroll
    for (int j = 0; j < 8; ++j)
        __builtin_amdgcn_global_load_lds((const unsigned*)(ub + (size_t)j * 262144 + voff), (LAS unsigned*)(buf + (j * 8 + w) * 1024), 16, 0, 0);
}
__device__ __forceinline__ void xattn_unit(LAS unsigned char* lds, int tid, const bf16* __restrict__ qx, const bf16* __restrict__ kv, bf16* __restrict__ obuf, int u) {
    const int b = u >> 6, h = (u >> 4) & 3, qt = u & 15;
    const int lane = tid & 63, w = __builtin_amdgcn_readfirstlane(tid >> 6), g = lane >> 4, c = lane & 15;
    const size_t token = (size_t)b * SEQ + qt * 128 + 16 * w + c;
    const bf16* qrow = qx + token * DM + h * 512;
    const bf16* kbase = kv + (size_t)(b * MEMLEN) * 4096 + h * 512; const bf16* vbase = kbase + 2048;
    const int krow_a = (c >> 2) * 8 + (c & 3), vrow_a = g * 8 + (c >> 2), vch = (c & 3) >> 1, vhalf = (c & 1) * 8;
    const int drow = 4 * w + (lane >> 4);
    const unsigned voff = (unsigned)(drow * 8192 + (((lane & 15) ^ (drow & 15)) << 4));
    int offK[2][4], offV[2][8];
#pragma unroll
    for (int t = 0; t < 2; ++t) { const int rk = krow_a + 4 * t, rv = vrow_a + 4 * t;
#pragma unroll
        for (int k = 0; k < 4; ++k) offK[t][k] = rk * 256 + (((k * 4 + g) ^ (rk & 15)) << 4);
#pragma unroll
        for (int d = 0; d < 8; ++d) offV[t][d] = rv * 256 + (((d * 2 + vch) ^ (rv & 15)) << 4) + vhalf; }
    f32x4 S[16];
#pragma unroll
    for (int i = 0; i < 16; ++i) S[i] = (f32x4){0.f, 0.f, 0.f, 0.f};
    xa_dma(kbase, 0, lds, w, voff);
    asm volatile("s_waitcnt vmcnt(0)" ::: "memory"); __syncthreads();
    for (int dc = 0; dc < 4; ++dc) {
        LAS unsigned char* cur = lds + (dc & 1) * 65536;
        bf16x8 qf[4];
#pragma unroll
        for (int k = 0; k < 4; ++k) qf[k] = *(const bf16x8*)(qrow + dc * 128 + k * 32 + g * 8);
#pragma unroll
        for (int kb = 0; kb < 8; ++kb) {
#pragma unroll
            for (int k = 0; k < 4; ++k) {
                S[kb * 2] = mfma16(lds16(cur + offK[0][k] + kb * 8192), qf[k], S[kb * 2]);
                S[kb * 2 + 1] = mfma16(lds16(cur + offK[1][k] + kb * 8192), qf[k], S[kb * 2 + 1]); }
            asm volatile("" : "+v"(S[kb * 2]), "+v"(S[kb * 2 + 1]) :: "memory");
            if (kb == 0) xa_dma(dc < 3 ? kbase : vbase, (dc + 1) & 3, lds + ((dc + 1) & 1) * 65536, w, voff);
        }
        asm volatile("s_waitcnt vmcnt(0)" ::: "memory"); __syncthreads();
    }
    const float scale = 0.044194173824159216f;
    float mx = -1e30f;
#pragma unroll
    for (int i = 0; i < 16; ++i) { mx = fmaxf(mx, fmaxf(fmaxf(S[i][0], S[i][1]), fmaxf(S[i][2], S[i][3]))); }
    mx = fmaxf(mx, __shfl_xor(mx, 16)); mx = fmaxf(mx, __shfl_xor(mx, 32));
    float l = 0.f;
#pragma unroll
    for (int i = 0; i < 16; ++i)
#pragma unroll
        for (int j = 0; j < 4; ++j) { const float pv = __expf((S[i][j] - mx) * scale); S[i][j] = pv; l += pv; }
    l += __shfl_xor(l, 16); l += __shfl_xor(l, 32);
    const float inv = 1.f / l;
    bf16x8 pf[8];
#pragma unroll
    for (int kb = 0; kb < 8; ++kb) { u32x4 pw; pw.x = pk2(S[kb * 2][0], S[kb * 2][1]); pw.y = pk2(S[kb * 2][2], S[kb * 2][3]); pw.z = pk2(S[kb * 2 + 1][0], S[kb * 2 + 1][1]); pw.w = pk2(S[kb * 2 + 1][2], S[kb * 2 + 1][3]);
        pf[kb] = __builtin_bit_cast(bf16x8, pw); }
    for (int dc = 0; dc < 4; ++dc) {
        LAS unsigned char* cur = lds + (dc & 1) * 65536;
        if (dc < 3) xa_dma(vbase, dc + 1, lds + ((dc + 1) & 1) * 65536, w, voff);
#pragma unroll
        for (int d = 0; d < 8; ++d) {
            f32x4 O = (f32x4){0.f, 0.f, 0.f, 0.f};
#pragma unroll
            for (int kb = 0; kb < 8; ++kb) O = mfma16(vtr8(cur + offV[0][d] + kb * 8192, cur + offV[1][d] + kb * 8192), pf[kb], O);
            u32x2 wv; wv.x = pk2(O[0] * inv, O[1] * inv); wv.y = pk2(O[2] * inv, O[3] * inv);
            *(u32x2*)(obuf + token * DM + h * 512 + dc * 128 + d * 16 + g * 4) = wv;
            asm volatile("" ::: "memory");
        }
        asm volatile("s_waitcnt vmcnt(0)" ::: "memory"); __syncthreads();
    }
}

constexpr int G_BCUM = 0, G_X1 = 65536, G_X2 = 98304, G_ZS = 131072, G_RED = 139264;
__device__ __forceinline__ void gla_gates(LAS unsigned char* lds, int tid, const bf16* __restrict__ proj, size_t tok0, int h, const float* __restrict__ Wf, const float* __restrict__ bf_,
                                          const float* __restrict__ Wb, const float* __restrict__ bb_) {
    if (tid < 256) { const int t = tid >> 2, part = tid & 3; const u32x4 v = *(const u32x4*)(proj + (tok0 + t) * LD_AB + 6144 + part * 8);
        LAS f32x4* zp = (LAS f32x4*)(lds + G_ZS + (t * 32 + part * 8) * 4);
        zp[0] = (f32x4){bflo(v.x), bfhi(v.x), bflo(v.y), bfhi(v.y)}; zp[1] = (f32x4){bflo(v.z), bfhi(v.z), bflo(v.w), bfhi(v.w)}; }
    __syncthreads();
    if (tid < 256) {
        const int dir = tid >> 7, kk = tid & 127; const float* Wg = dir ? Wb : Wf; const float* bg = dir ? bb_ : bf_;
        float w[16];
#pragma unroll
        for (int r = 0; r < 16; ++r) w[r] = Wg[r * 512 + h * 128 + kk];
        const float bias = bg[h * 128 + kk];
        float cum = 0.f; LAS float* bc = (LAS float*)(lds + G_BCUM) + dir * 8192 + kk; const LAS unsigned char* zs = lds + G_ZS + dir * 64;
        for (int s = 0; s < 64; ++s) { const int t = dir ? 63 - s : s;
            const LAS f32x4* z4 = (const LAS f32x4*)(zs + t * 128);
            const f32x4 z0 = z4[0], z1 = z4[1], z2 = z4[2], z3 = z4[3];
            float u = bias;
            u += z0[0] * w[0] + z0[1] * w[1] + z0[2] * w[2] + z0[3] * w[3];
            u += z1[0] * w[4] + z1[1] * w[5] + z1[2] * w[6] + z1[3] * w[7];
            u += z2[0] * w[8] + z2[1] * w[9] + z2[2] * w[10] + z2[3] * w[11];
            u += z3[0] * w[12] + z3[1] * w[13] + z3[2] * w[14] + z3[3] * w[15];
            const float ls = fminf(u, 0.f) - __logf(1.f + __expf(-fabsf(u)));
            cum += ls * 0.0625f; bc[t * 128] = cum; }
    }
    __syncthreads();
}
__device__ __forceinline__ void gla_stage_v(LAS unsigned char* vdst, int tid, const bf16* __restrict__ proj, size_t tok0, int h) {
    for (int idx = tid; idx < 2048; idx += 512) { const int row = idx >> 5, ch = idx & 31;
        *(LAS u32x4*)(vdst + row * 512 + ((ch ^ (row & 15)) << 4)) = *(const u32x4*)(proj + (tok0 + row) * LD_AB + 4096 + h * 256 + ch * 8); }
}
__device__ __forceinline__ void gla_stage1_unit(LAS unsigned char* lds, int tid, const bf16* __restrict__ proj, int item, const float* Wf, const float* bf_, const float* Wb, const float* bb_,
                                                bf16* __restrict__ St, float* __restrict__ Dd) {
    const int b = item >> 7, h = (item >> 5) & 3, cidx = item & 31; const size_t tok0 = (size_t)b * SEQ + cidx * 64;
    gla_gates(lds, tid, proj, tok0, h, Wf, bf_, Wb, bb_);
    {
        const int kk = tid & 127, jq = tid >> 7;
        const LAS float* bcf = (const LAS float*)(lds + G_BCUM) + kk; const LAS float* bcb = bcf + 8192;
        const float blf = bcf[63 * 128], blb = bcb[0];
#pragma unroll
        for (int cc = 0; cc < 2; ++cc) { const int jc = jq * 2 + cc; float of[8], obk[8];
#pragma unroll
            for (int e = 0; e < 8; ++e) { const int j = jc * 8 + e; const float kv = __uint_as_float((unsigned)proj[(tok0 + j) * LD_AB + 3584 + h * 128 + kk] << 16);
                of[e] = kv * __expf(blf - bcf[j * 128]); obk[e] = kv * __expf(blb - bcb[j * 128]); }
            const int lo = kk * 128 + ((jc ^ (kk & 7)) << 4);
            *(LAS u32x4*)(lds + G_X1 + lo) = (u32x4){pk2(of[0], of[1]), pk2(of[2], of[3]), pk2(of[4], of[5]), pk2(of[6], of[7])};
            *(LAS u32x4*)(lds + G_X1 + 16384 + lo) = (u32x4){pk2(obk[0], obk[1]), pk2(obk[2], obk[3]), pk2(obk[4], obk[5]), pk2(obk[6], obk[7])}; }
        if (tid < 128) { Dd[(size_t)item * 128 + kk] = __expf(blf); Dd[(size_t)(1024 + item) * 128 + kk] = __expf(blb); }
    }
    gla_stage_v(lds + G_X2, tid, proj, tok0, h);
    __syncthreads();
    const int lane = tid & 63, w = tid >> 6, g = lane >> 4, c = lane & 15;
    const int vrow_a = g * 8 + (c >> 2), vch = (c & 3) >> 1, vhalf = (c & 1) * 8;
#pragma unroll
    for (int dbi = 0; dbi < 2; ++dbi) { const int db = 2 * w + dbi; bf16x8 vf[2];
#pragma unroll
        for (int ksj = 0; ksj < 2; ++ksj) { const int r0 = ksj * 32 + vrow_a, r1 = r0 + 4, chunk = db * 2 + vch;
            vf[ksj] = vtr8(lds + G_X2 + r0 * 512 + ((chunk ^ (r0 & 15)) << 4) + vhalf, lds + G_X2 + r1 * 512 + ((chunk ^ (r1 & 15)) << 4) + vhalf); }
#pragma unroll
        for (int dir = 0; dir < 2; ++dir)
#pragma unroll
            for (int nb = 0; nb < 8; ++nb) { f32x4 acc = (f32x4){0.f, 0.f, 0.f, 0.f}; const int kk = nb * 16 + c;
#pragma unroll
                for (int ksj = 0; ksj < 2; ++ksj) acc = mfma16(vf[ksj], lds16(lds + G_X1 + dir * 16384 + kk * 128 + (((ksj * 4 + g) ^ (kk & 7)) << 4)), acc);
                bf16* sp = St + ((size_t)(dir * 1024 + item) * 256 + db * 16 + g * 4) * 128 + kk;
#ifdef DBG_ZERO_ST
                for (int j = 0; j < 4; ++j) sp[j * 128] = (bf16)0; }
#else
                for (int j = 0; j < 4; ++j) sp[j * 128] = (bf16)(pk2(acc[j], 0.f) & 0xffffu); }
#endif
    }
    __syncthreads();
}
__device__ __forceinline__ void gla_scan(bf16* __restrict__ St, const float* __restrict__ Dd, int grp, int gtid, int nthreads) {
    for (int wi = gtid; wi < 32768; wi += nthreads) {
        const int dir = wi >> 14, bh = grp * 4 + ((wi >> 12) & 3), e8 = wi & 4095, kk0 = (e8 * 8) & 127;
        float st[8];
#pragma unroll
        for (int e = 0; e < 8; ++e) st[e] = 0.f;
#pragma unroll 8
        for (int s = 0; s < 32; ++s) { const int cidx = dir ? 31 - s : s; const size_t it = (size_t)dir * 1024 + bh * 32 + cidx;
            u32x4* sp = (u32x4*)(St + it * 32768 + e8 * 8); const u32x4 uu = *sp;
            const f32x4 d0 = *(const f32x4*)(Dd + it * 128 + kk0), d1 = *(const f32x4*)(Dd + it * 128 + kk0 + 4);
            *sp = (u32x4){pk2(st[0], st[1]), pk2(st[2], st[3]), pk2(st[4], st[5]), pk2(st[6], st[7])};
            st[0] = d0[0] * st[0] + bflo(uu.x); st[1] = d0[1] * st[1] + bfhi(uu.x); st[2] = d0[2] * st[2] + bflo(uu.y); st[3] = d0[3] * st[3] + bfhi(uu.y);
            st[4] = d1[0] * st[4] + bflo(uu.z); st[5] = d1[1] * st[5] + bfhi(uu.z); st[6] = d1[2] * st[6] + bflo(uu.w); st[7] = d1[3] * st[7] + bfhi(uu.w); }
    }
}
__device__ __forceinline__ void gla_stage3_unit(LAS unsigned char* lds, int tid, const bf16* __restrict__ proj, int item, const float* Wf, const float* bf_, const float* Wb, const float* bb_,
                                                const bf16* __restrict__ St, const float* __restrict__ head_norm, bf16* __restrict__ obuf) {
    const int b = item >> 7, h = (item >> 5) & 3, cidx = item & 31; const size_t tok0 = (size_t)b * SEQ + cidx * 64;
    gla_gates(lds, tid, proj, tok0, h, Wf, bf_, Wb, bb_);
    const float qscale = 0.08838834764831845f;
    for (int task = tid; task < 1024; task += 512) { const int row = task >> 4, ch = task & 15;
        const u32x4 q8 = *(const u32x4*)(proj + (tok0 + row) * LD_AB + 3072 + h * 128 + ch * 8), k8 = *(const u32x4*)(proj + (tok0 + row) * LD_AB + 3584 + h * 128 + ch * 8);
        const LAS f32x4* bfp = (const LAS f32x4*)(lds + G_BCUM + (row * 128 + ch * 8) * 4); const LAS f32x4* bbp = (const LAS f32x4*)(lds + G_BCUM + 32768 + (row * 128 + ch * 8) * 4);
        const f32x4 f0 = bfp[0], f1 = bfp[1], b0 = bbp[0], b1 = bbp[1];
        const float qv[8] = {bflo(q8.x), bfhi(q8.x), bflo(q8.y), bfhi(q8.y), bflo(q8.z), bfhi(q8.z), bflo(q8.w), bfhi(q8.w)};
        const float kvv[8] = {bflo(k8.x), bfhi(k8.x), bflo(k8.y), bfhi(k8.y), bflo(k8.z), bfhi(k8.z), bflo(k8.w), bfhi(k8.w)};
        const float bfv[8] = {f0[0], f0[1], f0[2], f0[3], f1[0], f1[1], f1[2], f1[3]}, bbv[8] = {b0[0], b0[1], b0[2], b0[3], b1[0], b1[1], b1[2], b1[3]};
        float qgf[8], qgb[8], kdf[8], kdb[8];
#pragma unroll
        for (int e = 0; e < 8; ++e) { const float ef = __expf(bfv[e]), eb = __expf(bbv[e]); qgf[e] = qv[e] * qscale * ef; qgb[e] = qv[e] * qscale * eb; kdf[e] = kvv[e] / ef; kdb[e] = kvv[e] / eb; }
        const int lo = row * 256 + ((ch ^ (row & 15)) << 4);
        *(LAS u32x4*)(lds + G_X1 + lo) = (u32x4){pk2(qgf[0], qgf[1]), pk2(qgf[2], qgf[3]), pk2(qgf[4], qgf[5]), pk2(qgf[6], qgf[7])};
        *(LAS u32x4*)(lds + G_X1 + 16384 + lo) = (u32x4){pk2(qgb[0], qgb[1]), pk2(qgb[2], qgb[3]), pk2(qgb[4], qgb[5]), pk2(qgb[6], qgb[7])};
        *(LAS u32x4*)(lds + G_X2 + lo) = (u32x4){pk2(kdf[0], kdf[1]), pk2(kdf[2], kdf[3]), pk2(kdf[4], kdf[5]), pk2(kdf[6], kdf[7])};
        *(LAS u32x4*)(lds + G_X2 + 16384 + lo) = (u32x4){pk2(kdb[0], kdb[1]), pk2(kdb[2], kdb[3]), pk2(kdb[4], kdb[5]), pk2(kdb[6], kdb[7])}; }
    __syncthreads();
    gla_stage_v(lds + G_BCUM, tid, proj, tok0, h);
    __syncthreads();
    const int lane = tid & 63, w = tid >> 6, g = lane >> 4, c = lane & 15, ib = w & 3, dh = w >> 2;
    const int krow_a = (c >> 2) * 8 + (c & 3), vrow_a = g * 8 + (c >> 2), vch = (c & 3) >> 1, vhalf = (c & 1) * 8;
    bf16x8 qg[2][4];
#pragma unroll
    for (int dir = 0; dir < 2; ++dir)
#pragma unroll
        for (int k = 0; k < 4; ++k) qg[dir][k] = lds16(lds + G_X1 + dir * 16384 + (ib * 16 + c) * 256 + (((k * 4 + g) ^ c) << 4));
    bf16x8 pf[2];
#pragma unroll
    for (int jb = 0; jb < 2; ++jb) { const int ra = jb * 32 + krow_a, rb = ra + 4;
        f32x4 sf0 = (f32x4){0.f, 0.f, 0.f, 0.f}, sf1 = sf0, sb0 = sf0, sb1 = sf0;
#pragma unroll
        for (int k = 0; k < 4; ++k) { const int chunk = k * 4 + g; const int oa = ra * 256 + ((chunk ^ (ra & 15)) << 4), obb = rb * 256 + ((chunk ^ (rb & 15)) << 4);
            sf0 = mfma16(lds16(lds + G_X2 + oa), qg[0][k], sf0); sf1 = mfma16(lds16(lds + G_X2 + obb), qg[0][k], sf1);
            sb0 = mfma16(lds16(lds + G_X2 + 16384 + oa), qg[1][k], sb0); sb1 = mfma16(lds16(lds + G_X2 + 16384 + obb), qg[1][k], sb1); }
        float pv[8]; const int iidx = ib * 16 + c;
#pragma unroll
        for (int jj = 0; jj < 8; ++jj) { const int jidx = jb * 32 + g * 8 + jj; const float vf_ = jj < 4 ? sf0[jj & 3] : sf1[jj & 3], vb_ = jj < 4 ? sb0[jj & 3] : sb1[jj & 3]; pv[jj] = (jidx <= iidx) ? vf_ : vb_; }
        u32x4 pw; pw.x = pk2(pv[0], pv[1]); pw.y = pk2(pv[2], pv[3]); pw.z = pk2(pv[4], pv[5]); pw.w = pk2(pv[6], pv[7]);
        pf[jb] = __builtin_bit_cast(bf16x8, pw); }
    f32x4 O[8]; float ssq = 0.f;
#pragma unroll
    for (int d = 0; d < 8; ++d) { const int dvb = dh * 8 + d; f32x4 acc = (f32x4){0.f, 0.f, 0.f, 0.f};
#pragma unroll
        for (int jb = 0; jb < 2; ++jb) { const int r0 = jb * 32 + vrow_a, r1 = r0 + 4, chunk = dvb * 2 + vch;
            acc = mfma16(vtr8(lds + G_BCUM + r0 * 512 + ((chunk ^ (r0 & 15)) << 4) + vhalf, lds + G_BCUM + r1 * 512 + ((chunk ^ (r1 & 15)) << 4) + vhalf), pf[jb], acc); }
#ifndef DBG_NO_INTER
#pragma unroll
        for (int dir = 0; dir < 2; ++dir) { const bf16* sp = St + ((size_t)(dir * 1024 + item) * 256 + dvb * 16 + c) * 128 + g * 8;
#pragma unroll
            for (int k = 0; k < 4; ++k) acc = mfma16(*(const bf16x8*)(sp + k * 32), qg[dir][k], acc); }
#endif
        O[d] = acc; ssq += (acc[0] * acc[0] + acc[1] * acc[1]) + (acc[2] * acc[2] + acc[3] * acc[3]); }
    ssq += __shfl_xor(ssq, 16); ssq += __shfl_xor(ssq, 32);
    LAS float* red = (LAS float*)(lds + G_RED);
    if (g == 0) red[w * 16 + c] = ssq;
    __syncthreads();
    const float tot = red[w * 16 + c] + red[(w ^ 4) * 16 + c];
    const float rstd = rsqrtf(tot * (1.f / 256.f) + EPS);
    const size_t token = tok0 + ib * 16 + c;
#pragma unroll
    for (int d = 0; d < 8; ++d) { const int dv0 = (dh * 8 + d) * 16 + g * 4;
        const f32x4 hn = *(const f32x4*)(head_norm + h * 256 + dv0); const u32x2 r2 = *(const u32x2*)(proj + token * LD_AB + 5120 + h * 256 + dv0);
        const float rv[4] = {bflo(r2.x), bfhi(r2.x), bflo(r2.y), bfhi(r2.y)}; float ov[4];
#pragma unroll
        for (int j = 0; j < 4; ++j) ov[j] = O[d][j] * rstd * hn[j] * pg8::silu_f(rv[j]);
        u32x2 wv; wv.x = pk2(ov[0], ov[1]); wv.y = pk2(ov[2], ov[3]); *(u32x2*)(obuf + token * DM + 1024 + h * 256 + dv0) = wv; }
    __syncthreads();
}
__device__ __forceinline__ void combine_a(const bf16* __restrict__ oc, const float* __restrict__ lse, bf16* __restrict__ obuf, int grp, int gtid, int nthreads) {
#pragma unroll 4
    for (int task = gtid; task < SEQ * 128; task += nthreads) { const int token = grp * SEQ + (task >> 7), h = (task >> 4) & 7, ch = task & 15;
        const float l0 = lse[(size_t)token * 8 + h], l1 = lse[(size_t)(MTOK + token) * 8 + h], l2 = lse[(size_t)(2 * MTOK + token) * 8 + h];
        const float mx = fmaxf(l0, fmaxf(l1, l2)); float w0 = __expf(l0 - mx), w1 = __expf(l1 - mx), w2 = __expf(l2 - mx); const float inv = 1.f / (w0 + w1 + w2); w0 *= inv; w1 *= inv; w2 *= inv;
        const size_t off = (size_t)token * 1024 + h * 128 + ch * 8;
        const u32x4 a = *(const u32x4*)(oc + off), bq = *(const u32x4*)(oc + (size_t)MTOK * 1024 + off), cq = *(const u32x4*)(oc + (size_t)2 * MTOK * 1024 + off);
        u32x4 o;
        o.x = pk2(w0 * bflo(a.x) + w1 * bflo(bq.x) + w2 * bflo(cq.x), w0 * bfhi(a.x) + w1 * bfhi(bq.x) + w2 * bfhi(cq.x));
        o.y = pk2(w0 * bflo(a.y) + w1 * bflo(bq.y) + w2 * bflo(cq.y), w0 * bfhi(a.y) + w1 * bfhi(bq.y) + w2 * bfhi(cq.y));
        o.z = pk2(w0 * bflo(a.z) + w1 * bflo(bq.z) + w2 * bflo(cq.z), w0 * bfhi(a.z) + w1 * bfhi(bq.z) + w2 * bfhi(cq.z));
        o.w = pk2(w0 * bflo(a.w) + w1 * bflo(bq.w) + w2 * bflo(cq.w), w0 * bfhi(a.w) + w1 * bfhi(bq.w) + w2 * bfhi(cq.w));
        *(u32x4*)(obuf + (size_t)token * DM + h * 128 + ch * 8) = o; }
}

#define XB_TMO      128
#define XB_XCNT(j)  (256  + 64 * (j))
#define XB_XSUB(j)  (1280 + 64 * (j))
#define XB_XGEN(j)  (2304 + 64 * (j))
#define XB_TOP      3328
#define XB_TOPGEN   3392
#define XCD_BAR_WORDS 3456
#define XB_SPIN_CAP (1u << 18)

__device__ __forceinline__ unsigned xb_ld(unsigned* p)              { return __hip_atomic_load(p, __ATOMIC_RELAXED, __HIP_MEMORY_SCOPE_AGENT); }
__device__ __forceinline__ unsigned xb_add(unsigned* p, unsigned v) { return __hip_atomic_fetch_add(p, v, __ATOMIC_RELAXED, __HIP_MEMORY_SCOPE_AGENT); }
__device__ __forceinline__ unsigned xb_xcc_id() { return (unsigned)__builtin_amdgcn_s_getreg((3 << 11) | 20) & 0xFu; }
#define XB_SPIN(cond, bar) do { unsigned _sp = 0; while (cond) { __builtin_amdgcn_s_sleep(1); \
    if ((++_sp & 255u) == 0u) { if (xb_ld(&(bar)[XB_TMO])) break; if (_sp > XB_SPIN_CAP) { atomicAdd(&(bar)[XB_TMO], 1u); break; } } } } while (0)

struct XcdBarrier {
    unsigned* bar; unsigned x;
    volatile LAS unsigned* st;
};

__device__ __forceinline__ XcdBarrier xcd_barrier_post(unsigned* bar, volatile LAS unsigned* st) {
    XcdBarrier b; b.bar = bar; b.x = xb_xcc_id(); b.st = st;
    if (threadIdx.x == 0) (void)xb_add(&bar[XB_XCNT(b.x)], 1u);
    return b;
}
__device__ __forceinline__ void xcd_barrier_complete(unsigned* bar, unsigned x, unsigned& nloc, unsigned& nx) {
    const unsigned G = gridDim.x * gridDim.y * gridDim.z;
    unsigned sum, cnt, mine, sp = 0u;
    for (;;) {
        sum = 0u; cnt = 0u; mine = 0u;
#pragma unroll
        for (unsigned j = 0; j < 16; ++j) { const unsigned c = xb_ld(&bar[XB_XCNT(j)]); sum += c; cnt += (c > 0u) ? 1u : 0u; mine = (j == x) ? c : mine; }
        if (sum == G) break;
        __builtin_amdgcn_s_sleep(1);
        if ((++sp & 255u) == 0u) { if (xb_ld(&bar[XB_TMO])) break; if (sp > XB_SPIN_CAP) { atomicAdd(&bar[XB_TMO], 1u); break; } }
    }
    nloc = mine > 0u ? mine : 1u; nx = cnt > 0u ? cnt : 1u;
}

__device__ __forceinline__ void xcd_barrier(const XcdBarrier& b) {
    asm volatile("s_waitcnt vmcnt(0)" ::: "memory");
    __syncthreads();
    if (threadIdx.x == 0) {
        unsigned* bar = b.bar;
        __builtin_amdgcn_s_waitcnt(0);
        unsigned nloc = b.st[0], nx = b.st[1];
        if (nloc == 0u) { xcd_barrier_complete(bar, b.x, nloc, nx); b.st[0] = nloc; b.st[1] = nx; }
        const unsigned old = xb_add(&bar[XB_XSUB(b.x)], 1u);
        const unsigned gen = old / nloc;
        if (old + 1u == (gen + 1u) * nloc) {
            __builtin_amdgcn_fence(__ATOMIC_RELEASE, "agent");
            asm volatile("s_waitcnt vmcnt(0)" ::: "memory");
            const unsigned og = xb_add(&bar[XB_TOP], 1u);
            const unsigned tg = og / nx;
            if (og + 1u == (tg + 1u) * nx) xb_add(&bar[XB_TOPGEN], 1u);
            else XB_SPIN(xb_ld(&bar[XB_TOPGEN]) == tg, bar);
            __builtin_amdgcn_fence(__ATOMIC_ACQUIRE, "agent");
            xb_add(&bar[XB_XGEN(b.x)], 1u);
            asm volatile("s_waitcnt vmcnt(0)" ::: "memory");
        } else {
            XB_SPIN(xb_ld(&bar[XB_XGEN(b.x)]) == gen, bar);
            __builtin_amdgcn_fence(__ATOMIC_ACQUIRE, "agent");
            asm volatile("s_waitcnt vmcnt(0)" ::: "memory");
        }
    }
    __syncthreads();
}

__device__ __forceinline__ void gsync_cg(cg::grid_group& grid) {
    asm volatile("s_waitcnt vmcnt(0) lgkmcnt(0)" ::: "memory");
    grid.sync();
    __builtin_amdgcn_fence(__ATOMIC_ACQUIRE, "agent");
    asm volatile("s_waitcnt vmcnt(0)" ::: "memory");
}
#define gsync(grid_) xcd_barrier(xbar)
__device__ __forceinline__ void grp_barrier(unsigned* gb, unsigned n, volatile LAS unsigned* ep, unsigned* tmo_bar) {
    asm volatile("s_waitcnt vmcnt(0)" ::: "memory");
    __syncthreads();
    if (threadIdx.x == 0) {
        __builtin_amdgcn_s_waitcnt(0);
        const unsigned e = ep[0];
        __builtin_amdgcn_fence(__ATOMIC_RELEASE, "agent");
        asm volatile("s_waitcnt vmcnt(0)" ::: "memory");
        const unsigned old_ = xb_add(gb, 1u);
        if (old_ + 1u == (e + 1u) * n) xb_add(gb + 64, 1u);
        else XB_SPIN(xb_ld(gb + 64) == e, tmo_bar);
        __builtin_amdgcn_fence(__ATOMIC_ACQUIRE, "agent");
        asm volatile("s_waitcnt vmcnt(0)" ::: "memory");
        ep[0] = e + 1u;
    }
    __syncthreads();
}
#define ggsync() grp_barrier((unsigned*)(p.ws + WS_CTL) + 4096 + 128 * grp, (unsigned)NL, (volatile LAS unsigned*)(lds + LDS_BYTES - 48), xbar.bar)

__device__ __forceinline__ int fresh_tid() { int t = threadIdx.x; asm volatile("" : "+v"(t)); return t; }
#ifndef DBG_STOP
#define DBG_STOP 0
#endif
#define DBG_CHECK(k) do { if (DBG_STOP == (k)) { for (int m_ = gw; m_ < MTOK; m_ += ngw) norm_row(X + (size_t)m_ * DM, p.in[36], nullptr, X + (size_t)m_ * DM, fresh_tid() & 63); return true; } } while (0)
template <int layer>
__device__ __forceinline__ bool run_layer(const Params& p, LAS unsigned char* lds, cg::grid_group& grid, const XcdBarrier& xbar, int wave, int G, int bid, int gw, int ngw, int nthreads) {
    unsigned char* ws = p.ws; const int grp = bid & 7, lidx = bid >> 3, NL = G >> 3;
    bf16* Hb = (bf16*)(ws + WS_H); bf16* PROJ = (bf16*)(ws + WS_PROJ); bf16* OBUF = (bf16*)(ws + WS_OBUF); bf16* OC = (bf16*)(ws + WS_OC); float* LSE = (float*)(ws + WS_LSE);
    bf16* ST = (bf16*)(ws + WS_ST); float* DD = (float*)(ws + WS_DD); bf16* KV = (bf16*)(ws + WS_KV);
    float* X = p.out; float* SSQ = (float*)(p.ws + WS_SSQ);
        { pg8::Gemm g{Hb, (const bf16*)(ws + WS_FF1IN), MTOK, 2 * DFF, DM}; pg8::StaticOrder S; S.init(MTOK, 2 * DFF, G, bid); pg8::EpiSwiglu E{PROJ, DFF, SSQ + (size_t)(layer * 4 + 0) * (MTOK * 8)};
          pg8::gemm_phase<pg8::EpiSwiglu, pg8::StaticOrder, true, true>(lds, g, S, E);
#ifdef EXP_DUP_FFNIN
          if (layer == 0) pg8::gemm_phase<pg8::EpiSwiglu, pg8::StaticOrder, true, true>(lds, g, S, E);
#endif
        }
        ggsync();
        { pg8::Gemm g{PROJ, (const bf16*)(ws + WS_FF1OUT), MTOK, DM, DFF}; pg8::StaticOrder S; S.init(MTOK, DM, G, bid); pg8::EpiResid<true, false> E{Hb, nullptr, SSQ + (size_t)(layer * 4 + 1) * (MTOK * 8), (LAS float*)(lds + 131072)};
          pg8::gemm_phase<pg8::EpiResid<true, false>, pg8::StaticOrder, true, true>(lds, g, S, E); }
        ggsync();
        if (layer == 0) {
            { pg8::Gemm g{Hb, (const bf16*)(ws + WS_MIXIN), MTOK, LD_AB, DM}; pg8::StaticOrder S; S.init(MTOK, LD_AB, G, bid); pg8::EpiPlain E{PROJ, LD_AB, SSQ + (size_t)(layer * 4 + 1) * (MTOK * 8)};
              pg8::gemm_phase<pg8::EpiPlain, pg8::StaticOrder, true, true>(lds, g, S, E); }
            ggsync();
#ifdef EXP_DUP_MA
            for (int rep_ = 0; rep_ < 2; ++rep_) {
#else
            {
#endif
#ifndef DBG_NO_A
            { const int tid = fresh_tid();
            for (int j = lidx; j < 384; j += NL) {
                const int cfg = j >> 7, v = j & 127, h = v & 7, rest = v >> 3, b = grp;
                const int dil = cfg == 0 ? 1 : (cfg == 1 ? 4 : 16), tiles = 16 / dil, r = rest / tiles, tile = rest % tiles, L = SEQ / dil, q0 = tile * 128;
                const bf16* base = PROJ + (size_t)b * SEQ * LD_AB + h * 128;
                const float slope = exp2f(-(float)(h + 1)) * (float)dil;
                banded_unit<128, 5, 1>(lds, tid, base, base + 1024, base + 2048, LD_AB, dil, r, L, q0 + 16 * wave, q0 - 64, 272, 16 * wave, 64, slope, 0.08838834764831845f, -1e30f, 0.f,
                                    OC + (size_t)cfg * MTOK * 1024 + (size_t)b * SEQ * 1024 + h * 128, 1024, LSE + (size_t)cfg * MTOK * 8 + (size_t)b * SEQ * 8 + h);
            } }
#endif
#ifndef DBG_NO_GLA
            { const int tid = fresh_tid(); for (int j = lidx; j < 128; j += NL) gla_stage1_unit(lds, tid, PROJ, grp * 128 + j, p.in[7], p.in[8], p.in[9], p.in[10], ST, DD); }
#endif
            }
            ggsync();
#if !defined(DBG_NO_GLA) && !defined(DBG_NO_SCAN)
            gla_scan(ST, DD, grp, lidx * 512 + fresh_tid(), NL * 512);
#endif
            ggsync();
#ifdef EXP_DUP_MC
            for (int rep_ = 0; rep_ < 2; ++rep_) {
#else
            {
#endif
#ifndef DBG_NO_GLA
            { const int tid = fresh_tid(); for (int j = lidx; j < 128; j += NL) gla_stage3_unit(lds, tid, PROJ, grp * 128 + j, p.in[7], p.in[8], p.in[9], p.in[10], ST, p.in[11], OBUF); }
#else
            for (int t_ = bid * 512 + fresh_tid(); t_ < MTOK * 128; t_ += nthreads) *(u32x4*)(OBUF + (size_t)(t_ >> 7) * DM + 1024 + (t_ & 127) * 8) = (u32x4){0u, 0u, 0u, 0u};
#endif
#ifndef DBG_NO_A
            combine_a(OC, LSE, OBUF, grp, lidx * 512 + fresh_tid(), NL * 512);
#else
            for (int t_ = bid * 512 + fresh_tid(); t_ < MTOK * 128; t_ += nthreads) *(u32x4*)(OBUF + (size_t)(t_ >> 7) * DM + (t_ & 127) * 8) = (u32x4){0u, 0u, 0u, 0u};
#endif
            }
            ggsync();
        } else {
            { pg8::Gemm g{Hb, (const bf16*)(ws + WS_MIXIN), MTOK, LD_C, DM}; pg8::StaticOrder S; S.init(MTOK, LD_C, G, bid); pg8::EpiPlain E{PROJ, LD_C, SSQ + (size_t)(layer * 4 + 1) * (MTOK * 8)};
              pg8::gemm_phase<pg8::EpiPlain, pg8::StaticOrder, true, true>(lds, g, S, E); }
            ggsync();
#ifdef EXP_DUP_C
            for (int rep_ = 0; rep_ < 2; ++rep_)
#endif
            { const int tid = fresh_tid();
            for (int j = lidx; j < 128; j += NL) {
                const int u = grp * 128 + j, qt = u & 31, gk = (u >> 5) & 3, b = u >> 7, head = gk * 8 + wave;
                const bf16* base = PROJ + (size_t)b * SEQ * LD_C;
                banded_unit<64, 10, 4>(lds, tid, base + head * 64, base + 2048 + gk * 64, base + 2304 + gk * 64, LD_C, 1, 0, SEQ, qt * 64, qt * 64 - 128, 320, 0, 128,
                                   exp2f(-0.25f * (float)(head + 1)), 0.125f, p.in[26][head], 1.f, OBUF + (size_t)b * SEQ * DM + head * 64, DM, nullptr);
            } }
            ggsync();
        }
        { pg8::Gemm g{OBUF, (const bf16*)(ws + WS_MIXOUT), MTOK, DM, DM}; pg8::StaticOrder S; S.init(MTOK, DM, G, bid); pg8::EpiResid<false, false> E{Hb, nullptr, SSQ + (size_t)(layer * 4 + 2) * (MTOK * 8), (LAS float*)(lds + 131072)};
          pg8::gemm_phase<pg8::EpiResid<false, false>, pg8::StaticOrder, true, true>(lds, g, S, E); }
        ggsync();
        { pg8::Gemm g{Hb, (const bf16*)(ws + WS_WQ), MTOK, DM, DM}; pg8::StaticOrder S; S.init(MTOK, DM, G, bid); pg8::EpiPlain E{PROJ, DM, SSQ + (size_t)(layer * 4 + 2) * (MTOK * 8)};
          pg8::gemm_phase<pg8::EpiPlain, pg8::StaticOrder, true, true>(lds, g, S, E); }
        ggsync();
        { const int tid = fresh_tid(); for (int j = lidx; j < 64; j += NL) xattn_unit(lds, tid, PROJ, KV + (size_t)layer * NBATCH * MEMLEN * 4096, OBUF, grp * 64 + j); }
#ifdef EXP_DUP_XATTN
        { const int tid = fresh_tid(); for (int j = lidx; j < 64; j += NL) xattn_unit(lds, tid, PROJ, KV + (size_t)layer * NBATCH * MEMLEN * 4096, OBUF, grp * 64 + j); }
#endif
        ggsync();
        { pg8::Gemm g{OBUF, (const bf16*)(ws + WS_WO), MTOK, DM, DM}; pg8::StaticOrder S; S.init(MTOK, DM, G, bid); pg8::EpiResid<false, false> E{Hb, nullptr, SSQ + (size_t)(layer * 4 + 3) * (MTOK * 8), (LAS float*)(lds + 131072)};
          pg8::gemm_phase<pg8::EpiResid<false, false>, pg8::StaticOrder, true, true>(lds, g, S, E); }
        ggsync();
        { pg8::Gemm g{Hb, (const bf16*)(ws + WS_FF2IN), MTOK, 2 * DFF, DM}; pg8::StaticOrder S; S.init(MTOK, 2 * DFF, G, bid); pg8::EpiSwiglu E{PROJ, DFF, SSQ + (size_t)(layer * 4 + 3) * (MTOK * 8)};
          pg8::gemm_phase<pg8::EpiSwiglu, pg8::StaticOrder, true, true>(lds, g, S, E); }
        ggsync();
        { pg8::Gemm g{PROJ, (const bf16*)(ws + WS_FF2OUT), MTOK, DM, DFF}; pg8::StaticOrder S; S.init(MTOK, DM, G, bid); pg8::EpiResid<true, layer == 1> E{Hb, X, SSQ + (size_t)(layer * 4 + 4) * (MTOK * 8), (LAS float*)(lds + 131072)};
          pg8::gemm_phase<pg8::EpiResid<true, layer == 1>, pg8::StaticOrder, true, true>(lds, g, S, E); }
        if (layer == 0) {
            gsync(grid);
            convert_weights<1>(p, lds, gw, ngw, wave, fresh_tid() & 63);
            gsync(grid);
        } else {
            ggsync();
            const int ftl = fresh_tid() & 63;
            const int mend = grp * SEQ + SEQ, mst = NL * 8; int m = grp * SEQ + lidx * 8 + wave;
            for (; m + mst < mend; m += 2 * mst) norm_row2(X + (size_t)m * DM, X + (size_t)(m + mst) * DM, p.in[36], nullptr, nullptr, X + (size_t)m * DM, X + (size_t)(m + mst) * DM, ftl);
            for (; m < mend; m += mst) norm_row(X + (size_t)m * DM, p.in[36], nullptr, X + (size_t)m * DM, ftl);
        }
    return false;
}

__global__ void __launch_bounds__(512, 2) mega_fwd(Params p) {
    extern __shared__ __attribute__((aligned(16))) unsigned char lds_raw[];
    LAS unsigned char* lds = (LAS unsigned char*)lds_raw;
    cg::grid_group grid = cg::this_grid();
    volatile LAS unsigned* xst = (volatile LAS unsigned*)(lds + LDS_BYTES - 64);
    if (threadIdx.x == 0) { xst[0] = 0u; xst[1] = 0u; xst[4] = 0u; }
    __syncthreads();
    const XcdBarrier xbar = xcd_barrier_post((unsigned*)(p.ws + WS_CTL), xst);
    const int wave = __builtin_amdgcn_readfirstlane((int)threadIdx.x >> 6);
    const int G = gridDim.x, bid = blockIdx.x, gw = bid * 8 + wave, ngw = G * 8, nthreads = G * 512;
    unsigned char* ws = p.ws;
    bf16* Hb = (bf16*)(ws + WS_H); bf16* PROJ = (bf16*)(ws + WS_PROJ); bf16* OBUF = (bf16*)(ws + WS_OBUF); bf16* OC = (bf16*)(ws + WS_OC); float* LSE = (float*)(ws + WS_LSE);
    bf16* ST = (bf16*)(ws + WS_ST); float* DD = (float*)(ws + WS_DD); bf16* KV = (bf16*)(ws + WS_KV); bf16* MEMH = (bf16*)(ws + WS_MEMH);
    float* X = p.out; float* SSQ = (float*)(p.ws + WS_SSQ);

    convert_weights<0>(p, lds, gw, ngw, wave, fresh_tid() & 63);
#ifdef EXP_DUP_CONVERT
    convert_weights<0>(p, lds, gw, ngw, wave, fresh_tid() & 63);
#endif
#ifdef EXP_SYNCS
    for (int i_ = 0; i_ < 20; ++i_) gsync(grid);
#endif
    norm_rows(p.in[1], p.in[14], MEMH, NBATCH * MEMLEN, gw, ngw, fresh_tid() & 63);
    norm_rows(p.in[1], p.in[29], MEMH + (size_t)NBATCH * MEMLEN * DM, NBATCH * MEMLEN, gw, ngw, fresh_tid() & 63);
    cast_rows_ssq(p.in[0], Hb, SSQ, MTOK, gw, ngw, fresh_tid() & 63);
    gsync_cg(grid);
    {
        const int grp = bid & 7, lidx = bid >> 3, NL = G >> 3;
        for (int j = lidx; j < 32; j += NL) { const int ly = j >> 4;
            pg8::Gemm g0{MEMH + (size_t)ly * NBATCH * MEMLEN * DM, (const bf16*)(ws + (ly ? WS_WKV1 : WS_WKV0)), NBATCH * MEMLEN, 4096, DM};
            pg8::OneUnit S0{{grp, j & 15}}; pg8::EpiPlain E0{KV + (size_t)ly * NBATCH * MEMLEN * 4096, 4096, nullptr};
            pg8::gemm_phase<pg8::EpiPlain, pg8::OneUnit, true, true>(lds, g0, S0, E0); }
    }
    if (run_layer<0>(p, lds, grid, xbar, wave, G, bid, gw, ngw, nthreads)) return;
    if (run_layer<1>(p, lds, grid, xbar, wave, G, bid, gw, ngw, nthreads)) return;
}

extern "C" void kernel_launch(void* const* d_in, const int* in_sizes, int n_in, void* d_out, int out_size, void* d_ws, size_t ws_size, hipStream_t stream) {
    static int grid = 0;
    if (grid == 0) {
        if (n_in != 37 || out_size != MTOK * DM || ws_size < WS_END) { fprintf(stderr, "kernel_launch: unexpected shapes (n_in %d out %d ws %zu)\n", n_in, out_size, ws_size); grid = -1; return; }
        int dev = 0, cus = 0, per_cu = 0;
        hipGetDevice(&dev);
        hipDeviceGetAttribute(&cus, hipDeviceAttributeMultiprocessorCount, dev);
        hipFuncSetAttribute((const void*)mega_fwd, hipFuncAttributeMaxDynamicSharedMemorySize, LDS_BYTES);
        if (hipOccupancyMaxActiveBlocksPerMultiprocessor(&per_cu, (const void*)mega_fwd, 512, LDS_BYTES) != hipSuccess || per_cu < 1) per_cu = 1;
        (void)hipGetLastError();
        grid = (cus * per_cu) & ~7;
    }
    if (grid < 0) return;
    if (hipMemsetAsync((char*)d_ws + WS_CTL, 0, 32768, stream) != hipSuccess) { fprintf(stderr, "kernel_launch: memset of the barrier words failed\n"); return; }
    Params p{};
    for (int i = 0; i < 37; ++i) p.in[i] = (const float*)d_in[i];
    p.out = (float*)d_out; p.ws = (unsigned char*)d_ws;
    void* args[] = {&p};
    hipError_t e = hipLaunchCooperativeKernel((const void*)mega_fwd, dim3(grid), dim3(512), args, LDS_BYTES, stream);
    if (e != hipSuccess) fprintf(stderr, "cooperative launch failed: %s (grid %d)\n", hipGetErrorString(e), grid);
}
```

```cpp
#include <hip/hip_runtime.h>
#include <hip/hip_cooperative_groups.h>
#include <cstdio>
#include <cstdint>
namespace cg = cooperative_groups;
namespace pg8 {
#define PG8_LAS __attribute__((address_space(3)))
typedef unsigned short bf16_t;
typedef short bf16x8 __attribute__((ext_vector_type(8)));
typedef float f32x4 __attribute__((ext_vector_type(4)));
typedef unsigned u32x4 __attribute__((ext_vector_type(4)));
constexpr int BM = 256, BK = 64, HALF = 128, HTB = HALF * BK * 2  , STAGE_BYTES = 8 * HTB, NXCD = 8, WGM = 8;

__host__ __device__ __forceinline__ int lds_byte(int r, int c) { const int st = (r >> 4) * 2 + (c >> 5), rr = r & 15, cc = c & 31, ob = rr * 64 + cc * 2; return st * 1024 + (ob ^ (((ob >> 9) & 1) << 5)); }
__host__ __device__ __forceinline__ void stage_rc(int b, int& R, int& C) { const int st = b / 1024, sb = b % 1024, swz = sb ^ (((sb >> 9) & 1) << 5); R = (st >> 1) * 16 + swz / 64; C = (st & 1) * 32 + (swz % 64) / 2; }
__host__ __device__ __forceinline__ int perm32(int rho) { const int n = rho >> 4, i = rho & 15; return 8 * (i >> 2) + 4 * n + (i & 3); }

struct Unit { int pm, pn; };
struct Gemm { const bf16_t* A; const bf16_t* Bt; int M, N, K; };

struct StaticOrder {
    int nM, nN, nwg, G, c;
    __host__ __device__ void init(int M, int N, int G_, int c_) { nM = M / BM; nN = N / BM; nwg = nM * nN; G = G_; c = c_; }
    __host__ __device__ bool next(int i, Unit& u) const {
        const long L = (long)i * G + c; if (L >= nwg) return false;
        int wgid = (int)L; { const int q = nwg / NXCD, r = nwg % NXCD, xcd = wgid % NXCD, off = wgid / NXCD; wgid = (xcd < r ? xcd * (q + 1) : r * (q + 1) + (xcd - r) * q) + off; }
        const int nig = WGM * nN, gid = wgid / nig, fm = gid * WGM, gsz = (nM - fm) < WGM ? (nM - fm) : WGM;
        u.pm = fm + ((wgid % nig) % gsz); u.pn = (wgid % nig) / gsz; return true;
    }
    __device__ __forceinline__ void a_ready(const Unit&) const {}
    __device__ __forceinline__ void done(const Unit&) const {}
};

typedef float f32x2_cv __attribute__((ext_vector_type(2))); typedef __bf16 bf16x2_cv __attribute__((ext_vector_type(2)));
__device__ __forceinline__ unsigned cvt_pk_bf16(float lo, float hi) { const f32x2_cv v = {lo, hi}; const bf16x2_cv b = __builtin_convertvector(v, bf16x2_cv); return __builtin_bit_cast(unsigned, b); }
template <class Epi, class Sched, bool ALIGN_EPI = false, bool SP2 = false>
__device__ __forceinline__ void gemm_phase(PG8_LAS unsigned char* lds, const Gemm g, const Sched& S, const Epi& E) {
    int tid_l = threadIdx.x; asm volatile("" : "+v"(tid_l));
    const int tid = tid_l, wid = __builtin_amdgcn_readfirstlane(tid >> 6), lane = tid & 63, wr = wid >> 2, wc = wid & 3, fr = lane & 15, fq = lane >> 4;
    const int K = g.K, nt = K / BK;
    unsigned voffA[2], voffB[2];
#pragma unroll
    for (int i = 0; i < 2; ++i) { int R, C; stage_rc(tid * 16 + i * 8192, R, C); const int Rb = Epi::PERM ? ((R & ~31) + perm32(R & 31)) : R;
        voffA[i] = (unsigned)(R * K + C) * 2u; voffB[i] = (unsigned)(Rb * K + C) * 2u; }
    const size_t kstep = (size_t)(BK * 2);
    const size_t hstep = (size_t)HALF * K * 2;
    const size_t tstep = 2 * hstep;
    const unsigned ldsw = (unsigned)wid * 1024u;
    const int aoff = lds_byte(wr * 64 + fr, fq * 8), boff = lds_byte(wc * 32 + fr, fq * 8);
#define PG8_SA(b, h) (((b) * 2 + (h)) * HTB)
#define PG8_SB(b, h) ((4 + (b) * 2 + (h)) * HTB)
#define PG8_STAGE(bufoff, gbase, voff) do { _Pragma("unroll") for (int _i = 0; _i < 2; ++_i) \
        __builtin_amdgcn_global_load_lds((const unsigned*)((const char*)(gbase) + (voff)[_i]), (PG8_LAS unsigned*)(lds + (bufoff) + ldsw + _i * 8192), 16, 0, 0); } while (0)
#define PG8_LDA(dst, b, h) do { _Pragma("unroll") for (int m = 0; m < 4; ++m) _Pragma("unroll") for (int k = 0; k < 2; ++k) dst[m][k] = *(const PG8_LAS bf16x8*)(lds + PG8_SA(b, h) + aoff + m * 2048 + k * 1024); } while (0)
#define PG8_LDB(dst, b, h) do { _Pragma("unroll") for (int n = 0; n < 2; ++n) _Pragma("unroll") for (int k = 0; k < 2; ++k) dst[n][k] = *(const PG8_LAS bf16x8*)(lds + PG8_SB(b, h) + boff + n * 2048 + k * 1024); } while (0)
#define PG8_MMA(ai, bj, At, Bt) do { __builtin_amdgcn_s_setprio(1); _Pragma("unroll") for (int m = 0; m < 4; ++m) _Pragma("unroll") for (int n = 0; n < 2; ++n) _Pragma("unroll") for (int k = 0; k < 2; ++k) \
        acc[ai][bj][m][n] = __builtin_amdgcn_mfma_f32_16x16x32_bf16(Bt[n][k], At[m][k], acc[ai][bj][m][n], 0, 0, 0); __builtin_amdgcn_s_setprio(0); } while (0)
#define PG8_WAIT_V(n) asm volatile("s_waitcnt vmcnt(" #n ")" ::: "memory")
#define PG8_WAIT_L(n) asm volatile("s_waitcnt lgkmcnt(" #n ")" ::: "memory")
#define PG8_BAR __builtin_amdgcn_s_barrier()
#define PG8_SCHED __builtin_amdgcn_sched_barrier(0)
    Unit cur, nxt; int ui = 0;
    if (!S.next(0, cur)) return;
    f32x4 acc[2][2][4][2];
#pragma unroll
    for (int a = 0; a < 2; ++a)
#pragma unroll
        for (int b = 0; b < 2; ++b)
#pragma unroll
            for (int m = 0; m < 4; ++m)
#pragma unroll
                for (int n = 0; n < 2; ++n) acc[a][b][m][n] = (f32x4){0.f, 0.f, 0.f, 0.f};
    bf16x8 At[4][2], B0[2][2], B1[2][2];
    const char* cA = (const char*)g.A + (size_t)cur.pm * tstep; const char* cB = (const char*)g.Bt + (size_t)cur.pn * tstep;
    S.a_ready(cur);
    if constexpr (SP2) {
        PG8_STAGE(PG8_SB(0, 0), cB, voffB); PG8_STAGE(PG8_SB(0, 1), cB + hstep, voffB); PG8_STAGE(PG8_SA(0, 0), cA, voffA); PG8_STAGE(PG8_SA(0, 1), cA + hstep, voffA);
        if (wr == 1) PG8_BAR;
        PG8_WAIT_V(2); PG8_BAR;
        PG8_STAGE(PG8_SB(1, 0), cB + kstep, voffB); PG8_STAGE(PG8_SA(1, 0), cA + kstep, voffA); PG8_STAGE(PG8_SB(1, 1), cB + hstep + kstep, voffB);
        PG8_WAIT_V(6); PG8_BAR;
    } else {
        PG8_STAGE(PG8_SB(0, 0), cB, voffB); PG8_STAGE(PG8_SA(0, 0), cA, voffA); PG8_STAGE(PG8_SB(0, 1), cB + hstep, voffB); PG8_STAGE(PG8_SA(0, 1), cA + hstep, voffA);
        if (wr == 1) PG8_BAR;
        PG8_WAIT_V(4); PG8_BAR;
        PG8_STAGE(PG8_SB(1, 0), cB + kstep, voffB); PG8_STAGE(PG8_SA(1, 0), cA + kstep, voffA); PG8_STAGE(PG8_SB(1, 1), cB + hstep + kstep, voffB);
        PG8_WAIT_V(6); PG8_BAR;
    }
    for (;;) {
        const bool has_next = S.next(ui + 1, nxt);
        const char* nA = has_next ? (const char*)g.A + (size_t)nxt.pm * tstep : cA; const char* nB = has_next ? (const char*)g.Bt + (size_t)nxt.pn * tstep : cB;
        for (int t = 0; t < nt; t += 2) {
            const bool last = (t == nt - 2);
            const char* a1 = cA + (size_t)(t + 1) * kstep;
            const char* a2 = last ? nA : cA + (size_t)(t + 2) * kstep; const char* b2 = last ? nB : cB + (size_t)(t + 2) * kstep;
            const char* a3 = a2 + kstep; const char* b3 = b2 + kstep;
            if (last && has_next) S.a_ready(nxt);
            if constexpr (SP2) {
            PG8_LDB(B0, 0, 0); PG8_LDB(B1, 0, 1); PG8_SCHED; PG8_LDA(At, 0, 0); PG8_STAGE(PG8_SA(1, 1), a1 + hstep, voffA);
            PG8_WAIT_V(8); PG8_WAIT_L(0); PG8_BAR; PG8_MMA(0, 0, At, B0); PG8_MMA(0, 1, At, B1); PG8_BAR; PG8_SCHED;
            PG8_LDA(At, 0, 1); PG8_STAGE(PG8_SB(0, 0), b2, voffB); PG8_STAGE(PG8_SB(0, 1), b2 + hstep, voffB); PG8_STAGE(PG8_SA(0, 0), a2, voffA);
            PG8_WAIT_V(8); PG8_WAIT_L(0); PG8_BAR; PG8_MMA(1, 0, At, B0); PG8_MMA(1, 1, At, B1); PG8_BAR; PG8_SCHED;
            PG8_LDB(B0, 1, 0); PG8_LDB(B1, 1, 1); PG8_SCHED; PG8_LDA(At, 1, 0); PG8_STAGE(PG8_SA(0, 1), a2 + hstep, voffA);
            PG8_WAIT_V(8); PG8_WAIT_L(0); PG8_BAR; PG8_MMA(0, 0, At, B0); PG8_MMA(0, 1, At, B1); PG8_BAR; PG8_SCHED;
            PG8_LDA(At, 1, 1); PG8_STAGE(PG8_SB(1, 0), b3, voffB); PG8_STAGE(PG8_SB(1, 1), b3 + hstep, voffB); PG8_STAGE(PG8_SA(1, 0), a3, voffA);
            PG8_WAIT_V(8); PG8_WAIT_L(0); PG8_BAR; PG8_MMA(1, 0, At, B0); PG8_MMA(1, 1, At, B1); PG8_BAR; PG8_SCHED;
            } else {
            PG8_LDB(B0, 0, 0); PG8_SCHED; PG8_LDA(At, 0, 0); PG8_STAGE(PG8_SA(1, 1), a1 + hstep, voffA);
            PG8_WAIT_L(8); PG8_BAR; PG8_WAIT_L(0); PG8_MMA(0, 0, At, B0); PG8_BAR; PG8_SCHED;
            PG8_LDB(B1, 0, 1); PG8_STAGE(PG8_SB(0, 0), b2, voffB);
            PG8_BAR; PG8_WAIT_L(0); PG8_MMA(0, 1, At, B1); PG8_BAR;
            PG8_LDA(At, 0, 1); PG8_STAGE(PG8_SA(0, 0), a2, voffA);
            PG8_BAR; PG8_WAIT_L(0); PG8_MMA(1, 0, At, B0); PG8_BAR; PG8_SCHED;
            PG8_STAGE(PG8_SB(0, 1), b2 + hstep, voffB);
            PG8_WAIT_V(6); PG8_BAR; PG8_MMA(1, 1, At, B1); PG8_BAR;
            PG8_LDB(B0, 1, 0); PG8_SCHED; PG8_LDA(At, 1, 0); PG8_STAGE(PG8_SA(0, 1), a2 + hstep, voffA);
            PG8_WAIT_L(8); PG8_BAR; PG8_WAIT_L(0); PG8_MMA(0, 0, At, B0); PG8_BAR; PG8_SCHED;
            PG8_LDB(B1, 1, 1); PG8_STAGE(PG8_SB(1, 0), b3, voffB);
            PG8_BAR; PG8_WAIT_L(0); PG8_MMA(0, 1, At, B1); PG8_BAR;
            PG8_LDA(At, 1, 1); PG8_STAGE(PG8_SA(1, 0), a3, voffA);
            PG8_BAR; PG8_WAIT_L(0); PG8_MMA(1, 0, At, B0); PG8_BAR; PG8_SCHED;
            PG8_STAGE(PG8_SB(1, 1), b3 + hstep, voffB);
            PG8_WAIT_V(6); PG8_BAR; PG8_MMA(1, 1, At, B1); PG8_BAR;
            }
        }
        if constexpr (ALIGN_EPI) { if (wr == 0) PG8_BAR; }
        if constexpr (!Epi::AFTER_DRAIN) { E(acc, cur, wr, wc, fr, fq); S.done(cur); }
        if (!has_next) break;
#pragma unroll
        for (int a = 0; a < 2; ++a)
#pragma unroll
            for (int b = 0; b < 2; ++b)
#pragma unroll
                for (int m = 0; m < 4; ++m)
#pragma unroll
                    for (int n = 0; n < 2; ++n) acc[a][b][m][n] = (f32x4){0.f, 0.f, 0.f, 0.f};
        cur = nxt; cA = nA; cB = nB; ++ui;
        if constexpr (ALIGN_EPI) { if (wr == 1) PG8_BAR; }
    }
    PG8_WAIT_V(0);
    if constexpr (!ALIGN_EPI) { if (wr == 0) PG8_BAR; }
    PG8_BAR;
    if constexpr (Epi::AFTER_DRAIN) { E.fused(acc, cur, wr, wc, fr, fq, lds, wid, lane); S.done(cur); }
#undef PG8_SA
#undef PG8_SB
#undef PG8_STAGE
#undef PG8_LDA
#undef PG8_LDB
#undef PG8_MMA
#undef PG8_WAIT_V
#undef PG8_WAIT_L
#undef PG8_BAR
#undef PG8_SCHED
}
}

namespace pg8 {
struct EpiPlain {
    static constexpr bool PERM = true, AFTER_DRAIN = false;
    bf16_t* O; int ldc; const float* ssq;
    __device__ __forceinline__ void operator()(const f32x4 (&acc)[2][2][4][2], const Unit& u, int wr, int wc, int fr, int fq) const {
        const int row0 = u.pm * BM + wr * 64 + fr, col0 = u.pn * BM + wc * 32 + 8 * fq;
#pragma unroll
        for (int ai = 0; ai < 2; ++ai)
#pragma unroll
            for (int m = 0; m < 4; ++m) { const int row = row0 + ai * HALF + m * 16; bf16_t* rowp = O + (size_t)row * ldc + col0;
                float rs = 1.f; if (ssq) { const f32x4 p0 = *(const f32x4*)(ssq + (size_t)row * 8), p1 = *(const f32x4*)(ssq + (size_t)row * 8 + 4); rs = rsqrtf((((p0[0] + p0[1]) + (p0[2] + p0[3])) + ((p1[0] + p1[1]) + (p1[2] + p1[3]))) * (1.f / 2048.f) + 1e-6f); }
#pragma unroll
                for (int bj = 0; bj < 2; ++bj) { const f32x4 v0 = acc[ai][bj][m][0] * rs, v1 = acc[ai][bj][m][1] * rs;
                    u32x4 w; w.x = cvt_pk_bf16(v0[0], v0[1]); w.y = cvt_pk_bf16(v0[2], v0[3]); w.z = cvt_pk_bf16(v1[0], v1[1]); w.w = cvt_pk_bf16(v1[2], v1[3]);
                    *(u32x4*)(rowp + bj * HALF) = w; } }
    }
};
__device__ __forceinline__ float silu_f(float x) { return x * __builtin_amdgcn_rcpf(1.f + __builtin_amdgcn_exp2f(x * -1.4426950408889634f)); }
struct EpiSwiglu {
    static constexpr bool PERM = true, AFTER_DRAIN = false;
    bf16_t* O; int ldc; const float* ssq;
    __device__ __forceinline__ void operator()(const f32x4 (&acc)[2][2][4][2], const Unit& u, int wr, int wc, int fr, int fq) const {
        const int row0 = u.pm * BM + wr * 64 + fr, col0 = u.pn * HALF + wc * 32 + 8 * fq;
#pragma unroll
        for (int ai = 0; ai < 2; ++ai)
#pragma unroll
            for (int m = 0; m < 4; ++m) { const int row = row0 + ai * HALF + m * 16; bf16_t* rowp = O + (size_t)row * ldc + col0;
                const f32x4 p0 = *(const f32x4*)(ssq + (size_t)row * 8), p1 = *(const f32x4*)(ssq + (size_t)row * 8 + 4); const float rs = rsqrtf((((p0[0] + p0[1]) + (p0[2] + p0[3])) + ((p1[0] + p1[1]) + (p1[2] + p1[3]))) * (1.f / 2048.f) + 1e-6f);
                const f32x4 g0 = acc[ai][0][m][0] * rs, g1 = acc[ai][0][m][1] * rs, u0 = acc[ai][1][m][0] * rs, u1 = acc[ai][1][m][1] * rs;
                u32x4 w;
                w.x = cvt_pk_bf16(silu_f(g0[0]) * u0[0], silu_f(g0[1]) * u0[1]); w.y = cvt_pk_bf16(silu_f(g0[2]) * u0[2], silu_f(g0[3]) * u0[3]);
                w.z = cvt_pk_bf16(silu_f(g1[0]) * u1[0], silu_f(g1[1]) * u1[1]); w.w = cvt_pk_bf16(silu_f(g1[2]) * u1[2], silu_f(g1[3]) * u1[3]);
                *(u32x4*)rowp = w; }
    }
};
template <bool HALF_ALPHA, bool F32OUT> struct EpiResid {
    static constexpr bool PERM = true, AFTER_DRAIN = false;
    bf16_t* xb; float* fout; float* ssqp; PG8_LAS float* red;
    __device__ __forceinline__ void operator()(const f32x4 (&acc)[2][2][4][2], const Unit& u, int wr, int wc, int fr, int fq) const {
        const int col0 = u.pn * BM + wc * 32 + 8 * fq; const float alpha = HALF_ALPHA ? 0.5f : 1.0f;
#pragma unroll
        for (int ai = 0; ai < 2; ++ai)
#pragma unroll
            for (int m = 0; m < 4; ++m) { const int rl = ai * HALF + wr * 64 + m * 16 + fr; const size_t off = (size_t)(u.pm * BM + rl) * 2048 + col0; float sq = 0.f;
#pragma unroll
                for (int bj = 0; bj < 2; ++bj) { const size_t o = off + bj * HALF; const u32x4 bw = *(const u32x4*)(xb + o);
                    const f32x4 b0 = {__uint_as_float(bw.x << 16), __uint_as_float(bw.x & 0xffff0000u), __uint_as_float(bw.y << 16), __uint_as_float(bw.y & 0xffff0000u)};
                    const f32x4 b1 = {__uint_as_float(bw.z << 16), __uint_as_float(bw.z & 0xffff0000u), __uint_as_float(bw.w << 16), __uint_as_float(bw.w & 0xffff0000u)};
                    const f32x4 v0 = b0 + acc[ai][bj][m][0] * alpha, v1 = b1 + acc[ai][bj][m][1] * alpha;
                    if (F32OUT) { *(f32x4*)(fout + o) = v0; *(f32x4*)(fout + o + 4) = v1; }
                    else { u32x4 w; w.x = cvt_pk_bf16(v0[0], v0[1]); w.y = cvt_pk_bf16(v0[2], v0[3]); w.z = cvt_pk_bf16(v1[0], v1[1]); w.w = cvt_pk_bf16(v1[2], v1[3]); *(u32x4*)(xb + o) = w;
                        sq += ((v0[0] * v0[0] + v0[1] * v0[1]) + (v0[2] * v0[2] + v0[3] * v0[3])) + ((v1[0] * v1[0] + v1[1] * v1[1]) + (v1[2] * v1[2] + v1[3] * v1[3])); } }
                if (!F32OUT) { sq += __shfl_xor(sq, 16); sq += __shfl_xor(sq, 32); if (fq == 0) red[rl * 4 + wc] = sq; } }
        if (!F32OUT) {
            asm volatile("s_waitcnt lgkmcnt(0)" ::: "memory"); __builtin_amdgcn_s_barrier(); asm volatile("" ::: "memory");
            const int t = (wr * 4 + wc) * 64 + fq * 16 + fr;
            if (t < 256) { const f32x4 v = *(const PG8_LAS f32x4*)(red + t * 4); ssqp[(size_t)(u.pm * BM + t) * 8 + u.pn] = (v[0] + v[1]) + (v[2] + v[3]); } }
    }
};
}

#define LAS __attribute__((address_space(3)))
typedef unsigned short bf16;
typedef float f32x4 __attribute__((ext_vector_type(4)));
typedef short bf16x8 __attribute__((ext_vector_type(8)));
typedef short s16x4 __attribute__((ext_vector_type(4)));
typedef unsigned u32x4 __attribute__((ext_vector_type(4)));
typedef unsigned u32x2 __attribute__((ext_vector_type(2)));

constexpr int MTOK = 16384, DM = 2048, SEQ = 2048, NBATCH = 8, DFF = 5504, MEMLEN = 256;
constexpr int LD_AB = 6400, LD_C = 2560;
constexpr float EPS = 1e-6f;
constexpr size_t MiB = 1u << 20;
constexpr size_t WS_FF1IN = 0, WS_FF1OUT = 44 * MiB, WS_FF2IN = 66 * MiB, WS_FF2OUT = 110 * MiB, WS_MIXIN = 132 * MiB, WS_MIXOUT = 157 * MiB,
                 WS_WQ = 165 * MiB, WS_WO = 173 * MiB, WS_WKV0 = 181 * MiB, WS_WKV1 = 197 * MiB, WS_H = 213 * MiB, WS_PROJ = 277 * MiB, WS_OBUF = 477 * MiB,
                 WS_OC = 541 * MiB, WS_LSE = 637 * MiB, WS_ST = 639 * MiB, WS_DD = 767 * MiB, WS_KV = 768 * MiB, WS_MEMH = 800 * MiB, WS_CTL = 816 * MiB, WS_SSQ = 817 * MiB, WS_END = 822 * MiB;
constexpr int LDS_BYTES = 147456;

struct Params { const float* in[37]; float* out; unsigned char* ws; };

__device__ __forceinline__ unsigned pk2(float lo, float hi) { return pg8::cvt_pk_bf16(lo, hi); }
__device__ __forceinline__ float bflo(unsigned w) { return __uint_as_float(w << 16); }
__device__ __forceinline__ float bfhi(unsigned w) { return __uint_as_float(w & 0xffff0000u); }
__device__ __forceinline__ float wave_sum(float v) {
#pragma unroll
    for (int o = 1; o < 64; o <<= 1) v += __shfl_xor(v, o);
    return v;
}
__device__ __forceinline__ f32x4 mfma16(bf16x8 a, bf16x8 b, f32x4 c) { return __builtin_amdgcn_mfma_f32_16x16x32_bf16(a, b, c, 0, 0, 0); }
__device__ __forceinline__ bf16x8 lds16(const LAS unsigned char* p) { return *(const LAS bf16x8*)p; }
__device__ __forceinline__ bf16x8 vtr8(const LAS unsigned char* p0, const LAS unsigned char* p1) {
    const s16x4 lo = __builtin_bit_cast(s16x4, __builtin_amdgcn_ds_read_tr16_b64_v4i16((LAS s16x4*)p0));
    const s16x4 hi = __builtin_bit_cast(s16x4, __builtin_amdgcn_ds_read_tr16_b64_v4i16((LAS s16x4*)p1));
    return (bf16x8){lo[0], lo[1], lo[2], lo[3], hi[0], hi[1], hi[2], hi[3]};
}

__device__ __forceinline__ void transpose_item(const float* __restrict__ W, const float* __restrict__ gain, int K, int N, bf16* __restrict__ WT, int mode, LAS float* scr, int item, int lane) {
    const int nblk = N / 32, kb = item / nblk, nb = item % nblk, k0 = 64 * kb, n0 = 32 * nb;
    int drow0 = n0;
    if (mode == 1) { const int up = n0 >= DFF ? 1 : 0, j = n0 - up * DFF; drow0 = (j >> 7) * 256 + (j & 127) + up * 128; }
#pragma unroll
    for (int i = 0; i < 8; ++i) { const int kk = 8 * i + (lane >> 3), n4 = (lane & 7) * 4;
        const f32x4 v = *(const f32x4*)(W + (size_t)(k0 + kk) * N + n0 + n4); const float gk = gain ? gain[k0 + kk] : 1.f;
        LAS float* d = scr + kk * 33 + n4; d[0] = v[0] * gk; d[1] = v[1] * gk; d[2] = v[2] * gk; d[3] = v[3] * gk; }
    asm volatile("s_waitcnt lgkmcnt(0)" ::: "memory");
    const int c = lane & 7;
#pragma unroll
    for (int j = 0; j < 4; ++j) { const int n = (lane >> 3) + 8 * j; const LAS float* s = scr + (8 * c) * 33 + n;
        u32x4 o; o.x = pk2(s[0 * 33], s[1 * 33]); o.y = pk2(s[2 * 33], s[3 * 33]); o.z = pk2(s[4 * 33], s[5 * 33]); o.w = pk2(s[6 * 33], s[7 * 33]);
        *(u32x4*)(WT + (size_t)(drow0 + n) * K + k0 + 8 * c) = o; }
    asm volatile("s_waitcnt lgkmcnt(0)" ::: "memory");
}
struct TD { const float* W; const float* gain; int K, N, mode; size_t dst; };
__device__ __forceinline__ TD get_td(const Params& p, int layer, int i) {
    TD t; t.mode = 0; t.K = DM; t.N = DM; t.W = nullptr; t.gain = nullptr; t.dst = 0;
    if (layer == 0) {
        switch (i) {
            case 0: t.W = p.in[3]; t.gain = p.in[2]; t.N = 2 * DFF; t.mode = 1; t.dst = WS_FF1IN; break;
            case 1: t.W = p.in[4]; t.K = DFF; t.dst = WS_FF1OUT; break;
            case 2: t.W = p.in[6]; t.gain = p.in[5]; t.N = 6176; t.dst = WS_MIXIN; break;
            case 3: t.W = p.in[12]; t.dst = WS_MIXOUT; break;
            case 4: t.W = p.in[15]; t.gain = p.in[13]; t.dst = WS_WQ; break;
            case 5: t.W = p.in[16]; t.N = 4096; t.dst = WS_WKV0; break;
            case 6: t.W = p.in[17]; t.dst = WS_WO; break;
            case 7: t.W = p.in[19]; t.gain = p.in[18]; t.N = 2 * DFF; t.mode = 1; t.dst = WS_FF2IN; break;
            case 8: t.W = p.in[20]; t.K = DFF; t.dst = WS_FF2OUT; break;
            default: t.W = p.in[31]; t.N = 4096; t.dst = WS_WKV1; break;
        }
    } else {
        switch (i) {
            case 0: t.W = p.in[22]; t.gain = p.in[21]; t.N = 2 * DFF; t.mode = 1; t.dst = WS_FF1IN; break;
            case 1: t.W = p.in[23]; t.K = DFF; t.dst = WS_FF1OUT; break;
            case 2: t.W = p.in[25]; t.gain = p.in[24]; t.N = 2560; t.dst = WS_MIXIN; break;
            case 3: t.W = p.in[27]; t.dst = WS_MIXOUT; break;
            case 4: t.W = p.in[30]; t.gain = p.in[28]; t.dst = WS_WQ; break;
            case 5: t.W = p.in[32]; t.dst = WS_WO; break;
            case 6: t.W = p.in[34]; t.gain = p.in[33]; t.N = 2 * DFF; t.mode = 1; t.dst = WS_FF2IN; break;
            default: t.W = p.in[35]; t.K = DFF; t.dst = WS_FF2OUT; break;
        }
    }
    return t;
}
template <int layer>
__device__ __forceinline__ void convert_weights(const Params& p, LAS unsigned char* lds, int gw, int ngw, int wave, int lane) {
    LAS float* scr = (LAS float*)(lds + wave * 16384);
    constexpr int nmat = layer == 0 ? 10 : 8;
#pragma unroll
    for (int i = 0; i < nmat; ++i) {
        const TD t = get_td(p, layer, i);
        const float* W = t.W; bf16* WT = (bf16*)(p.ws + t.dst);
        const int items = (t.K / 64) * (t.N / 32);
        for (int it = gw; it < items; it += ngw) transpose_item(W, t.gain, t.K, t.N, WT, t.mode, scr, it, lane);
    }
}
__device__ __forceinline__ void norm_row(const float* xrow, const float* gain, bf16* orow, float* of, int lane) {
    const f32x4* xr = (const f32x4*)xrow + lane;
    f32x4 v[8]; float s = 0.f;
#pragma unroll
    for (int j = 0; j < 8; ++j) { v[j] = xr[64 * j]; s += (v[j].x * v[j].x + v[j].y * v[j].y) + (v[j].z * v[j].z + v[j].w * v[j].w); }
    const float rstd = rsqrtf(wave_sum(s) * (1.f / DM) + EPS);
    const f32x4* gr = (const f32x4*)gain + lane;
#pragma unroll
    for (int j = 0; j < 8; ++j) { const f32x4 g = gr[64 * j]; const f32x4 y = v[j] * rstd * g;
        if (of) ((f32x4*)of)[64 * j + lane] = y;
        else { u32x2 w; w.x = pk2(y.x, y.y); w.y = pk2(y.z, y.w); ((u32x2*)orow)[64 * j + lane] = w; } }
}
__device__ __forceinline__ void cast_rows_ssq(const float* x, bf16* xb, float* ssq, int nrows, int gw, int ngw, int lane) {
    for (int m = gw; m < nrows; m += ngw) { const f32x4* xr = (const f32x4*)(x + (size_t)m * DM) + lane; float s_ = 0.f; f32x4 v[8];
#pragma unroll
        for (int j = 0; j < 8; ++j) v[j] = xr[64 * j];
#pragma unroll
        for (int j = 0; j < 8; ++j) { s_ += (v[j].x * v[j].x + v[j].y * v[j].y) + (v[j].z * v[j].z + v[j].w * v[j].w);
            u32x2 w; w.x = pk2(v[j].x, v[j].y); w.y = pk2(v[j].z, v[j].w); ((u32x2*)(xb + (size_t)m * DM))[64 * j + lane] = w; }
        s_ = wave_sum(s_); if (lane < 8) ssq[(size_t)m * 8 + lane] = lane == 0 ? s_ : 0.f; }
}
__device__ __forceinline__ void norm_row2(const float* xa, const float* xb_, const float* gain, bf16* oa, bf16* ob_, float* fa, float* fb, int lane) {
    const f32x4* ra = (const f32x4*)xa + lane; const f32x4* rb = (const f32x4*)xb_ + lane;
    f32x4 va[8], vb[8]; float sa = 0.f, sb = 0.f;
#pragma unroll
    for (int j = 0; j < 8; ++j) { va[j] = ra[64 * j]; vb[j] = rb[64 * j]; }
#pragma unroll
    for (int j = 0; j < 8; ++j) { sa += (va[j].x * va[j].x + va[j].y * va[j].y) + (va[j].z * va[j].z + va[j].w * va[j].w); sb += (vb[j].x * vb[j].x + vb[j].y * vb[j].y) + (vb[j].z * vb[j].z + vb[j].w * vb[j].w); }
    const float rsa = rsqrtf(wave_sum(sa) * (1.f / DM) + EPS), rsb = rsqrtf(wave_sum(sb) * (1.f / DM) + EPS);
    const f32x4* gr = (const f32x4*)gain + lane;
#pragma unroll
    for (int j = 0; j < 8; ++j) { const f32x4 g = gr[64 * j]; const f32x4 ya = va[j] * rsa * g, yb = vb[j] * rsb * g;
        if (fa) { ((f32x4*)fa)[64 * j + lane] = ya; ((f32x4*)fb)[64 * j + lane] = yb; }
        else { u32x2 wa, wb; wa.x = pk2(ya.x, ya.y); wa.y = pk2(ya.z, ya.w); wb.x = pk2(yb.x, yb.y); wb.y = pk2(yb.z, yb.w); ((u32x2*)oa)[64 * j + lane] = wa; ((u32x2*)ob_)[64 * j + lane] = wb; } }
}
__device__ __forceinline__ void norm_rows(const float* x, const float* gain, bf16* out, int nrows, int gw, int ngw, int lane) {
    int m = gw;
    for (; m + ngw < nrows; m += 2 * ngw) norm_row2(x + (size_t)m * DM, x + (size_t)(m + ngw) * DM, gain, out + (size_t)m * DM, out + (size_t)(m + ngw) * DM, nullptr, nullptr, lane);
    for (; m < nrows; m += ngw) norm_row(x + (size_t)m * DM, gain, out + (size_t)m * DM, nullptr, lane);
}

template <int HD, int NB, int NQ>
__device__ __forceinline__ void banded_unit(LAS unsigned char* lds, int tid, const bf16* __restrict__ qb, const bf16* __restrict__ kbp, const bf16* __restrict__ vbp, int ld,
                                            int dil, int r, int L, int qpos0, int ks, int nrows, int wave_row_off, int W, float slope, float scale, float m_init, float l_init,
                                            bf16* __restrict__ ob, int old, float* __restrict__ lseb) {
    constexpr int CH = HD / 8, ROWB = HD * 2, SWZ = (CH - 1) & 15, NK = HD / 32, ND = HD / 16;
    LAS unsigned char* Kt = lds; LAS unsigned char* Vt = lds + nrows * ROWB;
    for (int idx = tid; idx < nrows * CH; idx += 512) {
        const int row = idx / CH, ch = idx % CH, kp = ks + row;
        u32x4 k4 = (u32x4){0u, 0u, 0u, 0u}, v4 = (u32x4){0u, 0u, 0u, 0u};
        if (kp >= 0 && kp < L) { const size_t off = (size_t)(kp * dil + r) * ld + ch * 8; k4 = *(const u32x4*)(kbp + off); v4 = *(const u32x4*)(vbp + off); }
        const int lo = row * ROWB + ((ch ^ (row & SWZ)) << 4);
        *(LAS u32x4*)(Kt + lo) = k4; *(LAS u32x4*)(Vt + lo) = v4;
    }
    __syncthreads();
    const int lane = tid & 63, g = lane >> 4, c = lane & 15;
    bf16x8 qf[NQ][NK]; f32x4 O[NQ][ND]; float m[NQ], l[NQ];
#pragma unroll
    for (int qi = 0; qi < NQ; ++qi) { const size_t qtok = (size_t)((qpos0 + 16 * qi + c) * dil + r);
#pragma unroll
        for (int k = 0; k < NK; ++k) qf[qi][k] = *(const bf16x8*)(qb + qtok * ld + k * 32 + g * 8);
#pragma unroll
        for (int d = 0; d < ND; ++d) O[qi][d] = (f32x4){0.f, 0.f, 0.f, 0.f};
        m[qi] = m_init; l[qi] = (g == 0) ? l_init : 0.f; }
    const int krow_a = (c >> 2) * 8 + (c & 3), vrow_a = g * 8 + (c >> 2), vch = (c & 3) >> 1, vhalf = (c & 1) * 8;
    for (int kb = 0; kb < NB; ++kb) {
        const int R0 = wave_row_off + kb * 32;
        const int ra = R0 + krow_a, rb = ra + 4;
        bf16x8 ka[NK], kbf[NK];
#pragma unroll
        for (int k = 0; k < NK; ++k) { const int chunk = k * 4 + g;
            ka[k] = lds16(Kt + ra * ROWB + ((chunk ^ (ra & SWZ)) << 4)); kbf[k] = lds16(Kt + rb * ROWB + ((chunk ^ (rb & SWZ)) << 4)); }
        const int r0 = R0 + vrow_a, r1 = r0 + 4;
        bf16x8 vf[ND];
#pragma unroll
        for (int d = 0; d < ND; ++d) { const int chunk = d * 2 + vch;
            vf[d] = vtr8(Vt + r0 * ROWB + ((chunk ^ (r0 & SWZ)) << 4) + vhalf, Vt + r1 * ROWB + ((chunk ^ (r1 & SWZ)) << 4) + vhalf); }
        const int kp0 = ks + R0 + g * 8;
#pragma unroll
        for (int qi = 0; qi < NQ; ++qi) {
            const int qb0 = qpos0 + 16 * qi;
            if (NQ > 1 && !((ks + R0 + 31 >= qb0 - W) && (ks + R0 <= qb0 + 15 + W))) continue;
            const int qpos = qb0 + c;
            f32x4 s0 = (f32x4){0.f, 0.f, 0.f, 0.f}, s1 = s0;
#pragma unroll
            for (int k = 0; k < NK; ++k) { s0 = mfma16(ka[k], qf[qi][k], s0); s1 = mfma16(kbf[k], qf[qi][k], s1); }
            float sv[8]; float bm = -1e30f;
#pragma unroll
            for (int jj = 0; jj < 8; ++jj) { const int kp = kp0 + jj; const int dd = kp - qpos; const int ad = dd < 0 ? -dd : dd; const bool valid = (ad <= W) && (kp >= 0) && (kp < L);
                const float raw = jj < 4 ? s0[jj & 3] : s1[jj & 3];
                sv[jj] = valid ? raw * scale - slope * (float)ad : -1e30f; bm = fmaxf(bm, sv[jj]); }
            bm = fmaxf(bm, __shfl_xor(bm, 16)); bm = fmaxf(bm, __shfl_xor(bm, 32));
            const float m_new = fmaxf(m[qi], bm), alpha = __expf(m[qi] - m_new);
            float ps = 0.f;
#pragma unroll
            for (int jj = 0; jj < 8; ++jj) { sv[jj] = __expf(sv[jj] - m_new); ps += sv[jj]; }
            l[qi] = l[qi] * alpha + ps; m[qi] = m_new;
            u32x4 pw; pw.x = pk2(sv[0], sv[1]); pw.y = pk2(sv[2], sv[3]); pw.z = pk2(sv[4], sv[5]); pw.w = pk2(sv[6], sv[7]);
            const bf16x8 pf = __builtin_bit_cast(bf16x8, pw);
#pragma unroll
            for (int d = 0; d < ND; ++d) O[qi][d] = mfma16(vf[d], pf, O[qi][d] * alpha);
        }
    }
#pragma unroll
    for (int qi = 0; qi < NQ; ++qi) { const size_t qtok = (size_t)((qpos0 + 16 * qi + c) * dil + r);
        float lt = l[qi]; lt += __shfl_xor(lt, 16); lt += __shfl_xor(lt, 32);
        const float inv = 1.f / lt;
#pragma unroll
        for (int d = 0; d < ND; ++d) { u32x2 w; w.x = pk2(O[qi][d][0] * inv, O[qi][d][1] * inv); w.y = pk2(O[qi][d][2] * inv, O[qi][d][3] * inv); *(u32x2*)(ob + qtok * old + d * 16 + g * 4) = w; }
        if (lseb != nullptr && g == 0) lseb[qtok * 8] = m[qi] + __logf(lt); }
    __syncthreads();
}

__device__ __forceinline__ void xa_dma(const bf16* __restrict__ base, int dc, LAS unsigned char* buf, int w, unsigned voff) {
    const char* ub = (const char*)base + (size_t)dc * 256;
#pragma unroll
    for (int j = 0; j < 8; ++j)
        __builtin_amdgcn_global_load_lds((const unsigned*)(ub + (size_t)j * 262144 + voff), (LAS unsigned*)(buf + (j * 8 + w) * 1024), 16, 0, 0);
}
__device__ __forceinline__ void xattn_unit(LAS unsigned char* lds, int tid, const bf16* __restrict__ qx, const bf16* __restrict__ kv, bf16* __restrict__ obuf, int u) {
    const int b = u >> 6, h = (u >> 4) & 3, qt = u & 15;
    const int lane = tid & 63, w = __builtin_amdgcn_readfirstlane(tid >> 6), g = lane >> 4, c = lane & 15;
    const size_t token = (size_t)b * SEQ + qt * 128 + 16 * w + c;
    const bf16* qrow = qx + token * DM + h * 512;
    const bf16* kbase = kv + (size_t)(b * MEMLEN) * 4096 + h * 512; const bf16* vbase = kbase + 2048;
    const int krow_a = (c >> 2) * 8 + (c & 3), vrow_a = g * 8 + (c >> 2), vch = (c & 3) >> 1, vhalf = (c & 1) * 8;
    const int drow = 4 * w + (lane >> 4);
    const unsigned voff = (unsigned)(drow * 8192 + (((lane & 15) ^ (drow & 15)) << 4));
    int offK[2][4], offV[2][8];
#pragma unroll
    for (int t = 0; t < 2; ++t) { const int rk = krow_a + 4 * t, rv = vrow_a + 4 * t;
#pragma unroll
        for (int k = 0; k < 4; ++k) offK[t][k] = rk * 256 + (((k * 4 + g) ^ (rk & 15)) << 4);
#pragma unroll
        for (int d = 0; d < 8; ++d) offV[t][d] = rv * 256 + (((d * 2 + vch) ^ (rv & 15)) << 4) + vhalf; }
    f32x4 S[16];
#pragma unroll
    for (int i = 0; i < 16; ++i) S[i] = (f32x4){0.f, 0.f, 0.f, 0.f};
    xa_dma(kbase, 0, lds, w, voff);
    asm volatile("s_waitcnt vmcnt(0)" ::: "memory"); __syncthreads();
    for (int dc = 0; dc < 4; ++dc) {
        LAS unsigned char* cur = lds + (dc & 1) * 65536;
        bf16x8 qf[4];
#pragma unroll
        for (int k = 0; k < 4; ++k) qf[k] = *(const bf16x8*)(qrow + dc * 128 + k * 32 + g * 8);
#pragma unroll
        for (int kb = 0; kb < 8; ++kb) {
#pragma unroll
            for (int k = 0; k < 4; ++k) {
                S[kb * 2] = mfma16(lds16(cur + offK[0][k] + kb * 8192), qf[k], S[kb * 2]);
                S[kb * 2 + 1] = mfma16(lds16(cur + offK[1][k] + kb * 8192), qf[k], S[kb * 2 + 1]); }
            asm volatile("" : "+v"(S[kb * 2]), "+v"(S[kb * 2 + 1]) :: "memory");
            if (kb == 0) xa_dma(dc < 3 ? kbase : vbase, (dc + 1) & 3, lds + ((dc + 1) & 1) * 65536, w, voff);
        }
        asm volatile("s_waitcnt vmcnt(0)" ::: "memory"); __syncthreads();
    }
    const float scale = 0.044194173824159216f;
    float mx = -1e30f;
#pragma unroll
    for (int i = 0; i < 16; ++i) { mx = fmaxf(mx, fmaxf(fmaxf(S[i][0], S[i][1]), fmaxf(S[i][2], S[i][3]))); }
    mx = fmaxf(mx, __shfl_xor(mx, 16)); mx = fmaxf(mx, __shfl_xor(mx, 32));
    float l = 0.f;
#pragma unroll
    for (int i = 0; i < 16; ++i)
#pragma unroll
        for (int j = 0; j < 4; ++j) { const float pv = __expf((S[i][j] - mx) * scale); S[i][j] = pv; l += pv; }
    l += __shfl_xor(l, 16); l += __shfl_xor(l, 32);
    const float inv = 1.f / l;
    bf16x8 pf[8];
#pragma unroll
    for (int kb = 0; kb < 8; ++kb) { u32x4 pw; pw.x = pk2(S[kb * 2][0], S[kb * 2][1]); pw.y = pk2(S[kb * 2][2], S[kb * 2][3]); pw.z = pk2(S[kb * 2 + 1][0], S[kb * 2 + 1][1]); pw.w = pk2(S[kb * 2 + 1][2], S[kb * 2 + 1][3]);
        pf[kb] = __builtin_bit_cast(bf16x8, pw); }
    for (int dc = 0; dc < 4; ++dc) {
        LAS unsigned char* cur = lds + (dc & 1) * 65536;
        if (dc < 3) xa_dma(vbase, dc + 1, lds + ((dc + 1) & 1) * 65536, w, voff);
#pragma unroll
        for (int d = 0; d < 8; ++d) {
            f32x4 O = (f32x4){0.f, 0.f, 0.f, 0.f};
#pragma unroll
            for (int kb = 0; kb < 8; ++kb) O = mfma16(vtr8(cur + offV[0][d] + kb * 8192, cur + offV[1][d] + kb * 8192), pf[kb], O);
            u32x2 wv; wv.x = pk2(O[0] * inv, O[1] * inv); wv.y = pk2(O[2] * inv, O[3] * inv);
            *(u32x2*)(obuf + token * DM + h * 512 + dc * 128 + d * 16 + g * 4) = wv;
            asm volatile("" ::: "memory");
        }
        asm volatile("s_waitcnt vmcnt(0)" ::: "memory"); __syncthreads();
    }
}

constexpr int G_BCUM = 0, G_X1 = 65536, G_X2 = 98304, G_ZS = 131072, G_RED = 139264;
__device__ __forceinline__ void gla_gates(LAS unsigned char* lds, int tid, const bf16* __restrict__ proj, size_t tok0, int h, const float* __restrict__ Wf, const float* __restrict__ bf_,
                                          const float* __restrict__ Wb, const float* __restrict__ bb_) {
    if (tid < 256) { const int t = tid >> 2, part = tid & 3; const u32x4 v = *(const u32x4*)(proj + (tok0 + t) * LD_AB + 6144 + part * 8);
        LAS f32x4* zp = (LAS f32x4*)(lds + G_ZS + (t * 32 + part * 8) * 4);
        zp[0] = (f32x4){bflo(v.x), bfhi(v.x), bflo(v.y), bfhi(v.y)}; zp[1] = (f32x4){bflo(v.z), bfhi(v.z), bflo(v.w), bfhi(v.w)}; }
    __syncthreads();
    if (tid < 256) {
        const int dir = tid >> 7, kk = tid & 127; const float* Wg = dir ? Wb : Wf; const float* bg = dir ? bb_ : bf_;
        float w[16];
#pragma unroll
        for (int r = 0; r < 16; ++r) w[r] = Wg[r * 512 + h * 128 + kk];
        const float bias = bg[h * 128 + kk];
        float cum = 0.f; LAS float* bc = (LAS float*)(lds + G_BCUM) + dir * 8192 + kk; const LAS unsigned char* zs = lds + G_ZS + dir * 64;
        for (int s = 0; s < 64; ++s) { const int t = dir ? 63 - s : s;
            const LAS f32x4* z4 = (const LAS f32x4*)(zs + t * 128);
            const f32x4 z0 = z4[0], z1 = z4[1], z2 = z4[2], z3 = z4[3];
            float u = bias;
            u += z0[0] * w[0] + z0[1] * w[1] + z0[2] * w[2] + z0[3] * w[3];
            u += z1[0] * w[4] + z1[1] * w[5] + z1[2] * w[6] + z1[3] * w[7];
            u += z2[0] * w[8] + z2[1] * w[9] + z2[2] * w[10] + z2[3] * w[11];
            u += z3[0] * w[12] + z3[1] * w[13] + z3[2] * w[14] + z3[3] * w[15];
            const float ls = fminf(u, 0.f) - __logf(1.f + __expf(-fabsf(u)));
            cum += ls * 0.0625f; bc[t * 128] = cum; }
    }
    __syncthreads();
}
__device__ __forceinline__ void gla_stage_v(LAS unsigned char* vdst, int tid, const bf16* __restrict__ proj, size_t tok0, int h) {
    for (int idx = tid; idx < 2048; idx += 512) { const int row = idx >> 5, ch = idx & 31;
        *(LAS u32x4*)(vdst + row * 512 + ((ch ^ (row & 15)) << 4)) = *(const u32x4*)(proj + (tok0 + row) * LD_AB + 4096 + h * 256 + ch * 8); }
}
__device__ __forceinline__ void gla_stage1_unit(LAS unsigned char* lds, int tid, const bf16* __restrict__ proj, int item, const float* Wf, const float* bf_, const float* Wb, const float* bb_,
                                                bf16* __restrict__ St, float* __restrict__ Dd) {
    const int b = item >> 7, h = (item >> 5) & 3, cidx = item & 31; const size_t tok0 = (size_t)b * SEQ + cidx * 64;
    gla_gates(lds, tid, proj, tok0, h, Wf, bf_, Wb, bb_);
    {
        const int kk = tid & 127, jq = tid >> 7;
        const LAS float* bcf = (const LAS float*)(lds + G_BCUM) + kk; const LAS float* bcb = bcf + 8192;
        const float blf = bcf[63 * 128], blb = bcb[0];
#pragma unroll
        for (int cc = 0; cc < 2; ++cc) { const int jc = jq * 2 + cc; float of[8], obk[8];
#pragma unroll
            for (int e = 0; e < 8; ++e) { const int j = jc * 8 + e; const float kv = __uint_as_float((unsigned)proj[(tok0 + j) * LD_AB + 3584 + h * 128 + kk] << 16);
                of[e] = kv * __expf(blf - bcf[j * 128]); obk[e] = kv * __expf(blb - bcb[j * 128]); }
            const int lo = kk * 128 + ((jc ^ (kk & 7)) << 4);
            *(LAS u32x4*)(lds + G_X1 + lo) = (u32x4){pk2(of[0], of[1]), pk2(of[2], of[3]), pk2(of[4], of[5]), pk2(of[6], of[7])};
            *(LAS u32x4*)(lds + G_X1 + 16384 + lo) = (u32x4){pk2(obk[0], obk[1]), pk2(obk[2], obk[3]), pk2(obk[4], obk[5]), pk2(obk[6], obk[7])}; }
        if (tid < 128) { Dd[(size_t)item * 128 + kk] = __expf(blf); Dd[(size_t)(1024 + item) * 128 + kk] = __expf(blb); }
    }
    gla_stage_v(lds + G_X2, tid, proj, tok0, h);
    __syncthreads();
    const int lane = tid & 63, w = tid >> 6, g = lane >> 4, c = lane & 15;
    const int vrow_a = g * 8 + (c >> 2), vch = (c & 3) >> 1, vhalf = (c & 1) * 8;
#pragma unroll
    for (int dbi = 0; dbi < 2; ++dbi) { const int db = 2 * w + dbi; bf16x8 vf[2];
#pragma unroll
        for (int ksj = 0; ksj < 2; ++ksj) { const int r0 = ksj * 32 + vrow_a, r1 = r0 + 4, chunk = db * 2 + vch;
            vf[ksj] = vtr8(lds + G_X2 + r0 * 512 + ((chunk ^ (r0 & 15)) << 4) + vhalf, lds + G_X2 + r1 * 512 + ((chunk ^ (r1 & 15)) << 4) + vhalf); }
#pragma unroll
        for (int dir = 0; dir < 2; ++dir)
#pragma unroll
            for (int nb = 0; nb < 8; ++nb) { f32x4 acc = (f32x4){0.f, 0.f, 0.f, 0.f}; const int kk = nb * 16 + c;
#pragma unroll
                for (int ksj = 0; ksj < 2; ++ksj) acc = mfma16(vf[ksj], lds16(lds + G_X1 + dir * 16384 + kk * 128 + (((ksj * 4 + g) ^ (kk & 7)) << 4)), acc);
                bf16* sp = St + ((size_t)(dir * 1024 + item) * 256 + db * 16 + g * 4) * 128 + kk;
#ifdef DBG_ZERO_ST
                for (int j = 0; j < 4; ++j) sp[j * 128] = (bf16)0; }
#else
                for (int j = 0; j < 4; ++j) sp[j * 128] = (bf16)(pk2(acc[j], 0.f) & 0xffffu); }
#endif
    }
    __syncthreads();
}
__device__ __forceinline__ void gla_scan(bf16* __restrict__ St, const float* __restrict__ Dd, int gtid, int nthreads) {
    for (int wi = gtid; wi < 262144; wi += nthreads) {
        const int dir = wi >> 17, bh = (wi >> 12) & 31, e8 = wi & 4095, kk0 = (e8 * 8) & 127;
        float st[8];
#pragma unroll
        for (int e = 0; e < 8; ++e) st[e] = 0.f;
#pragma unroll 8
        for (int s = 0; s < 32; ++s) { const int cidx = dir ? 31 - s : s; const size_t it = (size_t)dir * 1024 + bh * 32 + cidx;
            u32x4* sp = (u32x4*)(St + it * 32768 + e8 * 8); const u32x4 uu = *sp;
            const f32x4 d0 = *(const f32x4*)(Dd + it * 128 + kk0), d1 = *(const f32x4*)(Dd + it * 128 + kk0 + 4);
            *sp = (u32x4){pk2(st[0], st[1]), pk2(st[2], st[3]), pk2(st[4], st[5]), pk2(st[6], st[7])};
            st[0] = d0[0] * st[0] + bflo(uu.x); st[1] = d0[1] * st[1] + bfhi(uu.x); st[2] = d0[2] * st[2] + bflo(uu.y); st[3] = d0[3] * st[3] + bfhi(uu.y);
            st[4] = d1[0] * st[4] + bflo(uu.z); st[5] = d1[1] * st[5] + bfhi(uu.z); st[6] = d1[2] * st[6] + bflo(uu.w); st[7] = d1[3] * st[7] + bfhi(uu.w); }
    }
}
__device__ __forceinline__ void gla_stage3_unit(LAS unsigned char* lds, int tid, const bf16* __restrict__ proj, int item, const float* Wf, const float* bf_, const float* Wb, const float* bb_,
                                                const bf16* __restrict__ St, const float* __restrict__ head_norm, bf16* __restrict__ obuf) {
    const int b = item >> 7, h = (item >> 5) & 3, cidx = item & 31; const size_t tok0 = (size_t)b * SEQ + cidx * 64;
    gla_gates(lds, tid, proj, tok0, h, Wf, bf_, Wb, bb_);
    const float qscale = 0.08838834764831845f;
    for (int task = tid; task < 1024; task += 512) { const int row = task >> 4, ch = task & 15;
        const u32x4 q8 = *(const u32x4*)(proj + (tok0 + row) * LD_AB + 3072 + h * 128 + ch * 8), k8 = *(const u32x4*)(proj + (tok0 + row) * LD_AB + 3584 + h * 128 + ch * 8);
        const LAS f32x4* bfp = (const LAS f32x4*)(lds + G_BCUM + (row * 128 + ch * 8) * 4); const LAS f32x4* bbp = (const LAS f32x4*)(lds + G_BCUM + 32768 + (row * 128 + ch * 8) * 4);
        const f32x4 f0 = bfp[0], f1 = bfp[1], b0 = bbp[0], b1 = bbp[1];
        const float qv[8] = {bflo(q8.x), bfhi(q8.x), bflo(q8.y), bfhi(q8.y), bflo(q8.z), bfhi(q8.z), bflo(q8.w), bfhi(q8.w)};
        const float kvv[8] = {bflo(k8.x), bfhi(k8.x), bflo(k8.y), bfhi(k8.y), bflo(k8.z), bfhi(k8.z), bflo(k8.w), bfhi(k8.w)};
        const float bfv[8] = {f0[0], f0[1], f0[2], f0[3], f1[0], f1[1], f1[2], f1[3]}, bbv[8] = {b0[0], b0[1], b0[2], b0[3], b1[0], b1[1], b1[2], b1[3]};
        float qgf[8], qgb[8], kdf[8], kdb[8];
#pragma unroll
        for (int e = 0; e < 8; ++e) { const float ef = __expf(bfv[e]), eb = __expf(bbv[e]); qgf[e] = qv[e] * qscale * ef; qgb[e] = qv[e] * qscale * eb; kdf[e] = kvv[e] / ef; kdb[e] = kvv[e] / eb; }
        const int lo = row * 256 + ((ch ^ (row & 15)) << 4);
        *(LAS u32x4*)(lds + G_X1 + lo) = (u32x4){pk2(qgf[0], qgf[1]), pk2(qgf[2], qgf[3]), pk2(qgf[4], qgf[5]), pk2(qgf[6], qgf[7])};
        *(LAS u32x4*)(lds + G_X1 + 16384 + lo) = (u32x4){pk2(qgb[0], qgb[1]), pk2(qgb[2], qgb[3]), pk2(qgb[4], qgb[5]), pk2(qgb[6], qgb[7])};
        *(LAS u32x4*)(lds + G_X2 + lo) = (u32x4){pk2(kdf[0], kdf[1]), pk2(kdf[2], kdf[3]), pk2(kdf[4], kdf[5]), pk2(kdf[6], kdf[7])};
        *(LAS u32x4*)(lds + G_X2 + 16384 + lo) = (u32x4){pk2(kdb[0], kdb[1]), pk2(kdb[2], kdb[3]), pk2(kdb[4], kdb[5]), pk2(kdb[6], kdb[7])}; }
    __syncthreads();
    gla_stage_v(lds + G_BCUM, tid, proj, tok0, h);
    __syncthreads();
    const int lane = tid & 63, w = tid >> 6, g = lane >> 4, c = lane & 15, ib = w & 3, dh = w >> 2;
    const int krow_a = (c >> 2) * 8 + (c & 3), vrow_a = g * 8 + (c >> 2), vch = (c & 3) >> 1, vhalf = (c & 1) * 8;
    bf16x8 qg[2][4];
#pragma unroll
    for (int dir = 0; dir < 2; ++dir)
#pragma unroll
        for (int k = 0; k < 4; ++k) qg[dir][k] = lds16(lds + G_X1 + dir * 16384 + (ib * 16 + c) * 256 + (((k * 4 + g) ^ c) << 4));
    bf16x8 pf[2];
#pragma unroll
    for (int jb = 0; jb < 2; ++jb) { const int ra = jb * 32 + krow_a, rb = ra + 4;
        f32x4 sf0 = (f32x4){0.f, 0.f, 0.f, 0.f}, sf1 = sf0, sb0 = sf0, sb1 = sf0;
#pragma unroll
        for (int k = 0; k < 4; ++k) { const int chunk = k * 4 + g; const int oa = ra * 256 + ((chunk ^ (ra & 15)) << 4), obb = rb * 256 + ((chunk ^ (rb & 15)) << 4);
            sf0 = mfma16(lds16(lds + G_X2 + oa), qg[0][k], sf0); sf1 = mfma16(lds16(lds + G_X2 + obb), qg[0][k], sf1);
            sb0 = mfma16(lds16(lds + G_X2 + 16384 + oa), qg[1][k], sb0); sb1 = mfma16(lds16(lds + G_X2 + 16384 + obb), qg[1][k], sb1); }
        float pv[8]; const int iidx = ib * 16 + c;
#pragma unroll
        for (int jj = 0; jj < 8; ++jj) { const int jidx = jb * 32 + g * 8 + jj; const float vf_ = jj < 4 ? sf0[jj & 3] : sf1[jj & 3], vb_ = jj < 4 ? sb0[jj & 3] : sb1[jj & 3]; pv[jj] = (jidx <= iidx) ? vf_ : vb_; }
        u32x4 pw; pw.x = pk2(pv[0], pv[1]); pw.y = pk2(pv[2], pv[3]); pw.z = pk2(pv[4], pv[5]); pw.w = pk2(pv[6], pv[7]);
        pf[jb] = __builtin_bit_cast(bf16x8, pw); }
    f32x4 O[8]; float ssq = 0.f;
#pragma unroll
    for (int d = 0; d < 8; ++d) { const int dvb = dh * 8 + d; f32x4 acc = (f32x4){0.f, 0.f, 0.f, 0.f};
#pragma unroll
        for (int jb = 0; jb < 2; ++jb) { const int r0 = jb * 32 + vrow_a, r1 = r0 + 4, chunk = dvb * 2 + vch;
            acc = mfma16(vtr8(lds + G_BCUM + r0 * 512 + ((chunk ^ (r0 & 15)) << 4) + vhalf, lds + G_BCUM + r1 * 512 + ((chunk ^ (r1 & 15)) << 4) + vhalf), pf[jb], acc); }
#ifndef DBG_NO_INTER
#pragma unroll
        for (int dir = 0; dir < 2; ++dir) { const bf16* sp = St + ((size_t)(dir * 1024 + item) * 256 + dvb * 16 + c) * 128 + g * 8;
#pragma unroll
            for (int k = 0; k < 4; ++k) acc = mfma16(*(const bf16x8*)(sp + k * 32), qg[dir][k], acc); }
#endif
        O[d] = acc; ssq += (acc[0] * acc[0] + acc[1] * acc[1]) + (acc[2] * acc[2] + acc[3] * acc[3]); }
    ssq += __shfl_xor(ssq, 16); ssq += __shfl_xor(ssq, 32);
    LAS float* red = (LAS float*)(lds + G_RED);
    if (g == 0) red[w * 16 + c] = ssq;
    __syncthreads();
    const float tot = red[w * 16 + c] + red[(w ^ 4) * 16 + c];
    const float rstd = rsqrtf(tot * (1.f / 256.f) + EPS);
    const size_t token = tok0 + ib * 16 + c;
#pragma unroll
    for (int d = 0; d < 8; ++d) { const int dv0 = (dh * 8 + d) * 16 + g * 4;
        const f32x4 hn = *(const f32x4*)(head_norm + h * 256 + dv0); const u32x2 r2 = *(const u32x2*)(proj + token * LD_AB + 5120 + h * 256 + dv0);
        const float rv[4] = {bflo(r2.x), bfhi(r2.x), bflo(r2.y), bfhi(r2.y)}; float ov[4];
#pragma unroll
        for (int j = 0; j < 4; ++j) ov[j] = O[d][j] * rstd * hn[j] * pg8::silu_f(rv[j]);
        u32x2 wv; wv.x = pk2(ov[0], ov[1]); wv.y = pk2(ov[2], ov[3]); *(u32x2*)(obuf + token * DM + 1024 + h * 256 + dv0) = wv; }
    __syncthreads();
}
__device__ __forceinline__ void combine_a(const bf16* __restrict__ oc, const float* __restrict__ lse, bf16* __restrict__ obuf, int gtid, int nthreads) {
#pragma unroll 4
    for (int task = gtid; task < MTOK * 128; task += nthreads) { const int token = task >> 7, h = (task >> 4) & 7, ch = task & 15;
        const float l0 = lse[(size_t)token * 8 + h], l1 = lse[(size_t)(MTOK + token) * 8 + h], l2 = lse[(size_t)(2 * MTOK + token) * 8 + h];
        const float mx = fmaxf(l0, fmaxf(l1, l2)); float w0 = __expf(l0 - mx), w1 = __expf(l1 - mx), w2 = __expf(l2 - mx); const float inv = 1.f / (w0 + w1 + w2); w0 *= inv; w1 *= inv; w2 *= inv;
        const size_t off = (size_t)token * 1024 + h * 128 + ch * 8;
        const u32x4 a = *(const u32x4*)(oc + off), bq = *(const u32x4*)(oc + (size_t)MTOK * 1024 + off), cq = *(const u32x4*)(oc + (size_t)2 * MTOK * 1024 + off);
        u32x4 o;
        o.x = pk2(w0 * bflo(a.x) + w1 * bflo(bq.x) + w2 * bflo(cq.x), w0 * bfhi(a.x) + w1 * bfhi(bq.x) + w2 * bfhi(cq.x));
        o.y = pk2(w0 * bflo(a.y) + w1 * bflo(bq.y) + w2 * bflo(cq.y), w0 * bfhi(a.y) + w1 * bfhi(bq.y) + w2 * bfhi(cq.y));
        o.z = pk2(w0 * bflo(a.z) + w1 * bflo(bq.z) + w2 * bflo(cq.z), w0 * bfhi(a.z) + w1 * bfhi(bq.z) + w2 * bfhi(cq.z));
        o.w = pk2(w0 * bflo(a.w) + w1 * bflo(bq.w) + w2 * bflo(cq.w), w0 * bfhi(a.w) + w1 * bfhi(bq.w) + w2 * bfhi(cq.w));
        *(u32x4*)(obuf + (size_t)token * DM + h * 128 + ch * 8) = o; }
}

#define XB_TMO      128
#define XB_XCNT(j)  (256  + 64 * (j))
#define XB_XSUB(j)  (1280 + 64 * (j))
#define XB_XGEN(j)  (2304 + 64 * (j))
#define XB_TOP      3328
#define XB_TOPGEN   3392
#define XCD_BAR_WORDS 3456
#define XB_SPIN_CAP (1u << 18)

__device__ __forceinline__ unsigned xb_ld(unsigned* p)              { return __hip_atomic_load(p, __ATOMIC_RELAXED, __HIP_MEMORY_SCOPE_AGENT); }
__device__ __forceinline__ unsigned xb_add(unsigned* p, unsigned v) { return __hip_atomic_fetch_add(p, v, __ATOMIC_RELAXED, __HIP_MEMORY_SCOPE_AGENT); }
__device__ __forceinline__ unsigned xb_xcc_id() { return (unsigned)__builtin_amdgcn_s_getreg((3 << 11) | 20) & 0xFu; }
#define XB_SPIN(cond, bar) do { unsigned _sp = 0; while (cond) { __builtin_amdgcn_s_sleep(1); \
    if ((++_sp & 255u) == 0u) { if (xb_ld(&(bar)[XB_TMO])) break; if (_sp > XB_SPIN_CAP) { atomicAdd(&(bar)[XB_TMO], 1u); break; } } } } while (0)

struct XcdBarrier {
    unsigned* bar; unsigned x;
    volatile LAS unsigned* st;
};

__device__ __forceinline__ XcdBarrier xcd_barrier_post(unsigned* bar, volatile LAS unsigned* st) {
    XcdBarrier b; b.bar = bar; b.x = xb_xcc_id(); b.st = st;
    if (threadIdx.x == 0) (void)xb_add(&bar[XB_XCNT(b.x)], 1u);
    return b;
}
__device__ __forceinline__ void xcd_barrier_complete(unsigned* bar, unsigned x, unsigned& nloc, unsigned& nx) {
    const unsigned G = gridDim.x * gridDim.y * gridDim.z;
    unsigned sum, cnt, mine, sp = 0u;
    for (;;) {
        sum = 0u; cnt = 0u; mine = 0u;
#pragma unroll
        for (unsigned j = 0; j < 16; ++j) { const unsigned c = xb_ld(&bar[XB_XCNT(j)]); sum += c; cnt += (c > 0u) ? 1u : 0u; mine = (j == x) ? c : mine; }
        if (sum == G) break;
        __builtin_amdgcn_s_sleep(1);
        if ((++sp & 255u) == 0u) { if (xb_ld(&bar[XB_TMO])) break; if (sp > XB_SPIN_CAP) { atomicAdd(&bar[XB_TMO], 1u); break; } }
    }
    nloc = mine > 0u ? mine : 1u; nx = cnt > 0u ? cnt : 1u;
}

__device__ __forceinline__ void xcd_barrier(const XcdBarrier& b) {
    asm volatile("s_waitcnt vmcnt(0)" ::: "memory");
    __syncthreads();
    if (threadIdx.x == 0) {
        unsigned* bar = b.bar;
        __builtin_amdgcn_s_waitcnt(0);
        unsigned nloc = b.st[0], nx = b.st[1];
        if (nloc == 0u) { xcd_barrier_complete(bar, b.x, nloc, nx); b.st[0] = nloc; b.st[1] = nx; }
        const unsigned old = xb_add(&bar[XB_XSUB(b.x)], 1u);
        const unsigned gen = old / nloc;
        if (old + 1u == (gen + 1u) * nloc) {
            __builtin_amdgcn_fence(__ATOMIC_RELEASE, "agent");
            asm volatile("s_waitcnt vmcnt(0)" ::: "memory");
            const unsigned og = xb_add(&bar[XB_TOP], 1u);
            const unsigned tg = og / nx;
            if (og + 1u == (tg + 1u) * nx) xb_add(&bar[XB_TOPGEN], 1u);
            else XB_SPIN(xb_ld(&bar[XB_TOPGEN]) == tg, bar);
            __builtin_amdgcn_fence(__ATOMIC_ACQUIRE, "agent");
            xb_add(&bar[XB_XGEN(b.x)], 1u);
            asm volatile("s_waitcnt vmcnt(0)" ::: "memory");
        } else {
            XB_SPIN(xb_ld(&bar[XB_XGEN(b.x)]) == gen, bar);
            __builtin_amdgcn_fence(__ATOMIC_ACQUIRE, "agent");
            asm volatile("s_waitcnt vmcnt(0)" ::: "memory");
        }
    }
    __syncthreads();
}

__device__ __forceinline__ void gsync_cg(cg::grid_group& grid) {
    asm volatile("s_waitcnt vmcnt(0) lgkmcnt(0)" ::: "memory");
    grid.sync();
    __builtin_amdgcn_fence(__ATOMIC_ACQUIRE, "agent");
    asm volatile("s_waitcnt vmcnt(0)" ::: "memory");
}
#define gsync(grid_) xcd_barrier(xbar)

__device__ __forceinline__ int fresh_tid() { int t = threadIdx.x; asm volatile("" : "+v"(t)); return t; }
#ifndef DBG_STOP
#define DBG_STOP 0
#endif
#define DBG_CHECK(k) do { if (DBG_STOP == (k)) { for (int m_ = gw; m_ < MTOK; m_ += ngw) norm_row(X + (size_t)m_ * DM, p.in[36], nullptr, X + (size_t)m_ * DM, fresh_tid() & 63); return true; } } while (0)
template <int layer>
__device__ __forceinline__ bool run_layer(const Params& p, LAS unsigned char* lds, cg::grid_group& grid, const XcdBarrier& xbar, int wave, int G, int bid, int gw, int ngw, int nthreads) {
    unsigned char* ws = p.ws;
    bf16* Hb = (bf16*)(ws + WS_H); bf16* PROJ = (bf16*)(ws + WS_PROJ); bf16* OBUF = (bf16*)(ws + WS_OBUF); bf16* OC = (bf16*)(ws + WS_OC); float* LSE = (float*)(ws + WS_LSE);
    bf16* ST = (bf16*)(ws + WS_ST); float* DD = (float*)(ws + WS_DD); bf16* KV = (bf16*)(ws + WS_KV);
    float* X = p.out; float* SSQ = (float*)(p.ws + WS_SSQ);
        { pg8::Gemm g{Hb, (const bf16*)(ws + WS_FF1IN), MTOK, 2 * DFF, DM}; pg8::StaticOrder S; S.init(MTOK, 2 * DFF, G, bid); pg8::EpiSwiglu E{PROJ, DFF, SSQ + (size_t)(layer * 4 + 0) * (MTOK * 8)};
          pg8::gemm_phase<pg8::EpiSwiglu, pg8::StaticOrder, true, true>(lds, g, S, E);
#ifdef EXP_DUP_FFNIN
          if (layer == 0) pg8::gemm_phase<pg8::EpiSwiglu, pg8::StaticOrder, true, true>(lds, g, S, E);
#endif
        }
        gsync(grid);
        { pg8::Gemm g{PROJ, (const bf16*)(ws + WS_FF1OUT), MTOK, DM, DFF}; pg8::StaticOrder S; S.init(MTOK, DM, G, bid); pg8::EpiResid<true, false> E{Hb, nullptr, SSQ + (size_t)(layer * 4 + 1) * (MTOK * 8), (LAS float*)(lds + 131072)};
          pg8::gemm_phase<pg8::EpiResid<true, false>, pg8::StaticOrder, true, true>(lds, g, S, E); }
        gsync(grid);
        if (layer == 0) {
            { pg8::Gemm g{Hb, (const bf16*)(ws + WS_MIXIN), MTOK, LD_AB, DM}; pg8::StaticOrder S; S.init(MTOK, LD_AB, G, bid); pg8::EpiPlain E{PROJ, LD_AB, SSQ + (size_t)(layer * 4 + 1) * (MTOK * 8)};
              pg8::gemm_phase<pg8::EpiPlain, pg8::StaticOrder, true, true>(lds, g, S, E); }
            gsync(grid);
#ifdef EXP_DUP_MA
            for (int rep_ = 0; rep_ < 2; ++rep_) {
#else
            {
#endif
#ifndef DBG_NO_A
            { const int tid = fresh_tid();
            for (int u = bid; u < 3072; u += G) {
                const int cfg = u >> 10; int v = u & 1023; const int h = v & 7; v >>= 3; const int b = v >> 4, rest = v & 15;
                const int dil = cfg == 0 ? 1 : (cfg == 1 ? 4 : 16), tiles = 16 / dil, r = rest / tiles, tile = rest % tiles, L = SEQ / dil, q0 = tile * 128;
                const bf16* base = PROJ + (size_t)b * SEQ * LD_AB + h * 128;
                const float slope = exp2f(-(float)(h + 1)) * (float)dil;
                banded_unit<128, 5, 1>(lds, tid, base, base + 1024, base + 2048, LD_AB, dil, r, L, q0 + 16 * wave, q0 - 64, 272, 16 * wave, 64, slope, 0.08838834764831845f, -1e30f, 0.f,
                                    OC + (size_t)cfg * MTOK * 1024 + (size_t)b * SEQ * 1024 + h * 128, 1024, LSE + (size_t)cfg * MTOK * 8 + (size_t)b * SEQ * 8 + h);
            } }
#endif
#ifndef DBG_NO_GLA
            { const int tid = fresh_tid(); for (int u = bid; u < 1024; u += G) gla_stage1_unit(lds, tid, PROJ, u, p.in[7], p.in[8], p.in[9], p.in[10], ST, DD); }
#endif
            }
            gsync(grid);
#if !defined(DBG_NO_GLA) && !defined(DBG_NO_SCAN)
            gla_scan(ST, DD, bid * 512 + fresh_tid(), nthreads);
#endif
            gsync(grid);
#ifdef EXP_DUP_MC
            for (int rep_ = 0; rep_ < 2; ++rep_) {
#else
            {
#endif
#ifndef DBG_NO_GLA
            { const int tid = fresh_tid(); for (int u = bid; u < 1024; u += G) gla_stage3_unit(lds, tid, PROJ, u, p.in[7], p.in[8], p.in[9], p.in[10], ST, p.in[11], OBUF); }
#else
            for (int t_ = bid * 512 + fresh_tid(); t_ < MTOK * 128; t_ += nthreads) *(u32x4*)(OBUF + (size_t)(t_ >> 7) * DM + 1024 + (t_ & 127) * 8) = (u32x4){0u, 0u, 0u, 0u};
#endif
#ifndef DBG_NO_A
            combine_a(OC, LSE, OBUF, bid * 512 + fresh_tid(), nthreads);
#else
            for (int t_ = bid * 512 + fresh_tid(); t_ < MTOK * 128; t_ += nthreads) *(u32x4*)(OBUF + (size_t)(t_ >> 7) * DM + (t_ & 127) * 8) = (u32x4){0u, 0u, 0u, 0u};
#endif
            }
            gsync(grid);
        } else {
            { pg8::Gemm g{Hb, (const bf16*)(ws + WS_MIXIN), MTOK, LD_C, DM}; pg8::StaticOrder S; S.init(MTOK, LD_C, G, bid); pg8::EpiPlain E{PROJ, LD_C, SSQ + (size_t)(layer * 4 + 1) * (MTOK * 8)};
              pg8::gemm_phase<pg8::EpiPlain, pg8::StaticOrder, true, true>(lds, g, S, E); }
            gsync(grid);
#ifdef EXP_DUP_C
            for (int rep_ = 0; rep_ < 2; ++rep_)
#endif
            { const int tid = fresh_tid();
            for (int u = bid; u < 1024; u += G) {
                const int qt = u & 31, gk = (u >> 5) & 3, b = u >> 7, head = gk * 8 + wave;
                const bf16* base = PROJ + (size_t)b * SEQ * LD_C;
                banded_unit<64, 10, 4>(lds, tid, base + head * 64, base + 2048 + gk * 64, base + 2304 + gk * 64, LD_C, 1, 0, SEQ, qt * 64, qt * 64 - 128, 320, 0, 128,
                                   exp2f(-0.25f * (float)(head + 1)), 0.125f, p.in[26][head], 1.f, OBUF + (size_t)b * SEQ * DM + head * 64, DM, nullptr);
            } }
            gsync(grid);
        }
        { pg8::Gemm g{OBUF, (const bf16*)(ws + WS_MIXOUT), MTOK, DM, DM}; pg8::StaticOrder S; S.init(MTOK, DM, G, bid); pg8::EpiResid<false, false> E{Hb, nullptr, SSQ + (size_t)(layer * 4 + 2) * (MTOK * 8), (LAS float*)(lds + 131072)};
          pg8::gemm_phase<pg8::EpiResid<false, false>, pg8::StaticOrder, true, true>(lds, g, S, E); }
        gsync(grid);
        { pg8::Gemm g{Hb, (const bf16*)(ws + WS_WQ), MTOK, DM, DM}; pg8::StaticOrder S; S.init(MTOK, DM, G, bid); pg8::EpiPlain E{PROJ, DM, SSQ + (size_t)(layer * 4 + 2) * (MTOK * 8)};
          pg8::gemm_phase<pg8::EpiPlain, pg8::StaticOrder, true, true>(lds, g, S, E); }
        gsync(grid);
        { const int tid = fresh_tid(); for (int u = bid; u < 512; u += G) xattn_unit(lds, tid, PROJ, KV + (size_t)layer * NBATCH * MEMLEN * 4096, OBUF, u); }
#ifdef EXP_DUP_XATTN
        { const int tid = fresh_tid(); for (int u = bid; u < 512; u += G) xattn_unit(lds, tid, PROJ, KV + (size_t)layer * NBATCH * MEMLEN * 4096, OBUF, u); }
#endif
        gsync(grid);
        { pg8::Gemm g{OBUF, (const bf16*)(ws + WS_WO), MTOK, DM, DM}; pg8::StaticOrder S; S.init(MTOK, DM, G, bid); pg8::EpiResid<false, false> E{Hb, nullptr, SSQ + (size_t)(layer * 4 + 3) * (MTOK * 8), (LAS float*)(lds + 131072)};
          pg8::gemm_phase<pg8::EpiResid<false, false>, pg8::StaticOrder, true, true>(lds, g, S, E); }
        gsync(grid);
        { pg8::Gemm g{Hb, (const bf16*)(ws + WS_FF2IN), MTOK, 2 * DFF, DM}; pg8::StaticOrder S; S.init(MTOK, 2 * DFF, G, bid); pg8::EpiSwiglu E{PROJ, DFF, SSQ + (size_t)(layer * 4 + 3) * (MTOK * 8)};
          pg8::gemm_phase<pg8::EpiSwiglu, pg8::StaticOrder, true, true>(lds, g, S, E); }
        gsync(grid);
        { pg8::Gemm g{PROJ, (const bf16*)(ws + WS_FF2OUT), MTOK, DM, DFF}; pg8::StaticOrder S; S.init(MTOK, DM, G, bid); pg8::EpiResid<true, layer == 1> E{Hb, X, SSQ + (size_t)(layer * 4 + 4) * (MTOK * 8), (LAS float*)(lds + 131072)};
          pg8::gemm_phase<pg8::EpiResid<true, layer == 1>, pg8::StaticOrder, true, true>(lds, g, S, E); }
        gsync(grid);
        if (layer == 0) {
            convert_weights<1>(p, lds, gw, ngw, wave, fresh_tid() & 63);
            gsync(grid);
        } else {
            const int ftl = fresh_tid() & 63;
            int m = gw;
            for (; m + ngw < MTOK; m += 2 * ngw) norm_row2(X + (size_t)m * DM, X + (size_t)(m + ngw) * DM, p.in[36], nullptr, nullptr, X + (size_t)m * DM, X + (size_t)(m + ngw) * DM, ftl);
            for (; m < MTOK; m += ngw) norm_row(X + (size_t)m * DM, p.in[36], nullptr, X + (size_t)m * DM, ftl);
        }
    return false;
}

__global__ void __launch_bounds__(512, 2) mega_fwd(Params p) {
    extern __shared__ __attribute__((aligned(16))) unsigned char lds_raw[];
    LAS unsigned char* lds = (LAS unsigned char*)lds_raw;
    cg::grid_group grid = cg::this_grid();
    volatile LAS unsigned* xst = (volatile LAS unsigned*)(lds + LDS_BYTES - 64);
    if (threadIdx.x == 0) { xst[0] = 0u; xst[1] = 0u; }
    __syncthreads();
    const XcdBarrier xbar = xcd_barrier_post((unsigned*)(p.ws + WS_CTL), xst);
    const int wave = __builtin_amdgcn_readfirstlane((int)threadIdx.x >> 6);
    const int G = gridDim.x, bid = blockIdx.x, gw = bid * 8 + wave, ngw = G * 8, nthreads = G * 512;
    unsigned char* ws = p.ws;
    bf16* Hb = (bf16*)(ws + WS_H); bf16* PROJ = (bf16*)(ws + WS_PROJ); bf16* OBUF = (bf16*)(ws + WS_OBUF); bf16* OC = (bf16*)(ws + WS_OC); float* LSE = (float*)(ws + WS_LSE);
    bf16* ST = (bf16*)(ws + WS_ST); float* DD = (float*)(ws + WS_DD); bf16* KV = (bf16*)(ws + WS_KV); bf16* MEMH = (bf16*)(ws + WS_MEMH);
    float* X = p.out; float* SSQ = (float*)(p.ws + WS_SSQ);

    convert_weights<0>(p, lds, gw, ngw, wave, fresh_tid() & 63);
#ifdef EXP_DUP_CONVERT
    convert_weights<0>(p, lds, gw, ngw, wave, fresh_tid() & 63);
#endif
#ifdef EXP_SYNCS
    for (int i_ = 0; i_ < 20; ++i_) gsync(grid);
#endif
    norm_rows(p.in[1], p.in[14], MEMH, NBATCH * MEMLEN, gw, ngw, fresh_tid() & 63);
    norm_rows(p.in[1], p.in[29], MEMH + (size_t)NBATCH * MEMLEN * DM, NBATCH * MEMLEN, gw, ngw, fresh_tid() & 63);
    cast_rows_ssq(p.in[0], Hb, SSQ, MTOK, gw, ngw, fresh_tid() & 63);
    gsync_cg(grid);
    {
        pg8::Gemm g0{MEMH, (const bf16*)(ws + WS_WKV0), NBATCH * MEMLEN, 4096, DM}; pg8::StaticOrder S0; S0.init(NBATCH * MEMLEN, 4096, G, bid);
        pg8::EpiPlain E0{KV, 4096, nullptr};
        pg8::gemm_phase<pg8::EpiPlain, pg8::StaticOrder, true, true>(lds, g0, S0, E0);
        pg8::Gemm g1{MEMH + (size_t)NBATCH * MEMLEN * DM, (const bf16*)(ws + WS_WKV1), NBATCH * MEMLEN, 4096, DM}; pg8::StaticOrder S1; S1.init(NBATCH * MEMLEN, 4096, G, (bid + G / 2) % G);
        pg8::EpiPlain E1{KV + (size_t)NBATCH * MEMLEN * 4096, 4096, nullptr};
        pg8::gemm_phase<pg8::EpiPlain, pg8::StaticOrder, true, true>(lds, g1, S1, E1);
    }
    if (run_layer<0>(p, lds, grid, xbar, wave, G, bid, gw, ngw, nthreads)) return;
    if (run_layer<1>(p, lds, grid, xbar, wave, G, bid, gw, ngw, nthreads)) return;
}

extern "C" void kernel_launch(void* const* d_in, const int* in_sizes, int n_in, void* d_out, int out_size, void* d_ws, size_t ws_size, hipStream_t stream) {
    static int grid = 0;
    if (grid == 0) {
        if (n_in != 37 || out_size != MTOK * DM || ws_size < WS_END) { fprintf(stderr, "kernel_launch: unexpected shapes (n_in %d out %d ws %zu)\n", n_in, out_size, ws_size); grid = -1; return; }
        int dev = 0, cus = 0, per_cu = 0;
        hipGetDevice(&dev);
        hipDeviceGetAttribute(&cus, hipDeviceAttributeMultiprocessorCount, dev);
        hipFuncSetAttribute((const void*)mega_fwd, hipFuncAttributeMaxDynamicSharedMemorySize, LDS_BYTES);
        if (hipOccupancyMaxActiveBlocksPerMultiprocessor(&per_cu, (const void*)mega_fwd, 512, LDS_BYTES) != hipSuccess || per_cu < 1) per_cu = 1;
        (void)hipGetLastError();
        grid = cus * per_cu;
    }
    if (grid < 0) return;
    if (hipMemsetAsync((char*)d_ws + WS_CTL, 0, 16384, stream) != hipSuccess) { fprintf(stderr, "kernel_launch: memset of the barrier words failed\n"); return; }
    Params p{};
    for (int i = 0; i < 37; ++i) p.in[i] = (const float*)d_in[i];
    p.out = (float*)d_out; p.ws = (unsigned char*)d_ws;
    void* args[] = {&p};
    hipError_t e = hipLaunchCooperativeKernel((const void*)mega_fwd, dim3(grid), dim3(512), args, LDS_BYTES, stream);
    if (e != hipSuccess) fprintf(stderr, "cooperative launch failed: %s (grid %d)\n", hipGetErrorString(e), grid);
}
```
